# Optimizing an MI355X kernel written in HIP

```python
import math
import jax, jax.numpy as jnp
from jax import lax
import numpy as np

D_MODEL = 1024
BATCH = 8
SEQ = 2048
DEPTH = 1

HEAD_DIM = 64
FOX_HEADS = D_MODEL // 128
DIFF_HEADS = D_MODEL // 256
FOX_WIDTH = FOX_HEADS * HEAD_DIM
DIFF_WIDTH = DIFF_HEADS * 2 * HEAD_DIM
MIX_WIDTH = FOX_WIDTH + DIFF_WIDTH
IN_COLS = 3 * FOX_WIDTH + FOX_HEADS + 3 * DIFF_WIDTH
ROPE_THETA = 500000.0
ROT_DIM = HEAD_DIM // 4
Q_BLOCK = 128
PEER_HEADS = 8
PEER_KEYS = 128
PEER_EXPERTS = PEER_KEYS * PEER_KEYS
PEER_KEY_DIM = 128
PEER_HALF = PEER_KEY_DIM // 2
PEER_TOPK = 16
TOKEN_CHUNK = 128
NORM_EPS = 1e-6
SUBLN_EPS = 1e-5

kernel_name = "hybrid_fox_diffattn_peer_adaln"


def _rmsnorm(x, g, eps):
    xf = x.astype(jnp.float32)
    y = xf * lax.rsqrt(jnp.mean(xf * xf, axis=-1, keepdims=True) + eps)
    return (y * g.astype(jnp.float32)).astype(x.dtype)


def _partial_rope(t, pos):
    half = ROT_DIM // 2
    inv = ROPE_THETA ** (-jnp.arange(0, ROT_DIM, 2, dtype=jnp.float32) / ROT_DIM)
    ang = pos[:, None] * inv[None, :]
    cos, sin = jnp.cos(ang), jnp.sin(ang)
    tr = t[..., :ROT_DIM].astype(jnp.float32)
    t1, t2 = tr[..., :half], tr[..., half:]
    rot = jnp.concatenate([t1 * cos - t2 * sin, t2 * cos + t1 * sin], axis=-1)
    return jnp.concatenate([rot.astype(t.dtype), t[..., ROT_DIM:]], axis=-1)


def _fox_attention(q, k, v, logf):
    B, H, S, dh = q.shape
    nb = S // Q_BLOCK
    F = jnp.cumsum(logf, axis=-1)
    qb = q.reshape(B, H, nb, Q_BLOCK, dh).transpose(2, 0, 1, 3, 4)
    Fb = F.reshape(B, H, nb, Q_BLOCK).transpose(2, 0, 1, 3)
    kf = k.astype(jnp.float32)
    kpos = jnp.arange(S)
    scale = dh ** -0.5

    def block(args):
        qi, Fi, bi = args
        s = jnp.einsum('bhqd,bhkd->bhqk', qi.astype(jnp.float32), kf) * scale
        s = s + Fi[..., None] - F[:, :, None, :]
        qpos = bi * Q_BLOCK + jnp.arange(Q_BLOCK)
        s = jnp.where(kpos[None, :] <= qpos[:, None], s, -jnp.inf)
        p = jax.nn.softmax(s, axis=-1)
        return jnp.einsum('bhqk,bhkd->bhqd', p.astype(v.dtype), v)

    o = lax.map(block, (qb, Fb, jnp.arange(nb)))
    return o.transpose(1, 2, 0, 3, 4).reshape(B, H, S, dh)


def _diff_attention(q, k, v, lam):
    B, H, _, S, dh = q.shape
    nb = S // Q_BLOCK
    qb = q.reshape(B, H, 2, nb, Q_BLOCK, dh).transpose(3, 0, 1, 2, 4, 5)
    kf = k.astype(jnp.float32)
    kpos = jnp.arange(S)
    scale = dh ** -0.5

    def block(args):
        qi, bi = args
        s = jnp.einsum('bhcqd,bhckd->bhcqk', qi.astype(jnp.float32), kf) * scale
        qpos = bi * Q_BLOCK + jnp.arange(Q_BLOCK)
        s = jnp.where(kpos[None, :] <= qpos[:, None], s, -jnp.inf)
        p = jax.nn.softmax(s, axis=-1)
        pd = p[:, :, 0] - lam * p[:, :, 1]
        return jnp.einsum('bhqk,bhkd->bhqd', pd.astype(v.dtype), v)

    o = lax.map(block, (qb, jnp.arange(nb)))
    return o.transpose(1, 2, 0, 3, 4).reshape(B, H, S, 2 * dh)


def _peer(h, w_pq, sub_keys, u_tab, v_tab):
    B, S, D = h.shape
    q = (h @ w_pq).reshape(B, S, PEER_HEADS, 2, PEER_HALF).astype(jnp.float32)
    sk = sub_keys.astype(jnp.float32)
    s1 = jnp.einsum('bshd,nd->bshn', q[..., 0, :], sk[0])
    s2 = jnp.einsum('bshd,nd->bshn', q[..., 1, :], sk[1])
    sc1, i1 = lax.top_k(s1, PEER_TOPK)
    sc2, i2 = lax.top_k(s2, PEER_TOPK)
    comb = (sc1[..., :, None] + sc2[..., None, :]).reshape(B, S, PEER_HEADS, PEER_TOPK * PEER_TOPK)
    top, ci = lax.top_k(comb, PEER_TOPK)
    e_idx = (jnp.take_along_axis(i1, ci // PEER_TOPK, axis=-1) * PEER_KEYS
             + jnp.take_along_axis(i2, ci % PEER_TOPK, axis=-1))
    g = jax.nn.softmax(top, axis=-1)
    T = B * S
    nc = T // TOKEN_CHUNK
    K = PEER_HEADS * PEER_TOPK
    hc = h.reshape(nc, TOKEN_CHUNK, D)
    ic = e_idx.reshape(nc, TOKEN_CHUNK, K)
    gc = g.reshape(nc, TOKEN_CHUNK, K)

    def chunk(args):
        hx, ix, gx = args
        u = u_tab[ix]
        a = jnp.einsum('ckd,cd->ck', u.astype(jnp.float32), hx.astype(jnp.float32))
        w = jax.nn.gelu(a, approximate=False) * gx
        return jnp.einsum('ck,ckd->cd', w.astype(h.dtype), v_tab[ix])

    out = lax.map(chunk, (hc, ic, gc))
    return out.reshape(B, S, D)


def setup_inputs(seed: int = 0) -> dict:
    key = jax.random.key(seed)
    ks = jax.random.split(key, 20)
    f32 = jnp.float32
    nrm = lambda k, shape, s: (jax.random.normal(k, shape, f32) * s)
    return {
        "x": nrm(ks[0], (BATCH, SEQ, D_MODEL), 1.0),
        "c": nrm(ks[1], (BATCH, D_MODEL), 1.0),
        "w_ada": nrm(ks[2], (DEPTH, D_MODEL, 6 * D_MODEL), 0.5 * D_MODEL ** -0.5),
        "b_ada": nrm(ks[3], (DEPTH, 6 * D_MODEL), 0.02),
        "g_attn": 1.0 + nrm(ks[4], (DEPTH, D_MODEL), 0.02),
        "w_in": nrm(ks[5], (DEPTH, D_MODEL, IN_COLS), D_MODEL ** -0.5),
        "b_f": nrm(ks[6], (DEPTH, FOX_HEADS), 0.1),
        "lambda_q1": nrm(ks[7], (DEPTH, HEAD_DIM), 0.1),
        "lambda_k1": nrm(ks[8], (DEPTH, HEAD_DIM), 0.1),
        "lambda_q2": nrm(ks[9], (DEPTH, HEAD_DIM), 0.1),
        "lambda_k2": nrm(ks[10], (DEPTH, HEAD_DIM), 0.1),
        "g_subln": 1.0 + nrm(ks[11], (DEPTH, 2 * HEAD_DIM), 0.02),
        "w_o": nrm(ks[12], (DEPTH, MIX_WIDTH, D_MODEL), MIX_WIDTH ** -0.5),
        "g_ffn": 1.0 + nrm(ks[13], (DEPTH, D_MODEL), 0.02),
        "w_pq": nrm(ks[14], (DEPTH, D_MODEL, PEER_HEADS * PEER_KEY_DIM), D_MODEL ** -0.5),
        "sub_keys": nrm(ks[15], (DEPTH, 2, PEER_KEYS, PEER_HALF), PEER_HALF ** -0.5),
        "u_experts": nrm(ks[16], (DEPTH, PEER_EXPERTS, D_MODEL), D_MODEL ** -0.5),
        "v_experts": nrm(ks[17], (DEPTH, PEER_EXPERTS, D_MODEL), PEER_TOPK ** -0.5),
        "g_final": 1.0 + nrm(ks[18], (D_MODEL,), 0.02),
    }


def reference(x, c, w_ada, b_ada, g_attn, w_in, b_f, lambda_q1, lambda_k1, lambda_q2,
              lambda_k2, g_subln, w_o, g_ffn, w_pq, sub_keys, u_experts, v_experts, g_final):
    B, S, D = x.shape
    pos = jnp.arange(S, dtype=jnp.float32)
    split_at = np.cumsum([FOX_WIDTH, FOX_WIDTH, FOX_WIDTH, FOX_HEADS,
                          DIFF_WIDTH, DIFF_WIDTH]).tolist()
    for l in range(DEPTH):
        mod = (jax.nn.silu(c.astype(jnp.float32)) @ w_ada[l].astype(jnp.float32)
               + b_ada[l].astype(jnp.float32)).astype(x.dtype)
        sh1, sc1, gt1, sh2, sc2, gt2 = [m[:, None, :] for m in jnp.split(mod, 6, axis=-1)]

        h = _rmsnorm(x, g_attn[l], NORM_EPS) * (1 + sc1) + sh1
        proj = h @ w_in[l]
        fq, fk, fv, fg, dq, dk, dv = jnp.split(proj, split_at, axis=-1)

        to_heads = lambda t, H, dh: t.reshape(B, S, H, dh).transpose(0, 2, 1, 3)
        fq, fk, fv = (to_heads(t, FOX_HEADS, HEAD_DIM) for t in (fq, fk, fv))
        logf = jax.nn.log_sigmoid((fg + b_f[l]).astype(jnp.float32)).transpose(0, 2, 1)
        o_fox = _fox_attention(fq, fk, fv, logf)

        to_pairs = lambda t: t.reshape(B, S, DIFF_HEADS, 2, HEAD_DIM).transpose(0, 2, 3, 1, 4)
        dq = _partial_rope(to_pairs(dq), pos)
        dk = _partial_rope(to_pairs(dk), pos)
        dv = to_heads(dv, DIFF_HEADS, 2 * HEAD_DIM)
        lam_init = 0.8 - 0.6 * math.exp(-0.3 * l)
        lam = (jnp.exp(jnp.sum(lambda_q1[l].astype(jnp.float32) * lambda_k1[l].astype(jnp.float32)))
               - jnp.exp(jnp.sum(lambda_q2[l].astype(jnp.float32) * lambda_k2[l].astype(jnp.float32)))
               + lam_init)
        o_diff = _diff_attention(dq, dk, dv, lam)
        o_diff = _rmsnorm(o_diff, g_subln[l], SUBLN_EPS) * (1.0 - lam_init)

        mixed = jnp.concatenate([
            o_fox.transpose(0, 2, 1, 3).reshape(B, S, FOX_WIDTH),
            o_diff.transpose(0, 2, 1, 3).reshape(B, S, DIFF_WIDTH).astype(o_fox.dtype)], axis=-1)
        x = x + gt1 * (mixed @ w_o[l])

        h2 = _rmsnorm(x, g_ffn[l], NORM_EPS) * (1 + sc2) + sh2
        x = x + gt2 * _peer(h2, w_pq[l], sub_keys[l], u_experts[l], v_experts[l])
    return _rmsnorm(x, g_final, NORM_EPS)
```

```cpp
#include <hip/hip_runtime.h>
#include <hip/hip_cooperative_groups.h>
#include <cstdio>
namespace cg = cooperative_groups;

#define DI __device__ __forceinline__
typedef unsigned short u16;
using bf16x8 = __attribute__((ext_vector_type(8))) short;
using f32x16 = __attribute__((ext_vector_type(16))) float;
typedef __bf16 bf16x2_t __attribute__((ext_vector_type(2)));
typedef float f32x2_t __attribute__((ext_vector_type(2)));
using u32x4 = __attribute__((ext_vector_type(4))) unsigned;
using u32x2 = __attribute__((ext_vector_type(2))) unsigned;
using f32x4 = __attribute__((ext_vector_type(4))) float;

#define MFMA32(a, b, c) __builtin_amdgcn_mfma_f32_32x32x16_bf16((a), (b), (c), 0, 0, 0)

static constexpr int T_TOK = 16384;
static constexpr int SEQ = 2048;
static constexpr int DM = 1024;
static constexpr int INC = 3080;
static constexpr float LOG2E = 1.4426950408889634f;
static constexpr int NTHREADS = 256;
static constexpr int SMEM_BYTES = 65536;

struct Params {
  const float *x, *c, *w_ada, *b_ada, *g_attn, *w_in, *b_f, *lq1, *lk1, *lq2, *lk2, *g_subln, *w_o, *g_ffn, *w_pq,
      *sub_keys, *u_exp, *v_exp, *g_final;
  float* out;
  char* ws;
  static constexpr size_t MB = 1024 * 1024;
  DI u16* WtIn() const { return (u16*)(ws + 0 * MB); }
  DI u16* WtO() const { return (u16*)(ws + 6 * MB); }
  DI u16* WtPq() const { return (u16*)(ws + 8 * MB); }
  DI u16* Ub() const { return (u16*)(ws + 10 * MB); }
  DI u16* Vb() const { return (u16*)(ws + 42 * MB); }
  DI u16* H() const { return (u16*)(ws + 74 * MB); }
  DI u16* QK() const { return (u16*)(ws + 106 * MB); }
  DI u16* Vt() const { return (u16*)(ws + 170 * MB); }
  DI u16* Qp() const { return (u16*)(ws + 106 * MB); }
  DI float* mod() const { return (float*)(ws + 202 * MB); }
  DI float* rope() const { return (float*)(ws + 202 * MB + 256 * 1024); }
  DI float* logf() const { return (float*)(ws + 203 * MB); }
  DI float* FL() const { return (float*)(ws + 204 * MB); }
  DI unsigned* counters() const { return (unsigned*)(ws + 205 * MB); }
  DI float* stash() const { return (float*)(ws + 206 * MB); }
};

DI unsigned pk2(float a, float b) {
  f32x2_t v = {a, b};
  bf16x2_t r = __builtin_convertvector(v, bf16x2_t);
  return __builtin_bit_cast(unsigned, r);
}
DI float bf_lo(unsigned u) { return __uint_as_float(u << 16); }
DI float bf_hi(unsigned u) { return __uint_as_float(u & 0xffff0000u); }
DI float wave_sum(float v) {
#pragma unroll
  for (int o = 32; o >= 1; o >>= 1) v += __shfl_xor(v, o);
  return v;
}
DI float wave_max(float v) {
#pragma unroll
  for (int o = 32; o >= 1; o >>= 1) v = fmaxf(v, __shfl_xor(v, o));
  return v;
}

DI void transpose_tile(const float* __restrict__ src, int ld, int col0, int k0, u16* __restrict__ dst, int n0, char* smem,
                       int tid) {
  float* t = (float*)smem;
  __syncthreads();
  {
    int cc = tid & 63, r0 = tid >> 6;
#pragma unroll
    for (int i = 0; i < 16; i++) {
      int r = r0 + 4 * i;
      t[r * 65 + cc] = src[(size_t)(k0 + r) * ld + col0 + cc];
    }
  }
  __syncthreads();
#pragma unroll
  for (int i = 0; i < 2; i++) {
    int q = tid + 256 * i;
    int n = q >> 3, kc = q & 7;
    uint4 v;
    v.x = pk2(t[(8 * kc + 0) * 65 + n], t[(8 * kc + 1) * 65 + n]);
    v.y = pk2(t[(8 * kc + 2) * 65 + n], t[(8 * kc + 3) * 65 + n]);
    v.z = pk2(t[(8 * kc + 4) * 65 + n], t[(8 * kc + 5) * 65 + n]);
    v.w = pk2(t[(8 * kc + 6) * 65 + n], t[(8 * kc + 7) * 65 + n]);
    *(uint4*)(dst + (size_t)(n0 + n) * 1024 + k0 + 8 * kc) = v;
  }
}

DI void phase0(const Params& p, char* smem, int tid) {
  asm volatile("" : "+v"(tid));
  const int bid = blockIdx.x, nb = gridDim.x;
  if (bid == 0 && tid == 0) { p.counters()[0] = 0u; p.counters()[1] = 0u; }
  {
    float* sc = (float*)smem;
    float* red = (float*)(smem + 32768);
    bool loaded = false;
    for (int it = bid; it < 192; it += nb) {
      if (!loaded) {
        for (int i = tid; i < 8192; i += NTHREADS) {
          float v = p.c[i];
          sc[i] = v / (1.f + __expf(-v));
        }
        loaded = true;
      }
      __syncthreads();
      int col = it * 32 + (tid & 31), kg = tid >> 5;
      float acc[8];
#pragma unroll
      for (int b = 0; b < 8; b++) acc[b] = 0.f;
      for (int k = kg * 128; k < kg * 128 + 128; k++) {
        float w = p.w_ada[(size_t)k * 6144 + col];
#pragma unroll
        for (int b = 0; b < 8; b++) acc[b] += sc[b * 1024 + k] * w;
      }
#pragma unroll
      for (int b = 0; b < 8; b++) red[(kg * 8 + b) * 32 + (tid & 31)] = acc[b];
      __syncthreads();
      {
        int b = tid >> 5, cc = tid & 31;
        float s = 0.f;
#pragma unroll
        for (int g = 0; g < 8; g++) s += red[(g * 8 + b) * 32 + cc];
        p.mod()[b * 6144 + it * 32 + cc] = s + p.b_ada[it * 32 + cc];
      }
    }
    __syncthreads();
  }
  for (int it = bid; it < 1280; it += nb) {
    if (it < 768) {
      int nt = it >> 4, kt = it & 15;
      int n0 = nt * 64;
      int col0 = n0 < 1536 ? n0 : n0 + 8;
      transpose_tile(p.w_in, INC, col0, kt * 64, p.WtIn(), n0, smem, tid);
    } else if (it < 1024) {
      int j = it - 768;
      transpose_tile(p.w_o, 1024, (j >> 4) * 64, (j & 15) * 64, p.WtO(), (j >> 4) * 64, smem, tid);
    } else {
      int j = it - 1024;
      transpose_tile(p.w_pq, 1024, (j >> 4) * 64, (j & 15) * 64, p.WtPq(), (j >> 4) * 64, smem, tid);
    }
  }
  {
    const size_t ngroups = (size_t)16384 * 1024 / 8;
    for (size_t g = (size_t)bid * NTHREADS + tid; g < 2 * ngroups; g += (size_t)nb * NTHREADS) {
      const float* src = g < ngroups ? p.u_exp + g * 8 : p.v_exp + (g - ngroups) * 8;
      u16* dst = g < ngroups ? p.Ub() + g * 8 : p.Vb() + (g - ngroups) * 8;
      float4 a = *(const float4*)src, b = *(const float4*)(src + 4);
      uint4 v;
      v.x = pk2(a.x, a.y); v.y = pk2(a.z, a.w); v.z = pk2(b.x, b.y); v.w = pk2(b.z, b.w);
      *(uint4*)dst = v;
    }
  }
  for (int e = bid * NTHREADS + tid; e < 2048 * 8; e += nb * NTHREADS) {
    int pos = e >> 3, i = e & 7;
    const double invs[8] = {1.0, 0.19392274474868576, 0.03760603093086393, 0.007292664737217109,
                            0.001414213562373095, 0.0002742481756762073, 5.318295896944988e-05, 1.031338537721246e-05};
    double inv = invs[0];
#pragma unroll
    for (int q = 1; q < 8; q++) inv = (i == q) ? invs[q] : inv;
    double ang = (double)pos * inv;
    double t = ang * 0.15915494309189535;
    t -= rint(t);
    double r = t * 6.283185307179586;
    double r2 = r * r;
    double s = 1.0, c = 1.0;
#pragma unroll
    for (int n = 15; n >= 1; n--) {
      s = 1.0 - s * r2 * (1.0 / (double)((2 * n) * (2 * n + 1)));
      c = 1.0 - c * r2 * (1.0 / (double)((2 * n - 1) * (2 * n)));
    }
    s *= r;
    p.rope()[pos * 16 + i] = (float)c;
    p.rope()[pos * 16 + 8 + i] = (float)s;
  }
}

DI void phase1a(const Params& p, char* smem, int tid) {
  asm volatile("" : "+v"(tid));
  float* wfg = (float*)smem;
  __syncthreads();
  for (int i = tid; i < 8192; i += NTHREADS) {
    int k = i >> 3, j = i & 7;
    wfg[j * 1024 + k] = p.w_in[(size_t)k * INC + 1536 + j];
  }
  __syncthreads();
  const int lane = tid & 63, w = tid >> 6;
  for (int tok = blockIdx.x * 4 + w; tok < T_TOK; tok += gridDim.x * 4) {
    const int b = tok >> 11, s = tok & 2047;
    const float* xr = p.x + (size_t)tok * DM;
    float4 xv[4];
    float ss = 0.f;
#pragma unroll
    for (int i = 0; i < 4; i++) {
      xv[i] = *(const float4*)(xr + 256 * i + 4 * lane);
      ss += xv[i].x * xv[i].x + xv[i].y * xv[i].y + xv[i].z * xv[i].z + xv[i].w * xv[i].w;
    }
    ss = wave_sum(ss);
    const float rstd = rsqrtf(ss * (1.f / 1024.f) + 1e-6f);
    const float* md = p.mod() + b * 6144;
    float fg[8];
#pragma unroll
    for (int j = 0; j < 8; j++) fg[j] = 0.f;
#pragma unroll
    for (int i = 0; i < 4; i++) {
      const int c0 = 256 * i + 4 * lane;
      float4 g = *(const float4*)(p.g_attn + c0);
      float4 sh = *(const float4*)(md + c0);
      float4 sc = *(const float4*)(md + 1024 + c0);
      float4 h;
      h.x = xv[i].x * rstd * g.x * (1.f + sc.x) + sh.x;
      h.y = xv[i].y * rstd * g.y * (1.f + sc.y) + sh.y;
      h.z = xv[i].z * rstd * g.z * (1.f + sc.z) + sh.z;
      h.w = xv[i].w * rstd * g.w * (1.f + sc.w) + sh.w;
      uint2 o;
      o.x = pk2(h.x, h.y); o.y = pk2(h.z, h.w);
      *(uint2*)(p.H() + (size_t)tok * DM + c0) = o;
#pragma unroll
      for (int j = 0; j < 8; j++) {
        float4 wv = *(const float4*)(wfg + j * 1024 + c0);
        fg[j] += h.x * wv.x + h.y * wv.y + h.z * wv.z + h.w * wv.w;
      }
    }
#pragma unroll
    for (int j = 0; j < 8; j++) fg[j] = wave_sum(fg[j]);
    float z = fg[0];
#pragma unroll
    for (int j = 1; j < 8; j++) z = (lane == j) ? fg[j] : z;
    if (lane < 8) {
      z += p.b_f[lane];
      float ls = fminf(z, 0.f) - log1pf(__expf(-fabsf(z)));
      p.logf()[(b * 8 + lane) * SEQ + s] = ls;
    }
  }
}

DI void phase_cumsum(const Params& p, char* smem, int tid) {
  asm volatile("" : "+v"(tid));
  double* part = (double*)smem;
  for (int seq = blockIdx.x; seq < 64; seq += gridDim.x) {
    __syncthreads();
    const float* lf = p.logf() + seq * SEQ + tid * 8;
    float4 a = *(const float4*)lf, b = *(const float4*)(lf + 4);
    double v0 = a.x, v1 = v0 + a.y, v2 = v1 + a.z, v3 = v2 + a.w, v4 = v3 + b.x, v5 = v4 + b.y, v6 = v5 + b.z, v7 = v6 + b.w;
    double run = v7;
    part[tid] = run;
    __syncthreads();
    double pre = 0.0;
    for (int i = 0; i < tid; i++) pre += part[i];
    const double L2E = 1.4426950408889634;
    float* dst = p.FL() + seq * SEQ + tid * 8;
    *(float4*)dst = make_float4((float)((v0 + pre) * L2E), (float)((v1 + pre) * L2E), (float)((v2 + pre) * L2E), (float)((v3 + pre) * L2E));
    *(float4*)(dst + 4) = make_float4((float)((v4 + pre) * L2E), (float)((v5 + pre) * L2E), (float)((v6 + pre) * L2E), (float)((v7 + pre) * L2E));
  }
  __syncthreads();
}

DI void gemm_mainloop(const u16* __restrict__ Lg, const u16* __restrict__ Rg, int l0, int r0, char* smem, int tid,
                      f32x16 (&acc)[2][2]) {
  const int lane = tid & 63, w = tid >> 6;
  const int wm = w & 1, wn = w >> 1;
  const int r = lane & 31, h = lane >> 5;
  const int lc = tid & 7, lr = tid >> 3;
  const int sw = ((lr >> 1) & 7);
#pragma unroll
  for (int i = 0; i < 2; i++)
#pragma unroll
    for (int j = 0; j < 2; j++)
#pragma unroll
      for (int q = 0; q < 16; q++) acc[i][j][q] = 0.f;
  u32x4 ra[4], rb[4];
  const u16* lp = Lg + (size_t)(l0 + lr) * 1024 + lc * 8;
  const u16* rp = Rg + (size_t)(r0 + lr) * 1024 + lc * 8;
#pragma unroll
  for (int i = 0; i < 4; i++) {
    ra[i] = *(const u32x4*)(lp + (size_t)i * 32 * 1024);
    rb[i] = *(const u32x4*)(rp + (size_t)i * 32 * 1024);
  }
  __syncthreads();
  {
    char* sL = smem;
    char* sR = smem + 16384;
#pragma unroll
    for (int i = 0; i < 4; i++) {
      int off = (lr + 32 * i) * 128 + ((lc ^ sw) << 4);
      *(u32x4*)(sL + off) = ra[i];
      *(u32x4*)(sR + off) = rb[i];
    }
  }
  __syncthreads();
  for (int kt = 0; kt < 16; kt++) {
    const char* sL = smem + (kt & 1) * 32768;
    const char* sR = sL + 16384;
    if (kt + 1 < 16) {
#pragma unroll
      for (int i = 0; i < 4; i++) {
        ra[i] = *(const u32x4*)(lp + (size_t)i * 32 * 1024 + (kt + 1) * 64);
        rb[i] = *(const u32x4*)(rp + (size_t)i * 32 * 1024 + (kt + 1) * 64);
      }
    }
#pragma unroll
    for (int ks = 0; ks < 4; ks++) {
      bf16x8 a[2], b[2];
#pragma unroll
      for (int i = 0; i < 2; i++) {
        int row = 64 * wm + 32 * i + r;
        a[i] = *(const bf16x8*)(sL + row * 128 + (((2 * ks + h) ^ ((row >> 1) & 7)) << 4));
        int rowb = 64 * wn + 32 * i + r;
        b[i] = *(const bf16x8*)(sR + rowb * 128 + (((2 * ks + h) ^ ((rowb >> 1) & 7)) << 4));
      }
#pragma unroll
      for (int i = 0; i < 2; i++)
#pragma unroll
        for (int j = 0; j < 2; j++) acc[i][j] = MFMA32(a[i], b[j], acc[i][j]);
    }
    if (kt + 1 < 16) {
      char* dL = smem + ((kt + 1) & 1) * 32768;
      char* dR = dL + 16384;
#pragma unroll
      for (int i = 0; i < 4; i++) {
        int off = (lr + 32 * i) * 128 + ((lc ^ sw) << 4);
        *(u32x4*)(dL + off) = ra[i];
        *(u32x4*)(dR + off) = rb[i];
      }
    }
    __syncthreads();
  }
}

DI void phase1b(const Params& p, char* smem, int tid) {
  asm volatile("" : "+v"(tid));
  const int lane = tid & 63, w = tid >> 6, wm = w & 1, wn = w >> 1, r = lane & 31, h = lane >> 5;
  for (int t = blockIdx.x; t < 128 * 24; t += gridDim.x) {
    const int nt = t % 24, mt = t / 24;
    const int m0 = mt * 128, n0 = nt * 128;
    const int b = m0 >> 11, s0 = m0 & 2047;
    const int seg = nt >> 2;
    f32x16 acc[2][2];
    if (seg == 2 || seg == 5) {
      gemm_mainloop(p.H(), p.WtIn(), m0, n0, smem, tid, acc);
      const int kind = seg == 2 ? 0 : 1;
      const int colbase = n0 - (seg == 2 ? 1024 : 2560);
#pragma unroll
      for (int i = 0; i < 2; i++)
#pragma unroll
        for (int j = 0; j < 2; j++) {
          int col = colbase + 64 * wn + 32 * j + r;
          u16* dst = p.Vt() + ((size_t)(kind * 8 + b) * 512 + col) * SEQ + s0 + 64 * wm + 32 * i + 4 * h;
#pragma unroll
          for (int g = 0; g < 4; g++) {
            uint2 o;
            o.x = pk2(acc[i][j][4 * g + 0], acc[i][j][4 * g + 1]);
            o.y = pk2(acc[i][j][4 * g + 2], acc[i][j][4 * g + 3]);
            *(uint2*)(dst + 8 * g) = o;
          }
        }
    } else {
      gemm_mainloop(p.WtIn(), p.H(), n0, m0, smem, tid, acc);
      const int kind = seg == 0 ? 0 : seg == 1 ? 1 : seg == 3 ? 2 : 3;
      const int colbase = n0 - (seg == 0 ? 0 : seg == 1 ? 512 : seg == 3 ? 1536 : 2048);
      const bool rope = (seg >= 3);
      const float scale = (seg == 0 || seg == 3) ? 0.125f * LOG2E : 1.f;
#pragma unroll
      for (int j = 0; j < 2; j++) {
        const int s = s0 + 64 * wn + 32 * j + r;
        f32x4 cs = {1.f, 1.f, 1.f, 1.f}, sn = {0.f, 0.f, 0.f, 0.f};
        if (rope) {
          cs = *(const f32x4*)(p.rope() + s * 16 + 4 * h);
          sn = *(const f32x4*)(p.rope() + s * 16 + 8 + 4 * h);
        }
#pragma unroll
        for (int i = 0; i < 2; i++) {
          const int colt = colbase + 64 * wm + 32 * i;
          const int hc = colt >> 6, d0 = colt & 63;
          f32x16 v = acc[i][j];
          if (rope && i == 0) {
#pragma unroll
            for (int q = 0; q < 4; q++) {
              float t1 = v[q], t2 = v[q + 4];
              v[q] = t1 * cs[q] - t2 * sn[q];
              v[q + 4] = t2 * cs[q] + t1 * sn[q];
            }
          }
          u16* dst = p.QK() + (((size_t)(kind * 8 + b) * 8 + hc) * SEQ + s) * 64 + d0 + 4 * h;
#pragma unroll
          for (int g = 0; g < 4; g++) {
            uint2 o;
            o.x = pk2(v[4 * g + 0] * scale, v[4 * g + 1] * scale);
            o.y = pk2(v[4 * g + 2] * scale, v[4 * g + 3] * scale);
            *(uint2*)(dst + 8 * g) = o;
          }
        }
      }
    }
  }
}

template <int DV, bool HASF>
DI void attn_pass(const u16* __restrict__ Qg, const u16* __restrict__ Kg, const u16* __restrict__ Vtg,
                  const float* __restrict__ FLg, int q0, char* smem, int tid, f32x16 (&o)[DV / 32]) {
  constexpr int NMB = DV / 32;
  constexpr int KSZ = 64 * 144;
  constexpr int VSZ = DV * 136;
  constexpr int STAGE = KSZ + VSZ + 256;
  constexpr int NVL = DV / 32;
  const int lane = tid & 63, w = tid >> 6, r = lane & 31, h = lane >> 5;
  const int qw0 = q0 + 32 * w;
  const int qcol = qw0 + r;
  const int nkt = (q0 + 128) >> 6;
  bf16x8 qf[4];
#pragma unroll
  for (int ks = 0; ks < 4; ks++) qf[ks] = *(const bf16x8*)(Qg + (size_t)qcol * 64 + 16 * ks + 8 * h);
#pragma unroll
  for (int mb = 0; mb < NMB; mb++)
#pragma unroll
    for (int q = 0; q < 16; q++) o[mb][q] = 0.f;
  float m_run = -INFINITY, lsum = 0.f;

  u32x4 rk[2], rv[NVL];
  f32x4 rf = {0.f, 0.f, 0.f, 0.f};
  auto gload = [&](int kt) {
    const int k0 = kt * 64;
#pragma unroll
    for (int i = 0; i < 2; i++) {
      int idx = tid + 256 * i;
      rk[i] = *(const u32x4*)(Kg + (size_t)(k0 + (idx >> 3)) * 64 + (idx & 7) * 8);
    }
#pragma unroll
    for (int i = 0; i < NVL; i++) {
      int idx = tid + 256 * i;
      rv[i] = *(const u32x4*)(Vtg + (size_t)(idx >> 3) * SEQ + k0 + (idx & 7) * 8);
    }
    if (HASF) {
      if (tid < 16) rf = *(const f32x4*)(FLg + k0 + 4 * tid);
    }
  };
  auto sstore = [&](int stage) {
    char* sK = smem + stage * STAGE;
    char* sV = sK + KSZ;
    float* sF = (float*)(sV + VSZ);
#pragma unroll
    for (int i = 0; i < 2; i++) {
      int idx = tid + 256 * i;
      int row = idx >> 3, c = idx & 7;
      *(u32x4*)(sK + row * 144 + (c << 4)) = rk[i];
    }
#pragma unroll
    for (int i = 0; i < NVL; i++) {
      int idx = tid + 256 * i;
      int row = idx >> 3, c = idx & 7;
      *(u32x2*)(sV + row * 136 + (c << 4)) = u32x2{rv[i].x, rv[i].y};
      *(u32x2*)(sV + row * 136 + (c << 4) + 8) = u32x2{rv[i].z, rv[i].w};
    }
    if (HASF) {
      if (tid < 16) *(f32x4*)(sF + 4 * tid) = rf;
    }
  };

  __syncthreads();
  gload(0);
  sstore(0);
  __syncthreads();
  for (int kt = 0; kt < nkt; kt++) {
    if (kt + 1 < nkt) gload(kt + 1);
    if (kt * 64 <= qw0) {
      const char* sK = smem + (kt & 1) * STAGE;
      const char* sV = sK + KSZ;
      const float* sF = (const float*)(sV + VSZ);
      const char* sKl = sK + r * 144 + h * 16;
      const char* sVl = sV + r * 136 + h * 8;
      f32x16 s[2];
#pragma unroll
      for (int mt = 0; mt < 2; mt++) {
#pragma unroll
        for (int q = 0; q < 16; q++) s[mt][q] = 0.f;
#pragma unroll
        for (int ks = 0; ks < 4; ks++) {
          bf16x8 a = *(const bf16x8*)(sKl + mt * (32 * 144) + ks * 32);
          s[mt] = MFMA32(a, qf[ks], s[mt]);
        }
      }
      if (HASF) {
#pragma unroll
        for (int mt = 0; mt < 2; mt++)
#pragma unroll
          for (int g = 0; g < 4; g++) {
            float4 f = *(const float4*)(sF + 32 * mt + 8 * g + 4 * h);
            s[mt][4 * g + 0] -= f.x;
            s[mt][4 * g + 1] -= f.y;
            s[mt][4 * g + 2] -= f.z;
            s[mt][4 * g + 3] -= f.w;
          }
      }
      if (kt * 64 + 63 > qw0) {
#pragma unroll
        for (int mt = 0; mt < 2; mt++)
#pragma unroll
          for (int q = 0; q < 16; q++) {
            int key = kt * 64 + 32 * mt + (q & 3) + 8 * (q >> 2) + 4 * h;
            s[mt][q] = key > qcol ? -INFINITY : s[mt][q];
          }
      }
      float mx = s[0][0];
#pragma unroll
      for (int mt = 0; mt < 2; mt++)
#pragma unroll
        for (int q = 0; q < 16; q++) mx = fmaxf(mx, s[mt][q]);
      mx = fmaxf(mx, __shfl_xor(mx, 32));
      const float m_new = fmaxf(m_run, mx);
      const float alpha = __builtin_amdgcn_exp2f(m_run - m_new);
      m_run = m_new;
      float ps = 0.f;
#pragma unroll
      for (int mt = 0; mt < 2; mt++)
#pragma unroll
        for (int q = 0; q < 16; q++) {
          float pv = __builtin_amdgcn_exp2f(s[mt][q] - m_new);
          s[mt][q] = pv;
          ps += pv;
        }
      lsum = lsum * alpha + ps;
#pragma unroll
      for (int mb = 0; mb < NMB; mb++)
#pragma unroll
        for (int q = 0; q < 16; q++) o[mb][q] *= alpha;
#pragma unroll
      for (int ks = 0; ks < 4; ks++) {
        const int mt = ks >> 1, q0r = 8 * (ks & 1);
        u32x4 pu;
        pu.x = pk2(s[mt][q0r + 0], s[mt][q0r + 1]);
        pu.y = pk2(s[mt][q0r + 2], s[mt][q0r + 3]);
        pu.z = pk2(s[mt][q0r + 4], s[mt][q0r + 5]);
        pu.w = pk2(s[mt][q0r + 6], s[mt][q0r + 7]);
        bf16x8 pb = __builtin_bit_cast(bf16x8, pu);
#pragma unroll
        for (int mb = 0; mb < NMB; mb++) {
          u32x2 lo = *(const u32x2*)(sVl + mb * (32 * 136) + ks * 32);
          u32x2 hi = *(const u32x2*)(sVl + mb * (32 * 136) + ks * 32 + 16);
          u32x4 au = {lo.x, lo.y, hi.x, hi.y};
          bf16x8 a = __builtin_bit_cast(bf16x8, au);
          o[mb] = MFMA32(a, pb, o[mb]);
        }
      }
    }
    if (kt + 1 < nkt) sstore((kt + 1) & 1);
    __syncthreads();
  }
  float l = lsum + __shfl_xor(lsum, 32);
  const float inv = 1.f / l;
#pragma unroll
  for (int mb = 0; mb < NMB; mb++)
#pragma unroll
    for (int q = 0; q < 16; q++) o[mb][q] *= inv;
}

DI void phase2(const Params& p, char* smem, int tid) {
  asm volatile("" : "+v"(tid));
  const int lane = tid & 63, w = tid >> 6, r = lane & 31, h = lane >> 5;
  __shared__ int s_item;
  float d1 = 0.f, d2 = 0.f;
  for (int i = 0; i < 64; i++) {
    d1 += p.lq1[i] * p.lk1[i];
    d2 += p.lq2[i] * p.lk2[i];
  }
  const float lam = expf(d1) - expf(d2) + 0.2f;
  for (;;) {
    __syncthreads();
    if (tid == 0) s_item = (int)atomicAdd(&p.counters()[0], 1u);
    __syncthreads();
    const int item = s_item;
    if (item >= 1536) break;
    if (item < 512) {
      const int qt = 15 - (item >> 5), bh = item & 31, b = bh >> 2, dh = bh & 3;
      const int q0 = qt * 128;
      const u16* Vtg = p.Vt() + ((size_t)(8 + b) * 512 + dh * 128) * SEQ;
      float* stash = p.stash() + ((size_t)blockIdx.x * NTHREADS + tid) * 64;
      f32x16 o[4];
#pragma unroll 1
      for (int c = 0; c < 2; c++) {
        const u16* Qg = p.QK() + ((size_t)(2 * 8 + b) * 8 + dh * 2 + c) * SEQ * 64;
        const u16* Kg = p.QK() + ((size_t)(3 * 8 + b) * 8 + dh * 2 + c) * SEQ * 64;
        attn_pass<128, false>(Qg, Kg, Vtg, nullptr, q0, smem, tid, o);
        if (c == 0) {
#pragma unroll
          for (int mb = 0; mb < 4; mb++)
#pragma unroll
            for (int q = 0; q < 4; q++)
              *(f32x4*)(stash + mb * 16 + q * 4) = f32x4{o[mb][4 * q], o[mb][4 * q + 1], o[mb][4 * q + 2], o[mb][4 * q + 3]};
        }
      }
      float ss = 0.f;
#pragma unroll
      for (int mb = 0; mb < 4; mb++)
#pragma unroll
        for (int q4 = 0; q4 < 4; q4++) {
          f32x4 sv = *(const f32x4*)(stash + mb * 16 + q4 * 4);
#pragma unroll
          for (int e = 0; e < 4; e++) {
            float a0 = sv[e] - lam * o[mb][4 * q4 + e];
            o[mb][4 * q4 + e] = a0;
            ss += a0 * a0;
          }
        }
      ss += __shfl_xor(ss, 32);
      const float rstd = rsqrtf(ss * (1.f / 128.f) + 1e-5f) * 0.8f;
      const int tok = b * SEQ + q0 + 32 * w + r;
#pragma unroll
      for (int mb = 0; mb < 4; mb++)
#pragma unroll
        for (int g = 0; g < 4; g++) {
          const int d = 32 * mb + 8 * g + 4 * h;
          float4 gs = *(const float4*)(p.g_subln + d);
          uint2 ov;
          ov.x = pk2(o[mb][4 * g + 0] * rstd * gs.x, o[mb][4 * g + 1] * rstd * gs.y);
          ov.y = pk2(o[mb][4 * g + 2] * rstd * gs.z, o[mb][4 * g + 3] * rstd * gs.w);
          *(uint2*)(p.H() + (size_t)tok * DM + 512 + dh * 128 + d) = ov;
        }
    } else {
      const int it = item - 512;
      const int qt = 15 - (it >> 6), bh = it & 63, b = bh >> 3, hd = bh & 7;
      const int q0 = qt * 128;
      const u16* Qg = p.QK() + ((size_t)(0 * 8 + b) * 8 + hd) * SEQ * 64;
      const u16* Kg = p.QK() + ((size_t)(1 * 8 + b) * 8 + hd) * SEQ * 64;
      const u16* Vtg = p.Vt() + ((size_t)(0 + b) * 512 + hd * 64) * SEQ;
      const float* FLg = p.FL() + (b * 8 + hd) * SEQ;
      f32x16 o[2];
      attn_pass<64, true>(Qg, Kg, Vtg, FLg, q0, smem, tid, o);
      const int tok = b * SEQ + q0 + 32 * w + r;
#pragma unroll
      for (int mb = 0; mb < 2; mb++)
#pragma unroll
        for (int g = 0; g < 4; g++) {
          const int d = 32 * mb + 8 * g + 4 * h;
          uint2 ov;
          ov.x = pk2(o[mb][4 * g + 0], o[mb][4 * g + 1]);
          ov.y = pk2(o[mb][4 * g + 2], o[mb][4 * g + 3]);
          *(uint2*)(p.H() + (size_t)tok * DM + hd * 64 + d) = ov;
        }
    }
  }
}

DI void phase3(const Params& p, char* smem, int tid) {
  asm volatile("" : "+v"(tid));
  const int lane = tid & 63, w = tid >> 6, wm = w & 1, wn = w >> 1, r = lane & 31, h = lane >> 5;
  for (int t = blockIdx.x; t < 128 * 8; t += gridDim.x) {
    const int nt = t & 7, mt = t >> 3;
    const int m0 = mt * 128, n0 = nt * 128;
    const int b = m0 >> 11;
    f32x16 acc[2][2];
    gemm_mainloop(p.WtO(), p.H(), n0, m0, smem, tid, acc);
#pragma unroll
    for (int j = 0; j < 2; j++) {
      const int tok = m0 + 64 * wn + 32 * j + r;
#pragma unroll
      for (int i = 0; i < 2; i++)
#pragma unroll
        for (int g = 0; g < 4; g++) {
          const int n = n0 + 64 * wm + 32 * i + 8 * g + 4 * h;
          float4 xv = *(const float4*)(p.x + (size_t)tok * DM + n);
          float4 gt = *(const float4*)(p.mod() + b * 6144 + 2048 + n);
          float4 ov;
          ov.x = xv.x + gt.x * acc[i][j][4 * g + 0];
          ov.y = xv.y + gt.y * acc[i][j][4 * g + 1];
          ov.z = xv.z + gt.z * acc[i][j][4 * g + 2];
          ov.w = xv.w + gt.w * acc[i][j][4 * g + 3];
          *(float4*)(p.out + (size_t)tok * DM + n) = ov;
        }
    }
  }
}

DI void phase3b(const Params& p, int tid) {
  asm volatile("" : "+v"(tid));
  const int lane = tid & 63, w = tid >> 6;
  for (int tok = blockIdx.x * 4 + w; tok < T_TOK; tok += gridDim.x * 4) {
    const int b = tok >> 11;
    const float* xr = p.out + (size_t)tok * DM;
    float4 xv[4];
    float ss = 0.f;
#pragma unroll
    for (int i = 0; i < 4; i++) {
      xv[i] = *(const float4*)(xr + 256 * i + 4 * lane);
      ss += xv[i].x * xv[i].x + xv[i].y * xv[i].y + xv[i].z * xv[i].z + xv[i].w * xv[i].w;
    }
    ss = wave_sum(ss);
    const float rstd = rsqrtf(ss * (1.f / 1024.f) + 1e-6f);
    const float* md = p.mod() + b * 6144;
#pragma unroll
    for (int i = 0; i < 4; i++) {
      const int c0 = 256 * i + 4 * lane;
      float4 g = *(const float4*)(p.g_ffn + c0);
      float4 sh = *(const float4*)(md + 3072 + c0);
      float4 sc = *(const float4*)(md + 4096 + c0);
      uint2 o;
      o.x = pk2(xv[i].x * rstd * g.x * (1.f + sc.x) + sh.x, xv[i].y * rstd * g.y * (1.f + sc.y) + sh.y);
      o.y = pk2(xv[i].z * rstd * g.z * (1.f + sc.z) + sh.z, xv[i].w * rstd * g.w * (1.f + sc.w) + sh.w);
      *(uint2*)(p.H() + (size_t)tok * DM + c0) = o;
    }
  }
}

DI void phase4(const Params& p, char* smem, int tid) {
  asm volatile("" : "+v"(tid));
  const int lane = tid & 63, w = tid >> 6, wm = w & 1, wn = w >> 1, r = lane & 31, h = lane >> 5;
  for (int t = blockIdx.x; t < 128 * 8; t += gridDim.x) {
    const int nt = t & 7, mt = t >> 3;
    const int m0 = mt * 128, n0 = nt * 128;
    f32x16 acc[2][2];
    gemm_mainloop(p.WtPq(), p.H(), n0, m0, smem, tid, acc);
#pragma unroll
    for (int j = 0; j < 2; j++) {
      const int tok = m0 + 64 * wn + 32 * j + r;
#pragma unroll
      for (int i = 0; i < 2; i++)
#pragma unroll
        for (int g = 0; g < 4; g++) {
          const int n = n0 + 64 * wm + 32 * i + 8 * g + 4 * h;
          uint2 o;
          o.x = pk2(acc[i][j][4 * g + 0], acc[i][j][4 * g + 1]);
          o.y = pk2(acc[i][j][4 * g + 2], acc[i][j][4 * g + 3]);
          *(uint2*)(p.Qp() + (size_t)tok * DM + n) = o;
        }
    }
  }
}

DI void top16_128(float v0, float v1, int lane, float& rv, int& ri) {
  rv = -INFINITY;
  ri = 0;
  for (int it = 0; it < 16; it++) {
    float m = wave_max(fmaxf(v0, v1));
    unsigned long long b0 = __ballot(v0 == m);
    unsigned long long b1 = __ballot(v1 == m);
    int idx;
    if (b0) {
      int l = __ffsll((long long)b0) - 1;
      idx = l;
      if (lane == l) v0 = -INFINITY;
    } else {
      int l = __ffsll((long long)b1) - 1;
      idx = l + 64;
      if (lane == l) v1 = -INFINITY;
    }
    if (lane == it) { rv = m; ri = idx; }
  }
}

template <int N>
struct TR {
  static DI float run(float (&part)[N], int lane) {
    constexpr int H = N / 2;
    float nxt[H];
    const bool up = (lane & H) != 0;
#pragma unroll
    for (int i = 0; i < H; i++) {
      float keep = up ? part[i + H] : part[i];
      float send = up ? part[i] : part[i + H];
      nxt[i] = keep + __shfl_xor(send, H);
    }
    return TR<H>::run(nxt, lane);
  }
};
template <>
struct TR<1> {
  static DI float run(float (&part)[1], int) { return part[0]; }
};

DI void phase5(const Params& p, char* smem, int tid) {
  asm volatile("" : "+v"(tid));
  const int lane = tid & 63, w = tid >> 6, r = lane & 31, h = lane >> 5;
  float* S = (float*)smem;
  bf16x8 skf[2][4];
#pragma unroll
  for (int c = 0; c < 2; c++)
#pragma unroll
    for (int ks = 0; ks < 4; ks++) {
      const float* src = p.sub_keys + ((size_t)c * 128 + 32 * w + r) * 64 + 16 * ks + 8 * h;
      float4 a = *(const float4*)src, b = *(const float4*)(src + 4);
      uint4 u = make_uint4(pk2(a.x, a.y), pk2(a.z, a.w), pk2(b.x, b.y), pk2(b.z, b.w));
      skf[c][ks] = __builtin_bit_cast(bf16x8, u);
    }
  int ci, cj;
  {
    const int offs[16] = {0, 16, 24, 29, 33, 36, 38, 40, 42, 43, 44, 45, 46, 47, 48, 49};
    int i = 0, off = 0;
#pragma unroll
    for (int q = 1; q < 16; q++)
      if (lane >= offs[q]) { i = q; off = offs[q]; }
    ci = i;
    cj = lane - off;
    if (lane >= 50) { ci = 0; cj = 0; }
  }
  for (int grp = blockIdx.x; grp < T_TOK / 4; grp += gridDim.x) {
    const int tok0 = grp * 4;
    __syncthreads();
    {
      const int tl = r >> 3, hd = r & 7;
#pragma unroll
      for (int c = 0; c < 2; c++) {
        f32x16 sc;
#pragma unroll
        for (int q = 0; q < 16; q++) sc[q] = 0.f;
#pragma unroll
        for (int ks = 0; ks < 4; ks++) {
          bf16x8 qb = *(const bf16x8*)(p.Qp() + (size_t)(tok0 + tl) * DM + hd * 128 + c * 64 + 16 * ks + 8 * h);
          sc = MFMA32(skf[c][ks], qb, sc);
        }
#pragma unroll
        for (int g = 0; g < 4; g++)
          *(float4*)(S + r * 260 + c * 128 + 32 * w + 8 * g + 4 * h) =
              make_float4(sc[4 * g + 0], sc[4 * g + 1], sc[4 * g + 2], sc[4 * g + 3]);
      }
    }
    __syncthreads();
    const int tok = tok0 + w;
    const int b = tok >> 11;
    int e_lo = 0, e_hi = 0;
    float g_lo = 0.f, g_hi = 0.f;
    for (int hd = 0; hd < 8; hd++) {
      const float* sr = S + (w * 8 + hd) * 260;
      float av, bv;
      int ai, bi;
      top16_128(sr[lane], sr[lane + 64], lane, av, ai);
      top16_128(sr[128 + lane], sr[128 + lane + 64], lane, bv, bi);
      float cv = __shfl(av, ci) + __shfl(bv, cj);
      int ce = __shfl(ai, ci) * 128 + __shfl(bi, cj);
      if (lane >= 50) cv = -INFINITY;
      float tv = -INFINITY;
      int te = 0;
      for (int it = 0; it < 16; it++) {
        float m = wave_max(cv);
        unsigned long long bm = __ballot(cv == m);
        int l = __ffsll((long long)bm) - 1;
        int e = __shfl(ce, l);
        if (lane == l) cv = -INFINITY;
        if (lane == it) { tv = m; te = e; }
      }
      float mx = __shfl(tv, 0);
      float ex = lane < 16 ? __expf(tv - mx) : 0.f;
      float sm = wave_sum(ex);
      float gg = ex / sm;
      float gsrc = __shfl(gg, lane & 15);
      int esrc = __shfl(te, lane & 15);
      if ((lane >> 4) == (hd & 3)) {
        if (hd < 4) { g_lo = gsrc; e_lo = esrc; }
        else { g_hi = gsrc; e_hi = esrc; }
      }
    }
    const u32x4 hq0 = *(const u32x4*)(p.H() + (size_t)tok * DM + 8 * lane);
    const u32x4 hq1 = *(const u32x4*)(p.H() + (size_t)tok * DM + 512 + 8 * lane);
    float w_lo = 0.f, w_hi = 0.f;
    float hf32[16];
#pragma unroll
    for (int q = 0; q < 4; q++) {
      hf32[2 * q] = bf_lo(hq0[q]); hf32[2 * q + 1] = bf_hi(hq0[q]);
      hf32[8 + 2 * q] = bf_lo(hq1[q]); hf32[8 + 2 * q + 1] = bf_hi(hq1[q]);
    }
    float acc[16];
#pragma unroll
    for (int i = 0; i < 16; i++) acc[i] = 0.f;
#pragma unroll 1
    for (int j = 0; j < 128; j++) {
      int e = j < 64 ? __builtin_amdgcn_readlane(e_lo, j & 63) : __builtin_amdgcn_readlane(e_hi, j & 63);
      float gj = __builtin_bit_cast(float, j < 64 ? __builtin_amdgcn_readlane(__builtin_bit_cast(int, g_lo), j & 63) : __builtin_amdgcn_readlane(__builtin_bit_cast(int, g_hi), j & 63));
      const float* ur = p.u_exp + (size_t)e * DM;
      float4 a0 = *(const float4*)(ur + 8 * lane), a1 = *(const float4*)(ur + 8 * lane + 4);
      float4 a2 = *(const float4*)(ur + 512 + 8 * lane), a3 = *(const float4*)(ur + 512 + 8 * lane + 4);
      float d = a0.x * hf32[0] + a0.y * hf32[1] + a0.z * hf32[2] + a0.w * hf32[3] + a1.x * hf32[4] + a1.y * hf32[5] + a1.z * hf32[6] + a1.w * hf32[7]
              + a2.x * hf32[8] + a2.y * hf32[9] + a2.z * hf32[10] + a2.w * hf32[11] + a3.x * hf32[12] + a3.y * hf32[13] + a3.z * hf32[14] + a3.w * hf32[15];
      d = wave_sum(d);
      float wj = 0.5f * d * (1.f + erff(d * 0.70710678118654752f)) * gj;
      const float* vr = p.v_exp + (size_t)e * DM;
      float4 b0 = *(const float4*)(vr + 8 * lane), b1 = *(const float4*)(vr + 8 * lane + 4);
      float4 b2 = *(const float4*)(vr + 512 + 8 * lane), b3 = *(const float4*)(vr + 512 + 8 * lane + 4);
      acc[0] += wj * b0.x; acc[1] += wj * b0.y; acc[2] += wj * b0.z; acc[3] += wj * b0.w;
      acc[4] += wj * b1.x; acc[5] += wj * b1.y; acc[6] += wj * b1.z; acc[7] += wj * b1.w;
      acc[8] += wj * b2.x; acc[9] += wj * b2.y; acc[10] += wj * b2.z; acc[11] += wj * b2.w;
      acc[12] += wj * b3.x; acc[13] += wj * b3.y; acc[14] += wj * b3.z; acc[15] += wj * b3.w;
    }
    float* orow = p.out + (size_t)tok * DM;
    const float* gt2 = p.mod() + b * 6144 + 5120;
    float x2[16];
    float ss = 0.f;
#pragma unroll
    for (int hf = 0; hf < 2; hf++)
#pragma unroll
      for (int q = 0; q < 2; q++) {
        const int c0 = 512 * hf + 8 * lane + 4 * q;
        float4 xv = *(const float4*)(orow + c0);
        float4 gt = *(const float4*)(gt2 + c0);
        float* a = acc + hf * 8 + q * 4;
        float* o = x2 + hf * 8 + q * 4;
        o[0] = xv.x + gt.x * a[0];
        o[1] = xv.y + gt.y * a[1];
        o[2] = xv.z + gt.z * a[2];
        o[3] = xv.w + gt.w * a[3];
        ss += o[0] * o[0] + o[1] * o[1] + o[2] * o[2] + o[3] * o[3];
      }
    ss = wave_sum(ss);
    const float rstd = rsqrtf(ss * (1.f / 1024.f) + 1e-6f);
#pragma unroll
    for (int hf = 0; hf < 2; hf++)
#pragma unroll
      for (int q = 0; q < 2; q++) {
        const int c0 = 512 * hf + 8 * lane + 4 * q;
        float4 gf = *(const float4*)(p.g_final + c0);
        float* o = x2 + hf * 8 + q * 4;
        *(float4*)(orow + c0) = make_float4(o[0] * rstd * gf.x, o[1] * rstd * gf.y, o[2] * rstd * gf.z, o[3] * rstd * gf.w);
      }
  }
}

__global__ void __launch_bounds__(NTHREADS, 2) fwd_megakernel(Params p) {
  __shared__ __attribute__((aligned(16))) char smem[SMEM_BYTES];
  cg::grid_group grid = cg::this_grid();
  const int tid = threadIdx.x;
  phase0(p, smem, tid);
  grid.sync();
  phase1a(p, smem, tid);
  grid.sync();
  phase_cumsum(p, smem, tid);
  phase1b(p, smem, tid);
  grid.sync();
  phase2(p, smem, tid);
  grid.sync();
  phase3(p, smem, tid);
  grid.sync();
  phase3b(p, tid);
  grid.sync();
  phase4(p, smem, tid);
  grid.sync();
  phase5(p, smem, tid);
}

extern "C" void kernel_launch(void* const* d_in, const int* in_sizes, int n_in, void* d_out, int out_size, void* d_ws,
                              size_t ws_size, hipStream_t stream) {
  static int grid_blocks = 0;
  if (!grid_blocks) {
    int dev = 0, cus = 0, per_cu = 0;
    hipGetDevice(&dev);
    hipDeviceGetAttribute(&cus, hipDeviceAttributeMultiprocessorCount, dev);
    hipOccupancyMaxActiveBlocksPerMultiprocessor(&per_cu, fwd_megakernel, NTHREADS, 0);
    if (per_cu > 2) per_cu = 2;
    if (per_cu < 1) per_cu = 1;
    grid_blocks = cus * per_cu;
  }
  Params p{};
  p.x = (const float*)d_in[0]; p.c = (const float*)d_in[1]; p.w_ada = (const float*)d_in[2]; p.b_ada = (const float*)d_in[3];
  p.g_attn = (const float*)d_in[4]; p.w_in = (const float*)d_in[5]; p.b_f = (const float*)d_in[6];
  p.lq1 = (const float*)d_in[7]; p.lk1 = (const float*)d_in[8]; p.lq2 = (const float*)d_in[9]; p.lk2 = (const float*)d_in[10];
  p.g_subln = (const float*)d_in[11]; p.w_o = (const float*)d_in[12]; p.g_ffn = (const float*)d_in[13];
  p.w_pq = (const float*)d_in[14]; p.sub_keys = (const float*)d_in[15]; p.u_exp = (const float*)d_in[16];
  p.v_exp = (const float*)d_in[17]; p.g_final = (const float*)d_in[18];
  p.out = (float*)d_out;
  p.ws = (char*)d_ws;
  void* args[] = {&p};
  hipError_t e = hipLaunchCooperativeKernel((void*)fwd_megakernel, dim3(grid_blocks), dim3(NTHREADS), args, 0, stream);
  if (e != hipSuccess) fprintf(stderr, "cooperative launch failed: %s (grid %d)\n", hipGetErrorString(e), grid_blocks);
}
```

```cpp
#include <hip/hip_runtime.h>
#include <hip/hip_cooperative_groups.h>
#include <cstdio>
namespace cg = cooperative_groups;

#define DI __device__ __forceinline__
typedef unsigned short u16;
using bf16x8 = __attribute__((ext_vector_type(8))) short;
using f32x16 = __attribute__((ext_vector_type(16))) float;
typedef __bf16 bf16x2_t __attribute__((ext_vector_type(2)));
typedef float f32x2_t __attribute__((ext_vector_type(2)));
using u32x4 = __attribute__((ext_vector_type(4))) unsigned;
using u32x2 = __attribute__((ext_vector_type(2))) unsigned;
using f32x4 = __attribute__((ext_vector_type(4))) float;

#define MFMA32(a, b, c) __builtin_amdgcn_mfma_f32_32x32x16_bf16((a), (b), (c), 0, 0, 0)

static constexpr int T_TOK = 16384;
static constexpr int SEQ = 2048;
static constexpr int DM = 1024;
static constexpr int INC = 3080;
static constexpr float LOG2E = 1.4426950408889634f;
static constexpr int NTHREADS = 256;
static constexpr int SMEM_BYTES = 65536;

struct Params {
  const float *x, *c, *w_ada, *b_ada, *g_attn, *w_in, *b_f, *lq1, *lk1, *lq2, *lk2, *g_subln, *w_o, *g_ffn, *w_pq,
      *sub_keys, *u_exp, *v_exp, *g_final;
  float* out;
  char* ws;
  static constexpr size_t MB = 1024 * 1024;
  DI u16* WtIn() const { return (u16*)(ws + 0 * MB); }
  DI u16* WtO() const { return (u16*)(ws + 6 * MB); }
  DI u16* WtPq() const { return (u16*)(ws + 8 * MB); }
  DI u16* Ub() const { return (u16*)(ws + 10 * MB); }
  DI u16* Vb() const { return (u16*)(ws + 42 * MB); }
  DI u16* H() const { return (u16*)(ws + 74 * MB); }
  DI u16* QK() const { return (u16*)(ws + 106 * MB); }
  DI u16* Vt() const { return (u16*)(ws + 170 * MB); }
  DI u16* Qp() const { return (u16*)(ws + 106 * MB); }
  DI float* mod() const { return (float*)(ws + 202 * MB); }
  DI float* rope() const { return (float*)(ws + 202 * MB + 256 * 1024); }
  DI float* logf() const { return (float*)(ws + 203 * MB); }
  DI float* FL() const { return (float*)(ws + 204 * MB); }
  DI unsigned* counters() const { return (unsigned*)(ws + 205 * MB); }
  DI float* stash() const { return (float*)(ws + 206 * MB); }
};

DI unsigned pk2(float a, float b) {
  f32x2_t v = {a, b};
  bf16x2_t r = __builtin_convertvector(v, bf16x2_t);
  return __builtin_bit_cast(unsigned, r);
}
DI float dot2bf(unsigned a, unsigned b, float c) {
  bf16x2_t x = __builtin_bit_cast(bf16x2_t, a);
  bf16x2_t y = __builtin_bit_cast(bf16x2_t, b);
  return __builtin_amdgcn_fdot2_f32_bf16(x, y, c, false);
}
DI float bf_lo(unsigned u) { return __uint_as_float(u << 16); }
DI float bf_hi(unsigned u) { return __uint_as_float(u & 0xffff0000u); }
DI float wave_sum(float v) {
#pragma unroll
  for (int o = 32; o >= 1; o >>= 1) v += __shfl_xor(v, o);
  return v;
}
DI float wave_max(float v) {
#pragma unroll
  for (int o = 32; o >= 1; o >>= 1) v = fmaxf(v, __shfl_xor(v, o));
  return v;
}

DI void transpose_tile(const float* __restrict__ src, int ld, int col0, int k0, u16* __restrict__ dst, int n0, char* smem,
                       int tid) {
  float* t = (float*)smem;
  __syncthreads();
  {
    int cc = tid & 63, r0 = tid >> 6;
#pragma unroll
    for (int i = 0; i < 16; i++) {
      int r = r0 + 4 * i;
      t[r * 65 + cc] = src[(size_t)(k0 + r) * ld + col0 + cc];
    }
  }
  __syncthreads();
#pragma unroll
  for (int i = 0; i < 2; i++) {
    int q = tid + 256 * i;
    int n = q >> 3, kc = q & 7;
    uint4 v;
    v.x = pk2(t[(8 * kc + 0) * 65 + n], t[(8 * kc + 1) * 65 + n]);
    v.y = pk2(t[(8 * kc + 2) * 65 + n], t[(8 * kc + 3) * 65 + n]);
    v.z = pk2(t[(8 * kc + 4) * 65 + n], t[(8 * kc + 5) * 65 + n]);
    v.w = pk2(t[(8 * kc + 6) * 65 + n], t[(8 * kc + 7) * 65 + n]);
    *(uint4*)(dst + (size_t)(n0 + n) * 1024 + k0 + 8 * kc) = v;
  }
}

DI void phase0(const Params& p, char* smem, int tid) {
  asm volatile("" : "+v"(tid));
  const int bid = blockIdx.x, nb = gridDim.x;
  if (bid == 0 && tid == 0) { p.counters()[0] = 0u; p.counters()[1] = 0u; }
  {
    float* sc = (float*)smem;
    float* red = (float*)(smem + 32768);
    bool loaded = false;
    for (int it = bid; it < 192; it += nb) {
      if (!loaded) {
        for (int i = tid; i < 8192; i += NTHREADS) {
          float v = p.c[i];
          sc[i] = v / (1.f + __expf(-v));
        }
        loaded = true;
      }
      __syncthreads();
      int col = it * 32 + (tid & 31), kg = tid >> 5;
      float acc[8];
#pragma unroll
      for (int b = 0; b < 8; b++) acc[b] = 0.f;
      for (int k = kg * 128; k < kg * 128 + 128; k++) {
        float w = p.w_ada[(size_t)k * 6144 + col];
#pragma unroll
        for (int b = 0; b < 8; b++) acc[b] += sc[b * 1024 + k] * w;
      }
#pragma unroll
      for (int b = 0; b < 8; b++) red[(kg * 8 + b) * 32 + (tid & 31)] = acc[b];
      __syncthreads();
      {
        int b = tid >> 5, cc = tid & 31;
        float s = 0.f;
#pragma unroll
        for (int g = 0; g < 8; g++) s += red[(g * 8 + b) * 32 + cc];
        p.mod()[b * 6144 + it * 32 + cc] = s + p.b_ada[it * 32 + cc];
      }
    }
    __syncthreads();
  }
  for (int it = bid; it < 1280; it += nb) {
    if (it < 768) {
      int nt = it >> 4, kt = it & 15;
      int n0 = nt * 64;
      int col0 = n0 < 1536 ? n0 : n0 + 8;
      transpose_tile(p.w_in, INC, col0, kt * 64, p.WtIn(), n0, smem, tid);
    } else if (it < 1024) {
      int j = it - 768;
      transpose_tile(p.w_o, 1024, (j >> 4) * 64, (j & 15) * 64, p.WtO(), (j >> 4) * 64, smem, tid);
    } else {
      int j = it - 1024;
      transpose_tile(p.w_pq, 1024, (j >> 4) * 64, (j & 15) * 64, p.WtPq(), (j >> 4) * 64, smem, tid);
    }
  }
  {
    const size_t ngroups = (size_t)16384 * 1024 / 8;
    for (size_t g = (size_t)bid * NTHREADS + tid; g < 2 * ngroups; g += (size_t)nb * NTHREADS) {
      const float* src = g < ngroups ? p.u_exp + g * 8 : p.v_exp + (g - ngroups) * 8;
      u16* dst = g < ngroups ? p.Ub() + g * 8 : p.Vb() + (g - ngroups) * 8;
      float4 a = *(const float4*)src, b = *(const float4*)(src + 4);
      uint4 v;
      v.x = pk2(a.x, a.y); v.y = pk2(a.z, a.w); v.z = pk2(b.x, b.y); v.w = pk2(b.z, b.w);
      *(uint4*)dst = v;
    }
  }
  for (int e = bid * NTHREADS + tid; e < 2048 * 8; e += nb * NTHREADS) {
    int pos = e >> 3, i = e & 7;
    const double invs[8] = {1.0, 0.19392274474868576, 0.03760603093086393, 0.007292664737217109,
                            0.001414213562373095, 0.0002742481756762073, 5.318295896944988e-05, 1.031338537721246e-05};
    double inv = invs[0];
#pragma unroll
    for (int q = 1; q < 8; q++) inv = (i == q) ? invs[q] : inv;
    double ang = (double)pos * inv;
    double t = ang * 0.15915494309189535;
    t -= rint(t);
    double r = t * 6.283185307179586;
    double r2 = r * r;
    double s = 1.0, c = 1.0;
#pragma unroll
    for (int n = 15; n >= 1; n--) {
      s = 1.0 - s * r2 * (1.0 / (double)((2 * n) * (2 * n + 1)));
      c = 1.0 - c * r2 * (1.0 / (double)((2 * n - 1) * (2 * n)));
    }
    s *= r;
    p.rope()[pos * 16 + i] = (float)c;
    p.rope()[pos * 16 + 8 + i] = (float)s;
  }
}

DI void phase1a(const Params& p, char* smem, int tid) {
  asm volatile("" : "+v"(tid));
  float* wfg = (float*)smem;
  __syncthreads();
  for (int i = tid; i < 8192; i += NTHREADS) {
    int k = i >> 3, j = i & 7;
    wfg[j * 1024 + k] = p.w_in[(size_t)k * INC + 1536 + j];
  }
  __syncthreads();
  const int lane = tid & 63, w = tid >> 6;
  for (int tok = blockIdx.x * 4 + w; tok < T_TOK; tok += gridDim.x * 4) {
    const int b = tok >> 11, s = tok & 2047;
    const float* xr = p.x + (size_t)tok * DM;
    float4 xv[4];
    float ss = 0.f;
#pragma unroll
    for (int i = 0; i < 4; i++) {
      xv[i] = *(const float4*)(xr + 256 * i + 4 * lane);
      ss += xv[i].x * xv[i].x + xv[i].y * xv[i].y + xv[i].z * xv[i].z + xv[i].w * xv[i].w;
    }
    ss = wave_sum(ss);
    const float rstd = rsqrtf(ss * (1.f / 1024.f) + 1e-6f);
    const float* md = p.mod() + b * 6144;
    float fg[8];
#pragma unroll
    for (int j = 0; j < 8; j++) fg[j] = 0.f;
#pragma unroll
    for (int i = 0; i < 4; i++) {
      const int c0 = 256 * i + 4 * lane;
      float4 g = *(const float4*)(p.g_attn + c0);
      float4 sh = *(const float4*)(md + c0);
      float4 sc = *(const float4*)(md + 1024 + c0);
      float4 h;
      h.x = xv[i].x * rstd * g.x * (1.f + sc.x) + sh.x;
      h.y = xv[i].y * rstd * g.y * (1.f + sc.y) + sh.y;
      h.z = xv[i].z * rstd * g.z * (1.f + sc.z) + sh.z;
      h.w = xv[i].w * rstd * g.w * (1.f + sc.w) + sh.w;
      uint2 o;
      o.x = pk2(h.x, h.y); o.y = pk2(h.z, h.w);
      *(uint2*)(p.H() + (size_t)tok * DM + c0) = o;
#pragma unroll
      for (int j = 0; j < 8; j++) {
        float4 wv = *(const float4*)(wfg + j * 1024 + c0);
        fg[j] += h.x * wv.x + h.y * wv.y + h.z * wv.z + h.w * wv.w;
      }
    }
#pragma unroll
    for (int j = 0; j < 8; j++) fg[j] = wave_sum(fg[j]);
    float z = fg[0];
#pragma unroll
    for (int j = 1; j < 8; j++) z = (lane == j) ? fg[j] : z;
    if (lane < 8) {
      z += p.b_f[lane];
      float ls = fminf(z, 0.f) - log1pf(__expf(-fabsf(z)));
      p.logf()[(b * 8 + lane) * SEQ + s] = ls;
    }
  }
}

DI void phase_cumsum(const Params& p, char* smem, int tid) {
  asm volatile("" : "+v"(tid));
  double* part = (double*)smem;
  for (int seq = blockIdx.x; seq < 64; seq += gridDim.x) {
    __syncthreads();
    const float* lf = p.logf() + seq * SEQ + tid * 8;
    float4 a = *(const float4*)lf, b = *(const float4*)(lf + 4);
    double v0 = a.x, v1 = v0 + a.y, v2 = v1 + a.z, v3 = v2 + a.w, v4 = v3 + b.x, v5 = v4 + b.y, v6 = v5 + b.z, v7 = v6 + b.w;
    double run = v7;
    part[tid] = run;
    __syncthreads();
    double pre = 0.0;
    for (int i = 0; i < tid; i++) pre += part[i];
    const double L2E = 1.4426950408889634;
    float* dst = p.FL() + seq * SEQ + tid * 8;
    *(float4*)dst = make_float4((float)((v0 + pre) * L2E), (float)((v1 + pre) * L2E), (float)((v2 + pre) * L2E), (float)((v3 + pre) * L2E));
    *(float4*)(dst + 4) = make_float4((float)((v4 + pre) * L2E), (float)((v5 + pre) * L2E), (float)((v6 + pre) * L2E), (float)((v7 + pre) * L2E));
  }
  __syncthreads();
}

DI void gemm_mainloop(const u16* __restrict__ Lg, const u16* __restrict__ Rg, int l0, int r0, char* smem, int tid,
                      f32x16 (&acc)[2][2]) {
  const int lane = tid & 63, w = tid >> 6;
  const int wm = w & 1, wn = w >> 1;
  const int r = lane & 31, h = lane >> 5;
  const int lc = tid & 7, lr = tid >> 3;
  const int sw = ((lr >> 1) & 7);
#pragma unroll
  for (int i = 0; i < 2; i++)
#pragma unroll
    for (int j = 0; j < 2; j++)
#pragma unroll
      for (int q = 0; q < 16; q++) acc[i][j][q] = 0.f;
  u32x4 ra[4], rb[4];
  const u16* lp = Lg + (size_t)(l0 + lr) * 1024 + lc * 8;
  const u16* rp = Rg + (size_t)(r0 + lr) * 1024 + lc * 8;
#pragma unroll
  for (int i = 0; i < 4; i++) {
    ra[i] = *(const u32x4*)(lp + (size_t)i * 32 * 1024);
    rb[i] = *(const u32x4*)(rp + (size_t)i * 32 * 1024);
  }
  __syncthreads();
  {
    char* sL = smem;
    char* sR = smem + 16384;
#pragma unroll
    for (int i = 0; i < 4; i++) {
      int off = (lr + 32 * i) * 128 + ((lc ^ sw) << 4);
      *(u32x4*)(sL + off) = ra[i];
      *(u32x4*)(sR + off) = rb[i];
    }
  }
  __syncthreads();
  for (int kt = 0; kt < 16; kt++) {
    const char* sL = smem + (kt & 1) * 32768;
    const char* sR = sL + 16384;
    if (kt + 1 < 16) {
#pragma unroll
      for (int i = 0; i < 4; i++) {
        ra[i] = *(const u32x4*)(lp + (size_t)i * 32 * 1024 + (kt + 1) * 64);
        rb[i] = *(const u32x4*)(rp + (size_t)i * 32 * 1024 + (kt + 1) * 64);
      }
    }
#pragma unroll
    for (int ks = 0; ks < 4; ks++) {
      bf16x8 a[2], b[2];
#pragma unroll
      for (int i = 0; i < 2; i++) {
        int row = 64 * wm + 32 * i + r;
        a[i] = *(const bf16x8*)(sL + row * 128 + (((2 * ks + h) ^ ((row >> 1) & 7)) << 4));
        int rowb = 64 * wn + 32 * i + r;
        b[i] = *(const bf16x8*)(sR + rowb * 128 + (((2 * ks + h) ^ ((rowb >> 1) & 7)) << 4));
      }
#pragma unroll
      for (int i = 0; i < 2; i++)
#pragma unroll
        for (int j = 0; j < 2; j++) acc[i][j] = MFMA32(a[i], b[j], acc[i][j]);
    }
    if (kt + 1 < 16) {
      char* dL = smem + ((kt + 1) & 1) * 32768;
      char* dR = dL + 16384;
#pragma unroll
      for (int i = 0; i < 4; i++) {
        int off = (lr + 32 * i) * 128 + ((lc ^ sw) << 4);
        *(u32x4*)(dL + off) = ra[i];
        *(u32x4*)(dR + off) = rb[i];
      }
    }
    __syncthreads();
  }
}

DI void phase1b(const Params& p, char* smem, int tid) {
  asm volatile("" : "+v"(tid));
  const int lane = tid & 63, w = tid >> 6, wm = w & 1, wn = w >> 1, r = lane & 31, h = lane >> 5;
  for (int t = blockIdx.x; t < 128 * 24; t += gridDim.x) {
    const int nt = t % 24, mt = t / 24;
    const int m0 = mt * 128, n0 = nt * 128;
    const int b = m0 >> 11, s0 = m0 & 2047;
    const int seg = nt >> 2;
    f32x16 acc[2][2];
    if (seg == 2 || seg == 5) {
      gemm_mainloop(p.H(), p.WtIn(), m0, n0, smem, tid, acc);
      const int kind = seg == 2 ? 0 : 1;
      const int colbase = n0 - (seg == 2 ? 1024 : 2560);
#pragma unroll
      for (int i = 0; i < 2; i++)
#pragma unroll
        for (int j = 0; j < 2; j++) {
          int col = colbase + 64 * wn + 32 * j + r;
          u16* dst = p.Vt() + ((size_t)(kind * 8 + b) * 512 + col) * SEQ + s0 + 64 * wm + 32 * i + 4 * h;
#pragma unroll
          for (int g = 0; g < 4; g++) {
            uint2 o;
            o.x = pk2(acc[i][j][4 * g + 0], acc[i][j][4 * g + 1]);
            o.y = pk2(acc[i][j][4 * g + 2], acc[i][j][4 * g + 3]);
            *(uint2*)(dst + 8 * g) = o;
          }
        }
    } else {
      gemm_mainloop(p.WtIn(), p.H(), n0, m0, smem, tid, acc);
      const int kind = seg == 0 ? 0 : seg == 1 ? 1 : seg == 3 ? 2 : 3;
      const int colbase = n0 - (seg == 0 ? 0 : seg == 1 ? 512 : seg == 3 ? 1536 : 2048);
      const bool rope = (seg >= 3);
      const float scale = (seg == 0 || seg == 3) ? 0.125f * LOG2E : 1.f;
#pragma unroll
      for (int j = 0; j < 2; j++) {
        const int s = s0 + 64 * wn + 32 * j + r;
        f32x4 cs = {1.f, 1.f, 1.f, 1.f}, sn = {0.f, 0.f, 0.f, 0.f};
        if (rope) {
          cs = *(const f32x4*)(p.rope() + s * 16 + 4 * h);
          sn = *(const f32x4*)(p.rope() + s * 16 + 8 + 4 * h);
        }
#pragma unroll
        for (int i = 0; i < 2; i++) {
          const int colt = colbase + 64 * wm + 32 * i;
          const int hc = colt >> 6, d0 = colt & 63;
          f32x16 v = acc[i][j];
          if (rope && i == 0) {
#pragma unroll
            for (int q = 0; q < 4; q++) {
              float t1 = v[q], t2 = v[q + 4];
              v[q] = t1 * cs[q] - t2 * sn[q];
              v[q + 4] = t2 * cs[q] + t1 * sn[q];
            }
          }
          u16* dst = p.QK() + (((size_t)(kind * 8 + b) * 8 + hc) * SEQ + s) * 64 + d0 + 4 * h;
#pragma unroll
          for (int g = 0; g < 4; g++) {
            uint2 o;
            o.x = pk2(v[4 * g + 0] * scale, v[4 * g + 1] * scale);
            o.y = pk2(v[4 * g + 2] * scale, v[4 * g + 3] * scale);
            *(uint2*)(dst + 8 * g) = o;
          }
        }
      }
    }
  }
}

template <int DV, bool HASF>
DI void attn_pass(const u16* __restrict__ Qg, const u16* __restrict__ Kg, const u16* __restrict__ Vtg,
                  const float* __restrict__ FLg, int q0, char* smem, int tid, f32x16 (&o)[DV / 32]) {
  constexpr int NMB = DV / 32;
  constexpr int KSZ = 64 * 144;
  constexpr int VSZ = DV * 136;
  constexpr int STAGE = KSZ + VSZ + 256;
  constexpr int NVL = DV / 32;
  const int lane = tid & 63, w = tid >> 6, r = lane & 31, h = lane >> 5;
  const int qw0 = q0 + 32 * w;
  const int qcol = qw0 + r;
  const int nkt = (q0 + 128) >> 6;
  bf16x8 qf[4];
#pragma unroll
  for (int ks = 0; ks < 4; ks++) qf[ks] = *(const bf16x8*)(Qg + (size_t)qcol * 64 + 16 * ks + 8 * h);
#pragma unroll
  for (int mb = 0; mb < NMB; mb++)
#pragma unroll
    for (int q = 0; q < 16; q++) o[mb][q] = 0.f;
  float m_run = -INFINITY, lsum = 0.f;

  u32x4 rk[2], rv[NVL];
  f32x4 rf = {0.f, 0.f, 0.f, 0.f};
  auto gload = [&](int kt) {
    const int k0 = kt * 64;
#pragma unroll
    for (int i = 0; i < 2; i++) {
      int idx = tid + 256 * i;
      rk[i] = *(const u32x4*)(Kg + (size_t)(k0 + (idx >> 3)) * 64 + (idx & 7) * 8);
    }
#pragma unroll
    for (int i = 0; i < NVL; i++) {
      int idx = tid + 256 * i;
      rv[i] = *(const u32x4*)(Vtg + (size_t)(idx >> 3) * SEQ + k0 + (idx & 7) * 8);
    }
    if (HASF) {
      if (tid < 16) rf = *(const f32x4*)(FLg + k0 + 4 * tid);
    }
  };
  auto sstore = [&](int stage) {
    char* sK = smem + stage * STAGE;
    char* sV = sK + KSZ;
    float* sF = (float*)(sV + VSZ);
#pragma unroll
    for (int i = 0; i < 2; i++) {
      int idx = tid + 256 * i;
      int row = idx >> 3, c = idx & 7;
      *(u32x4*)(sK + row * 144 + (c << 4)) = rk[i];
    }
#pragma unroll
    for (int i = 0; i < NVL; i++) {
      int idx = tid + 256 * i;
      int row = idx >> 3, c = idx & 7;
      *(u32x2*)(sV + row * 136 + (c << 4)) = u32x2{rv[i].x, rv[i].y};
      *(u32x2*)(sV + row * 136 + (c << 4) + 8) = u32x2{rv[i].z, rv[i].w};
    }
    if (HASF) {
      if (tid < 16) *(f32x4*)(sF + 4 * tid) = rf;
    }
  };

  __syncthreads();
  gload(0);
  sstore(0);
  __syncthreads();
  for (int kt = 0; kt < nkt; kt++) {
    if (kt + 1 < nkt) gload(kt + 1);
    if (kt * 64 <= qw0) {
      const char* sK = smem + (kt & 1) * STAGE;
      const char* sV = sK + KSZ;
      const float* sF = (const float*)(sV + VSZ);
      const char* sKl = sK + r * 144 + h * 16;
      const char* sVl = sV + r * 136 + h * 8;
      f32x16 s[2];
#pragma unroll
      for (int mt = 0; mt < 2; mt++) {
#pragma unroll
        for (int q = 0; q < 16; q++) s[mt][q] = 0.f;
#pragma unroll
        for (int ks = 0; ks < 4; ks++) {
          bf16x8 a = *(const bf16x8*)(sKl + mt * (32 * 144) + ks * 32);
          s[mt] = MFMA32(a, qf[ks], s[mt]);
        }
      }
      if (HASF) {
#pragma unroll
        for (int mt = 0; mt < 2; mt++)
#pragma unroll
          for (int g = 0; g < 4; g++) {
            float4 f = *(const float4*)(sF + 32 * mt + 8 * g + 4 * h);
            s[mt][4 * g + 0] -= f.x;
            s[mt][4 * g + 1] -= f.y;
            s[mt][4 * g + 2] -= f.z;
            s[mt][4 * g + 3] -= f.w;
          }
      }
      if (kt * 64 + 63 > qw0) {
#pragma unroll
        for (int mt = 0; mt < 2; mt++)
#pragma unroll
          for (int q = 0; q < 16; q++) {
            int key = kt * 64 + 32 * mt + (q & 3) + 8 * (q >> 2) + 4 * h;
            s[mt][q] = key > qcol ? -INFINITY : s[mt][q];
          }
      }
      float mx = s[0][0];
#pragma unroll
      for (int mt = 0; mt < 2; mt++)
#pragma unroll
        for (int q = 0; q < 16; q++) mx = fmaxf(mx, s[mt][q]);
      mx = fmaxf(mx, __shfl_xor(mx, 32));
      const float m_new = fmaxf(m_run, mx);
      const float alpha = __builtin_amdgcn_exp2f(m_run - m_new);
      m_run = m_new;
      float ps = 0.f;
#pragma unroll
      for (int mt = 0; mt < 2; mt++)
#pragma unroll
        for (int q = 0; q < 16; q++) {
          float pv = __builtin_amdgcn_exp2f(s[mt][q] - m_new);
          s[mt][q] = pv;
          ps += pv;
        }
      lsum = lsum * alpha + ps;
#pragma unroll
      for (int mb = 0; mb < NMB; mb++)
#pragma unroll
        for (int q = 0; q < 16; q++) o[mb][q] *= alpha;
#pragma unroll
      for (int ks = 0; ks < 4; ks++) {
        const int mt = ks >> 1, q0r = 8 * (ks & 1);
        u32x4 pu;
        pu.x = pk2(s[mt][q0r + 0], s[mt][q0r + 1]);
        pu.y = pk2(s[mt][q0r + 2], s[mt][q0r + 3]);
        pu.z = pk2(s[mt][q0r + 4], s[mt][q0r + 5]);
        pu.w = pk2(s[mt][q0r + 6], s[mt][q0r + 7]);
        bf16x8 pb = __builtin_bit_cast(bf16x8, pu);
#pragma unroll
        for (int mb = 0; mb < NMB; mb++) {
          u32x2 lo = *(const u32x2*)(sVl + mb * (32 * 136) + ks * 32);
          u32x2 hi = *(const u32x2*)(sVl + mb * (32 * 136) + ks * 32 + 16);
          u32x4 au = {lo.x, lo.y, hi.x, hi.y};
          bf16x8 a = __builtin_bit_cast(bf16x8, au);
          o[mb] = MFMA32(a, pb, o[mb]);
        }
      }
    }
    if (kt + 1 < nkt) sstore((kt + 1) & 1);
    __syncthreads();
  }
  float l = lsum + __shfl_xor(lsum, 32);
  const float inv = 1.f / l;
#pragma unroll
  for (int mb = 0; mb < NMB; mb++)
#pragma unroll
    for (int q = 0; q < 16; q++) o[mb][q] *= inv;
}

DI void phase2(const Params& p, char* smem, int tid) {
  asm volatile("" : "+v"(tid));
  const int lane = tid & 63, w = tid >> 6, r = lane & 31, h = lane >> 5;
  __shared__ int s_item;
  float d1 = 0.f, d2 = 0.f;
  for (int i = 0; i < 64; i++) {
    d1 += p.lq1[i] * p.lk1[i];
    d2 += p.lq2[i] * p.lk2[i];
  }
  const float lam = expf(d1) - expf(d2) + 0.2f;
  for (;;) {
    __syncthreads();
    if (tid == 0) s_item = (int)atomicAdd(&p.counters()[0], 1u);
    __syncthreads();
    const int item = s_item;
    if (item >= 1536) break;
    if (item < 512) {
      const int qt = 15 - (item >> 5), bh = item & 31, b = bh >> 2, dh = bh & 3;
      const int q0 = qt * 128;
      const u16* Vtg = p.Vt() + ((size_t)(8 + b) * 512 + dh * 128) * SEQ;
      float* stash = p.stash() + ((size_t)blockIdx.x * NTHREADS + tid) * 64;
      f32x16 o[4];
#pragma unroll 1
      for (int c = 0; c < 2; c++) {
        const u16* Qg = p.QK() + ((size_t)(2 * 8 + b) * 8 + dh * 2 + c) * SEQ * 64;
        const u16* Kg = p.QK() + ((size_t)(3 * 8 + b) * 8 + dh * 2 + c) * SEQ * 64;
        attn_pass<128, false>(Qg, Kg, Vtg, nullptr, q0, smem, tid, o);
        if (c == 0) {
#pragma unroll
          for (int mb = 0; mb < 4; mb++)
#pragma unroll
            for (int q = 0; q < 4; q++)
              *(f32x4*)(stash + mb * 16 + q * 4) = f32x4{o[mb][4 * q], o[mb][4 * q + 1], o[mb][4 * q + 2], o[mb][4 * q + 3]};
        }
      }
      float ss = 0.f;
#pragma unroll
      for (int mb = 0; mb < 4; mb++)
#pragma unroll
        for (int q4 = 0; q4 < 4; q4++) {
          f32x4 sv = *(const f32x4*)(stash + mb * 16 + q4 * 4);
#pragma unroll
          for (int e = 0; e < 4; e++) {
            float a0 = sv[e] - lam * o[mb][4 * q4 + e];
            o[mb][4 * q4 + e] = a0;
            ss += a0 * a0;
          }
        }
      ss += __shfl_xor(ss, 32);
      const float rstd = rsqrtf(ss * (1.f / 128.f) + 1e-5f) * 0.8f;
      const int tok = b * SEQ + q0 + 32 * w + r;
#pragma unroll
      for (int mb = 0; mb < 4; mb++)
#pragma unroll
        for (int g = 0; g < 4; g++) {
          const int d = 32 * mb + 8 * g + 4 * h;
          float4 gs = *(const float4*)(p.g_subln + d);
          uint2 ov;
          ov.x = pk2(o[mb][4 * g + 0] * rstd * gs.x, o[mb][4 * g + 1] * rstd * gs.y);
          ov.y = pk2(o[mb][4 * g + 2] * rstd * gs.z, o[mb][4 * g + 3] * rstd * gs.w);
          *(uint2*)(p.H() + (size_t)tok * DM + 512 + dh * 128 + d) = ov;
        }
    } else {
      const int it = item - 512;
      const int qt = 15 - (it >> 6), bh = it & 63, b = bh >> 3, hd = bh & 7;
      const int q0 = qt * 128;
      const u16* Qg = p.QK() + ((size_t)(0 * 8 + b) * 8 + hd) * SEQ * 64;
      const u16* Kg = p.QK() + ((size_t)(1 * 8 + b) * 8 + hd) * SEQ * 64;
      const u16* Vtg = p.Vt() + ((size_t)(0 + b) * 512 + hd * 64) * SEQ;
      const float* FLg = p.FL() + (b * 8 + hd) * SEQ;
      f32x16 o[2];
      attn_pass<64, true>(Qg, Kg, Vtg, FLg, q0, smem, tid, o);
      const int tok = b * SEQ + q0 + 32 * w + r;
#pragma unroll
      for (int mb = 0; mb < 2; mb++)
#pragma unroll
        for (int g = 0; g < 4; g++) {
          const int d = 32 * mb + 8 * g + 4 * h;
          uint2 ov;
          ov.x = pk2(o[mb][4 * g + 0], o[mb][4 * g + 1]);
          ov.y = pk2(o[mb][4 * g + 2], o[mb][4 * g + 3]);
          *(uint2*)(p.H() + (size_t)tok * DM + hd * 64 + d) = ov;
        }
    }
  }
}

DI void phase3(const Params& p, char* smem, int tid) {
  asm volatile("" : "+v"(tid));
  const int lane = tid & 63, w = tid >> 6, wm = w & 1, wn = w >> 1, r = lane & 31, h = lane >> 5;
  for (int t = blockIdx.x; t < 128 * 8; t += gridDim.x) {
    const int nt = t & 7, mt = t >> 3;
    const int m0 = mt * 128, n0 = nt * 128;
    const int b = m0 >> 11;
    f32x16 acc[2][2];
    gemm_mainloop(p.WtO(), p.H(), n0, m0, smem, tid, acc);
#pragma unroll
    for (int j = 0; j < 2; j++) {
      const int tok = m0 + 64 * wn + 32 * j + r;
#pragma unroll
      for (int i = 0; i < 2; i++)
#pragma unroll
        for (int g = 0; g < 4; g++) {
          const int n = n0 + 64 * wm + 32 * i + 8 * g + 4 * h;
          float4 xv = *(const float4*)(p.x + (size_t)tok * DM + n);
          float4 gt = *(const float4*)(p.mod() + b * 6144 + 2048 + n);
          float4 ov;
          ov.x = xv.x + gt.x * acc[i][j][4 * g + 0];
          ov.y = xv.y + gt.y * acc[i][j][4 * g + 1];
          ov.z = xv.z + gt.z * acc[i][j][4 * g + 2];
          ov.w = xv.w + gt.w * acc[i][j][4 * g + 3];
          *(float4*)(p.out + (size_t)tok * DM + n) = ov;
        }
    }
  }
}

DI void phase3b(const Params& p, int tid) {
  asm volatile("" : "+v"(tid));
  const int lane = tid & 63, w = tid >> 6;
  for (int tok = blockIdx.x * 4 + w; tok < T_TOK; tok += gridDim.x * 4) {
    const int b = tok >> 11;
    const float* xr = p.out + (size_t)tok * DM;
    float4 xv[4];
    float ss = 0.f;
#pragma unroll
    for (int i = 0; i < 4; i++) {
      xv[i] = *(const float4*)(xr + 256 * i + 4 * lane);
      ss += xv[i].x * xv[i].x + xv[i].y * xv[i].y + xv[i].z * xv[i].z + xv[i].w * xv[i].w;
    }
    ss = wave_sum(ss);
    const float rstd = rsqrtf(ss * (1.f / 1024.f) + 1e-6f);
    const float* md = p.mod() + b * 6144;
#pragma unroll
    for (int i = 0; i < 4; i++) {
      const int c0 = 256 * i + 4 * lane;
      float4 g = *(const float4*)(p.g_ffn + c0);
      float4 sh = *(const float4*)(md + 3072 + c0);
      float4 sc = *(const float4*)(md + 4096 + c0);
      uint2 o;
      o.x = pk2(xv[i].x * rstd * g.x * (1.f + sc.x) + sh.x, xv[i].y * rstd * g.y * (1.f + sc.y) + sh.y);
      o.y = pk2(xv[i].z * rstd * g.z * (1.f + sc.z) + sh.z, xv[i].w * rstd * g.w * (1.f + sc.w) + sh.w);
      *(uint2*)(p.H() + (size_t)tok * DM + c0) = o;
    }
  }
}

DI void phase4(const Params& p, char* smem, int tid) {
  asm volatile("" : "+v"(tid));
  const int lane = tid & 63, w = tid >> 6, wm = w & 1, wn = w >> 1, r = lane & 31, h = lane >> 5;
  for (int t = blockIdx.x; t < 128 * 8; t += gridDim.x) {
    const int nt = t & 7, mt = t >> 3;
    const int m0 = mt * 128, n0 = nt * 128;
    f32x16 acc[2][2];
    gemm_mainloop(p.WtPq(), p.H(), n0, m0, smem, tid, acc);
#pragma unroll
    for (int j = 0; j < 2; j++) {
      const int tok = m0 + 64 * wn + 32 * j + r;
#pragma unroll
      for (int i = 0; i < 2; i++)
#pragma unroll
        for (int g = 0; g < 4; g++) {
          const int n = n0 + 64 * wm + 32 * i + 8 * g + 4 * h;
          uint2 o;
          o.x = pk2(acc[i][j][4 * g + 0], acc[i][j][4 * g + 1]);
          o.y = pk2(acc[i][j][4 * g + 2], acc[i][j][4 * g + 3]);
          *(uint2*)(p.Qp() + (size_t)tok * DM + n) = o;
        }
    }
  }
}

DI void top16_128(float v0, float v1, int lane, float& rv, int& ri) {
  rv = -INFINITY;
  ri = 0;
  for (int it = 0; it < 16; it++) {
    float m = wave_max(fmaxf(v0, v1));
    unsigned long long b0 = __ballot(v0 == m);
    unsigned long long b1 = __ballot(v1 == m);
    int idx;
    if (b0) {
      int l = __ffsll((long long)b0) - 1;
      idx = l;
      if (lane == l) v0 = -INFINITY;
    } else {
      int l = __ffsll((long long)b1) - 1;
      idx = l + 64;
      if (lane == l) v1 = -INFINITY;
    }
    if (lane == it) { rv = m; ri = idx; }
  }
}

template <int N>
struct TR {
  static DI float run(float (&part)[N], int lane) {
    constexpr int H = N / 2;
    float nxt[H];
    const bool up = (lane & H) != 0;
#pragma unroll
    for (int i = 0; i < H; i++) {
      float keep = up ? part[i + H] : part[i];
      float send = up ? part[i] : part[i + H];
      nxt[i] = keep + __shfl_xor(send, H);
    }
    return TR<H>::run(nxt, lane);
  }
};
template <>
struct TR<1> {
  static DI float run(float (&part)[1], int) { return part[0]; }
};

DI void phase5(const Params& p, char* smem, int tid) {
  asm volatile("" : "+v"(tid));
  const int lane = tid & 63, w = tid >> 6, r = lane & 31, h = lane >> 5;
  float* S = (float*)smem;
  bf16x8 skf[2][4];
#pragma unroll
  for (int c = 0; c < 2; c++)
#pragma unroll
    for (int ks = 0; ks < 4; ks++) {
      const float* src = p.sub_keys + ((size_t)c * 128 + 32 * w + r) * 64 + 16 * ks + 8 * h;
      float4 a = *(const float4*)src, b = *(const float4*)(src + 4);
      uint4 u = make_uint4(pk2(a.x, a.y), pk2(a.z, a.w), pk2(b.x, b.y), pk2(b.z, b.w));
      skf[c][ks] = __builtin_bit_cast(bf16x8, u);
    }
  int ci, cj;
  {
    const int offs[16] = {0, 16, 24, 29, 33, 36, 38, 40, 42, 43, 44, 45, 46, 47, 48, 49};
    int i = 0, off = 0;
#pragma unroll
    for (int q = 1; q < 16; q++)
      if (lane >= offs[q]) { i = q; off = offs[q]; }
    ci = i;
    cj = lane - off;
    if (lane >= 50) { ci = 0; cj = 0; }
  }
  for (int grp = blockIdx.x; grp < T_TOK / 4; grp += gridDim.x) {
    const int tok0 = grp * 4;
    __syncthreads();
    {
      const int tl = r >> 3, hd = r & 7;
#pragma unroll
      for (int c = 0; c < 2; c++) {
        f32x16 sc;
#pragma unroll
        for (int q = 0; q < 16; q++) sc[q] = 0.f;
#pragma unroll
        for (int ks = 0; ks < 4; ks++) {
          bf16x8 qb = *(const bf16x8*)(p.Qp() + (size_t)(tok0 + tl) * DM + hd * 128 + c * 64 + 16 * ks + 8 * h);
          sc = MFMA32(skf[c][ks], qb, sc);
        }
#pragma unroll
        for (int g = 0; g < 4; g++)
          *(float4*)(S + r * 260 + c * 128 + 32 * w + 8 * g + 4 * h) =
              make_float4(sc[4 * g + 0], sc[4 * g + 1], sc[4 * g + 2], sc[4 * g + 3]);
      }
    }
    __syncthreads();
    const int tok = tok0 + w;
    const int b = tok >> 11;
    int e_lo = 0, e_hi = 0;
    float g_lo = 0.f, g_hi = 0.f;
    for (int hd = 0; hd < 8; hd++) {
      const float* sr = S + (w * 8 + hd) * 260;
      float av, bv;
      int ai, bi;
      top16_128(sr[lane], sr[lane + 64], lane, av, ai);
      top16_128(sr[128 + lane], sr[128 + lane + 64], lane, bv, bi);
      float cv = __shfl(av, ci) + __shfl(bv, cj);
      int ce = __shfl(ai, ci) * 128 + __shfl(bi, cj);
      if (lane >= 50) cv = -INFINITY;
      float tv = -INFINITY;
      int te = 0;
      for (int it = 0; it < 16; it++) {
        float m = wave_max(cv);
        unsigned long long bm = __ballot(cv == m);
        int l = __ffsll((long long)bm) - 1;
        int e = __shfl(ce, l);
        if (lane == l) cv = -INFINITY;
        if (lane == it) { tv = m; te = e; }
      }
      float mx = __shfl(tv, 0);
      float ex = lane < 16 ? __expf(tv - mx) : 0.f;
      float sm = wave_sum(ex);
      float gg = ex / sm;
      float gsrc = __shfl(gg, lane & 15);
      int esrc = __shfl(te, lane & 15);
      if ((lane >> 4) == (hd & 3)) {
        if (hd < 4) { g_lo = gsrc; e_lo = esrc; }
        else { g_hi = gsrc; e_hi = esrc; }
      }
    }
    const u32x4 hq0 = *(const u32x4*)(p.H() + (size_t)tok * DM + 8 * lane);
    const u32x4 hq1 = *(const u32x4*)(p.H() + (size_t)tok * DM + 512 + 8 * lane);
    float w_lo = 0.f, w_hi = 0.f;
#pragma unroll
    for (int half = 0; half < 2; half++) {
      const int esel = half ? e_hi : e_lo;
      float aslot = 0.f;
#pragma unroll 1
      for (int jb = 0; jb < 8; jb++) {
        u32x4 u0[8], u1[8];
#pragma unroll
        for (int jj = 0; jj < 8; jj++) {
          int e = __builtin_amdgcn_readlane(esel, jb * 8 + jj);
          const u16* row = p.Ub() + (size_t)e * DM;
          u0[jj] = *(const u32x4*)(row + 8 * lane);
          u1[jj] = *(const u32x4*)(row + 512 + 8 * lane);
        }
        float part[8];
#pragma unroll
        for (int jj = 0; jj < 8; jj++) {
          float a = 0.f;
#pragma unroll
          for (int q = 0; q < 4; q++) {
            const unsigned ua = u0[jj][q], ub = u1[jj][q], ha = hq0[q], hb = hq1[q];
            a = dot2bf(ua, ha, a);
            a = dot2bf(ub, hb, a);
          }
          part[jj] = a;
        }
        float v = TR<8>::run(part, lane);
        v += __shfl_xor(v, 8);
        v += __shfl_xor(v, 16);
        v += __shfl_xor(v, 32);
        if ((lane >> 3) == jb) aslot = v;
      }
      float ge = 0.5f * aslot * (1.f + erff(aslot * 0.70710678118654752f));
      if (half) w_hi = ge * g_hi; else w_lo = ge * g_lo;
    }
    float acc[16];
#pragma unroll
    for (int i = 0; i < 16; i++) acc[i] = 0.f;
#pragma unroll
    for (int half = 0; half < 2; half++) {
      const int esel = half ? e_hi : e_lo;
      const int wsel = __builtin_bit_cast(int, half ? w_hi : w_lo);
#pragma unroll 1
      for (int jb = 0; jb < 8; jb++) {
        u32x4 u0[8], u1[8];
#pragma unroll
        for (int jj = 0; jj < 8; jj++) {
          int e = __builtin_amdgcn_readlane(esel, jb * 8 + jj);
          const u16* row = p.Vb() + (size_t)e * DM;
          u0[jj] = *(const u32x4*)(row + 8 * lane);
          u1[jj] = *(const u32x4*)(row + 512 + 8 * lane);
        }
#pragma unroll
        for (int jj = 0; jj < 8; jj++) {
          float wj = __builtin_bit_cast(float, __builtin_amdgcn_readlane(wsel, jb * 8 + jj));
#pragma unroll
          for (int q = 0; q < 4; q++) {
            acc[2 * q] += wj * bf_lo(u0[jj][q]);
            acc[2 * q + 1] += wj * bf_hi(u0[jj][q]);
            acc[8 + 2 * q] += wj * bf_lo(u1[jj][q]);
            acc[8 + 2 * q + 1] += wj * bf_hi(u1[jj][q]);
          }
        }
      }
    }
    float* orow = p.out + (size_t)tok * DM;
    const float* gt2 = p.mod() + b * 6144 + 5120;
    float x2[16];
    float ss = 0.f;
#pragma unroll
    for (int hf = 0; hf < 2; hf++)
#pragma unroll
      for (int q = 0; q < 2; q++) {
        const int c0 = 512 * hf + 8 * lane + 4 * q;
        float4 xv = *(const float4*)(orow + c0);
        float4 gt = *(const float4*)(gt2 + c0);
        float* a = acc + hf * 8 + q * 4;
        float* o = x2 + hf * 8 + q * 4;
        o[0] = xv.x + gt.x * a[0];
        o[1] = xv.y + gt.y * a[1];
        o[2] = xv.z + gt.z * a[2];
        o[3] = xv.w + gt.w * a[3];
        ss += o[0] * o[0] + o[1] * o[1] + o[2] * o[2] + o[3] * o[3];
      }
    ss = wave_sum(ss);
    const float rstd = rsqrtf(ss * (1.f / 1024.f) + 1e-6f);
#pragma unroll
    for (int hf = 0; hf < 2; hf++)
#pragma unroll
      for (int q = 0; q < 2; q++) {
        const int c0 = 512 * hf + 8 * lane + 4 * q;
        float4 gf = *(const float4*)(p.g_final + c0);
        float* o = x2 + hf * 8 + q * 4;
        *(float4*)(orow + c0) = make_float4(o[0] * rstd * gf.x, o[1] * rstd * gf.y, o[2] * rstd * gf.z, o[3] * rstd * gf.w);
      }
  }
}

__global__ void __launch_bounds__(NTHREADS, 2) fwd_megakernel(Params p) {
  __shared__ __attribute__((aligned(16))) char smem[SMEM_BYTES];
  cg::grid_group grid = cg::this_grid();
  const int tid = threadIdx.x;
  phase0(p, smem, tid);
  grid.sync();
  phase1a(p, smem, tid);
  grid.sync();
  phase_cumsum(p, smem, tid);
  phase1b(p, smem, tid);
  grid.sync();
  phase2(p, smem, tid);
  grid.sync();
  phase3(p, smem, tid);
  grid.sync();
  phase3b(p, tid);
  grid.sync();
  phase4(p, smem, tid);
  grid.sync();
  phase5(p, smem, tid);
}

extern "C" void kernel_launch(void* const* d_in, const int* in_sizes, int n_in, void* d_out, int out_size, void* d_ws,
                              size_t ws_size, hipStream_t stream) {
  static int grid_blocks = 0;
  if (!grid_blocks) {
    int dev = 0, cus = 0, per_cu = 0;
    hipGetDevice(&dev);
    hipDeviceGetAttribute(&cus, hipDeviceAttributeMultiprocessorCount, dev);
    hipOccupancyMaxActiveBlocksPerMultiprocessor(&per_cu, fwd_megakernel, NTHREADS, 0);
    if (per_cu > 2) per_cu = 2;
    if (per_cu < 1) per_cu = 1;
    grid_blocks = cus * per_cu;
  }
  Params p{};
  p.x = (const float*)d_in[0]; p.c = (const float*)d_in[1]; p.w_ada = (const float*)d_in[2]; p.b_ada = (const float*)d_in[3];
  p.g_attn = (const float*)d_in[4]; p.w_in = (const float*)d_in[5]; p.b_f = (const float*)d_in[6];
  p.lq1 = (const float*)d_in[7]; p.lk1 = (const float*)d_in[8]; p.lq2 = (const float*)d_in[9]; p.lk2 = (const float*)d_in[10];
  p.g_subln = (const float*)d_in[11]; p.w_o = (const float*)d_in[12]; p.g_ffn = (const float*)d_in[13];
  p.w_pq = (const float*)d_in[14]; p.sub_keys = (const float*)d_in[15]; p.u_exp = (const float*)d_in[16];
  p.v_exp = (const float*)d_in[17]; p.g_final = (const float*)d_in[18];
  p.out = (float*)d_out;
  p.ws = (char*)d_ws;
  void* args[] = {&p};
  hipError_t e = hipLaunchCooperativeKernel((void*)fwd_megakernel, dim3(grid_blocks), dim3(NTHREADS), args, 0, stream);
  if (e != hipSuccess) fprintf(stderr, "cooperative launch failed: %s (grid %d)\n", hipGetErrorString(e), grid_blocks);
}
```

```cpp
#include <hip/hip_runtime.h>
#include <hip/hip_cooperative_groups.h>
#include <cstdio>
namespace cg = cooperative_groups;

#define DI __device__ __forceinline__
typedef unsigned short u16;
using bf16x8 = __attribute__((ext_vector_type(8))) short;
using f32x16 = __attribute__((ext_vector_type(16))) float;
typedef __bf16 bf16x2_t __attribute__((ext_vector_type(2)));
typedef float f32x2_t __attribute__((ext_vector_type(2)));
using u32x4 = __attribute__((ext_vector_type(4))) unsigned;
using u32x2 = __attribute__((ext_vector_type(2))) unsigned;
using f32x4 = __attribute__((ext_vector_type(4))) float;

#define MFMA32(a, b, c) __builtin_amdgcn_mfma_f32_32x32x16_bf16((a), (b), (c), 0, 0, 0)

static constexpr int T_TOK = 16384;
static constexpr int SEQ = 2048;
static constexpr int DM = 1024;
static constexpr int INC = 3080;
static constexpr float LOG2E = 1.4426950408889634f;
static constexpr int NTHREADS = 256;
static constexpr int SMEM_BYTES = 70656;

struct Params {
  const float *x, *c, *w_ada, *b_ada, *g_attn, *w_in, *b_f, *lq1, *lk1, *lq2, *lk2, *g_subln, *w_o, *g_ffn, *w_pq,
      *sub_keys, *u_exp, *v_exp, *g_final;
  float* out;
  char* ws;
  static constexpr size_t MB = 1024 * 1024;
  DI u16* WtIn() const { return (u16*)(ws + 0 * MB); }
  DI u16* WtO() const { return (u16*)(ws + 6 * MB); }
  DI u16* WtPq() const { return (u16*)(ws + 8 * MB); }
  DI unsigned char* Uq() const { return (unsigned char*)(ws + 10 * MB); }
  DI unsigned char* Vq() const { return (unsigned char*)(ws + 42 * MB); }
  DI u16* H() const { return (u16*)(ws + 74 * MB); }
  DI u16* QK() const { return (u16*)(ws + 106 * MB); }
  DI u16* Vt() const { return (u16*)(ws + 170 * MB); }
  DI u16* Qp() const { return (u16*)(ws + 106 * MB); }
  DI float* mod() const { return (float*)(ws + 202 * MB); }
  DI float* rope() const { return (float*)(ws + 202 * MB + 256 * 1024); }
  DI float* logf() const { return (float*)(ws + 203 * MB); }
  DI float* FL() const { return (float*)(ws + 204 * MB); }
  DI unsigned* counters() const { return (unsigned*)(ws + 205 * MB); }
  DI float* stash() const { return (float*)(ws + 206 * MB); }
};

DI unsigned pk2(float a, float b) {
  f32x2_t v = {a, b};
  bf16x2_t r = __builtin_convertvector(v, bf16x2_t);
  return __builtin_bit_cast(unsigned, r);
}
DI float dot2bf(unsigned a, unsigned b, float c) {
  bf16x2_t x = __builtin_bit_cast(bf16x2_t, a);
  bf16x2_t y = __builtin_bit_cast(bf16x2_t, b);
  return __builtin_amdgcn_fdot2_f32_bf16(x, y, c, false);
}
DI float bf_lo(unsigned u) { return __uint_as_float(u << 16); }
DI float bf_hi(unsigned u) { return __uint_as_float(u & 0xffff0000u); }
DI float wave_sum(float v) {
#pragma unroll
  for (int o = 32; o >= 1; o >>= 1) v += __shfl_xor(v, o);
  return v;
}
DI float wave_max(float v) {
#pragma unroll
  for (int o = 32; o >= 1; o >>= 1) v = fmaxf(v, __shfl_xor(v, o));
  return v;
}

DI void transpose_tile(const float* __restrict__ src, int ld, int col0, int k0, u16* __restrict__ dst, int n0, char* smem,
                       int tid) {
  float* t = (float*)smem;
  __syncthreads();
  {
    int cc = tid & 63, r0 = tid >> 6;
#pragma unroll
    for (int i = 0; i < 16; i++) {
      int r = r0 + 4 * i;
      t[r * 65 + cc] = src[(size_t)(k0 + r) * ld + col0 + cc];
    }
  }
  __syncthreads();
#pragma unroll
  for (int i = 0; i < 2; i++) {
    int q = tid + 256 * i;
    int n = q >> 3, kc = q & 7;
    uint4 v;
    v.x = pk2(t[(8 * kc + 0) * 65 + n], t[(8 * kc + 1) * 65 + n]);
    v.y = pk2(t[(8 * kc + 2) * 65 + n], t[(8 * kc + 3) * 65 + n]);
    v.z = pk2(t[(8 * kc + 4) * 65 + n], t[(8 * kc + 5) * 65 + n]);
    v.w = pk2(t[(8 * kc + 6) * 65 + n], t[(8 * kc + 7) * 65 + n]);
    *(uint4*)(dst + (size_t)(n0 + n) * 1024 + k0 + 8 * kc) = v;
  }
}

DI void phase0(const Params& p, char* smem, int tid) {
  asm volatile("" : "+v"(tid));
  const int bid = blockIdx.x, nb = gridDim.x;
  if (bid == 0 && tid == 0) { p.counters()[0] = 0u; p.counters()[1] = 0u; }
  {
    float* sc = (float*)smem;
    float* red = (float*)(smem + 32768);
    bool loaded = false;
    for (int it = bid; it < 192; it += nb) {
      if (!loaded) {
        for (int i = tid; i < 8192; i += NTHREADS) {
          float v = p.c[i];
          sc[i] = v / (1.f + __expf(-v));
        }
        loaded = true;
      }
      __syncthreads();
      int col = it * 32 + (tid & 31), kg = tid >> 5;
      float acc[8];
#pragma unroll
      for (int b = 0; b < 8; b++) acc[b] = 0.f;
      for (int k = kg * 128; k < kg * 128 + 128; k++) {
        float w = p.w_ada[(size_t)k * 6144 + col];
#pragma unroll
        for (int b = 0; b < 8; b++) acc[b] += sc[b * 1024 + k] * w;
      }
#pragma unroll
      for (int b = 0; b < 8; b++) red[(kg * 8 + b) * 32 + (tid & 31)] = acc[b];
      __syncthreads();
      {
        int b = tid >> 5, cc = tid & 31;
        float s = 0.f;
#pragma unroll
        for (int g = 0; g < 8; g++) s += red[(g * 8 + b) * 32 + cc];
        p.mod()[b * 6144 + it * 32 + cc] = s + p.b_ada[it * 32 + cc];
      }
    }
    __syncthreads();
  }
  for (int it = bid; it < 1280; it += nb) {
    if (it < 768) {
      int nt = it >> 4, kt = it & 15;
      int n0 = nt * 64;
      int col0 = n0 < 1536 ? n0 : n0 + 8;
      transpose_tile(p.w_in, INC, col0, kt * 64, p.WtIn(), n0, smem, tid);
    } else if (it < 1024) {
      int j = it - 768;
      transpose_tile(p.w_o, 1024, (j >> 4) * 64, (j & 15) * 64, p.WtO(), (j >> 4) * 64, smem, tid);
    } else {
      int j = it - 1024;
      transpose_tile(p.w_pq, 1024, (j >> 4) * 64, (j & 15) * 64, p.WtPq(), (j >> 4) * 64, smem, tid);
    }
  }
  {
    const size_t ngroups = (size_t)16384 * 1024 / 16;
    for (size_t g = (size_t)bid * NTHREADS + tid; g < 2 * ngroups; g += (size_t)nb * NTHREADS) {
      const bool isu = g < ngroups;
      const float* src = isu ? p.u_exp + g * 16 : p.v_exp + (g - ngroups) * 16;
      unsigned char* dst = isu ? p.Uq() + g * 16 : p.Vq() + (g - ngroups) * 16;
      const float sc = isu ? 64.f : 8.f;
      u32x4 v;
#pragma unroll
      for (int q = 0; q < 4; q++) {
        float4 a = *(const float4*)(src + 4 * q);
        unsigned wv = 0;
        wv = __builtin_amdgcn_cvt_pk_fp8_f32(a.x * sc, a.y * sc, wv, false);
        wv = __builtin_amdgcn_cvt_pk_fp8_f32(a.z * sc, a.w * sc, wv, true);
        v[q] = wv;
      }
      *(u32x4*)dst = v;
    }
  }
  for (int e = bid * NTHREADS + tid; e < 2048 * 8; e += nb * NTHREADS) {
    int pos = e >> 3, i = e & 7;
    const double invs[8] = {1.0, 0.19392274474868576, 0.03760603093086393, 0.007292664737217109,
                            0.001414213562373095, 0.0002742481756762073, 5.318295896944988e-05, 1.031338537721246e-05};
    double inv = invs[0];
#pragma unroll
    for (int q = 1; q < 8; q++) inv = (i == q) ? invs[q] : inv;
    double ang = (double)pos * inv;
    double t = ang * 0.15915494309189535;
    t -= rint(t);
    double r = t * 6.283185307179586;
    double r2 = r * r;
    double s = 1.0, c = 1.0;
#pragma unroll
    for (int n = 15; n >= 1; n--) {
      s = 1.0 - s * r2 * (1.0 / (double)((2 * n) * (2 * n + 1)));
      c = 1.0 - c * r2 * (1.0 / (double)((2 * n - 1) * (2 * n)));
    }
    s *= r;
    p.rope()[pos * 16 + i] = (float)c;
    p.rope()[pos * 16 + 8 + i] = (float)s;
  }
}

DI void phase1a(const Params& p, char* smem, int tid) {
  asm volatile("" : "+v"(tid));
  float* wfg = (float*)smem;
  __syncthreads();
  for (int i = tid; i < 8192; i += NTHREADS) {
    int k = i >> 3, j = i & 7;
    wfg[j * 1024 + k] = p.w_in[(size_t)k * INC + 1536 + j];
  }
  __syncthreads();
  const int lane = tid & 63, w = tid >> 6;
  for (int tok = blockIdx.x * 4 + w; tok < T_TOK; tok += gridDim.x * 4) {
    const int b = tok >> 11, s = tok & 2047;
    const float* xr = p.x + (size_t)tok * DM;
    float4 xv[4];
    float ss = 0.f;
#pragma unroll
    for (int i = 0; i < 4; i++) {
      xv[i] = *(const float4*)(xr + 256 * i + 4 * lane);
      ss += xv[i].x * xv[i].x + xv[i].y * xv[i].y + xv[i].z * xv[i].z + xv[i].w * xv[i].w;
    }
    ss = wave_sum(ss);
    const float rstd = rsqrtf(ss * (1.f / 1024.f) + 1e-6f);
    const float* md = p.mod() + b * 6144;
    float fg[8];
#pragma unroll
    for (int j = 0; j < 8; j++) fg[j] = 0.f;
#pragma unroll
    for (int i = 0; i < 4; i++) {
      const int c0 = 256 * i + 4 * lane;
      float4 g = *(const float4*)(p.g_attn + c0);
      float4 sh = *(const float4*)(md + c0);
      float4 sc = *(const float4*)(md + 1024 + c0);
      float4 h;
      h.x = xv[i].x * rstd * g.x * (1.f + sc.x) + sh.x;
      h.y = xv[i].y * rstd * g.y * (1.f + sc.y) + sh.y;
      h.z = xv[i].z * rstd * g.z * (1.f + sc.z) + sh.z;
      h.w = xv[i].w * rstd * g.w * (1.f + sc.w) + sh.w;
      uint2 o;
      o.x = pk2(h.x, h.y); o.y = pk2(h.z, h.w);
      *(uint2*)(p.H() + (size_t)tok * DM + c0) = o;
#pragma unroll
      for (int j = 0; j < 8; j++) {
        float4 wv = *(const float4*)(wfg + j * 1024 + c0);
        fg[j] += h.x * wv.x + h.y * wv.y + h.z * wv.z + h.w * wv.w;
      }
    }
#pragma unroll
    for (int j = 0; j < 8; j++) fg[j] = wave_sum(fg[j]);
    float z = fg[0];
#pragma unroll
    for (int j = 1; j < 8; j++) z = (lane == j) ? fg[j] : z;
    if (lane < 8) {
      z += p.b_f[lane];
      float ls = fminf(z, 0.f) - log1pf(__expf(-fabsf(z)));
      p.logf()[(b * 8 + lane) * SEQ + s] = ls;
    }
  }
}

DI void phase_cumsum(const Params& p, char* smem, int tid) {
  asm volatile("" : "+v"(tid));
  double* part = (double*)smem;
  for (int seq = blockIdx.x; seq < 64; seq += gridDim.x) {
    __syncthreads();
    const float* lf = p.logf() + seq * SEQ + tid * 8;
    float4 a = *(const float4*)lf, b = *(const float4*)(lf + 4);
    double v0 = a.x, v1 = v0 + a.y, v2 = v1 + a.z, v3 = v2 + a.w, v4 = v3 + b.x, v5 = v4 + b.y, v6 = v5 + b.z, v7 = v6 + b.w;
    double run = v7;
    part[tid] = run;
    __syncthreads();
    double pre = 0.0;
    for (int i = 0; i < tid; i++) pre += part[i];
    const double L2E = 1.4426950408889634;
    float* dst = p.FL() + seq * SEQ + tid * 8;
    *(float4*)dst = make_float4((float)((v0 + pre) * L2E), (float)((v1 + pre) * L2E), (float)((v2 + pre) * L2E), (float)((v3 + pre) * L2E));
    *(float4*)(dst + 4) = make_float4((float)((v4 + pre) * L2E), (float)((v5 + pre) * L2E), (float)((v6 + pre) * L2E), (float)((v7 + pre) * L2E));
  }
  __syncthreads();
}

DI void gemm_mainloop(const u16* __restrict__ Lg, const u16* __restrict__ Rg, int l0, int r0, char* smem, int tid,
                      f32x16 (&acc)[2][2]) {
  const int lane = tid & 63, w = tid >> 6;
  const int wm = w & 1, wn = w >> 1;
  const int r = lane & 31, h = lane >> 5;
  const int lc = tid & 7, lr = tid >> 3;
  const int sw = ((lr >> 1) & 7);
#pragma unroll
  for (int i = 0; i < 2; i++)
#pragma unroll
    for (int j = 0; j < 2; j++)
#pragma unroll
      for (int q = 0; q < 16; q++) acc[i][j][q] = 0.f;
  u32x4 ra[4], rb[4];
  const u16* lp = Lg + (size_t)(l0 + lr) * 1024 + lc * 8;
  const u16* rp = Rg + (size_t)(r0 + lr) * 1024 + lc * 8;
#pragma unroll
  for (int i = 0; i < 4; i++) {
    ra[i] = *(const u32x4*)(lp + (size_t)i * 32 * 1024);
    rb[i] = *(const u32x4*)(rp + (size_t)i * 32 * 1024);
  }
  __syncthreads();
  {
    char* sL = smem;
    char* sR = smem + 16384;
#pragma unroll
    for (int i = 0; i < 4; i++) {
      int off = (lr + 32 * i) * 128 + ((lc ^ sw) << 4);
      *(u32x4*)(sL + off) = ra[i];
      *(u32x4*)(sR + off) = rb[i];
    }
  }
  __syncthreads();
  for (int kt = 0; kt < 16; kt++) {
    const char* sL = smem + (kt & 1) * 32768;
    const char* sR = sL + 16384;
    if (kt + 1 < 16) {
#pragma unroll
      for (int i = 0; i < 4; i++) {
        ra[i] = *(const u32x4*)(lp + (size_t)i * 32 * 1024 + (kt + 1) * 64);
        rb[i] = *(const u32x4*)(rp + (size_t)i * 32 * 1024 + (kt + 1) * 64);
      }
    }
#pragma unroll
    for (int ks = 0; ks < 4; ks++) {
      bf16x8 a[2], b[2];
#pragma unroll
      for (int i = 0; i < 2; i++) {
        int row = 64 * wm + 32 * i + r;
        a[i] = *(const bf16x8*)(sL + row * 128 + (((2 * ks + h) ^ ((row >> 1) & 7)) << 4));
        int rowb = 64 * wn + 32 * i + r;
        b[i] = *(const bf16x8*)(sR + rowb * 128 + (((2 * ks + h) ^ ((rowb >> 1) & 7)) << 4));
      }
#pragma unroll
      for (int i = 0; i < 2; i++)
#pragma unroll
        for (int j = 0; j < 2; j++) acc[i][j] = MFMA32(a[i], b[j], acc[i][j]);
    }
    if (kt + 1 < 16) {
      char* dL = smem + ((kt + 1) & 1) * 32768;
      char* dR = dL + 16384;
#pragma unroll
      for (int i = 0; i < 4; i++) {
        int off = (lr + 32 * i) * 128 + ((lc ^ sw) << 4);
        *(u32x4*)(dL + off) = ra[i];
        *(u32x4*)(dR + off) = rb[i];
      }
    }
    __syncthreads();
  }
}

DI void phase1b(const Params& p, char* smem, int tid) {
  asm volatile("" : "+v"(tid));
  const int lane = tid & 63, w = tid >> 6, wm = w & 1, wn = w >> 1, r = lane & 31, h = lane >> 5;
  for (int t = blockIdx.x; t < 128 * 24; t += gridDim.x) {
    const int nt = t % 24, mt = t / 24;
    const int m0 = mt * 128, n0 = nt * 128;
    const int b = m0 >> 11, s0 = m0 & 2047;
    const int seg = nt >> 2;
    f32x16 acc[2][2];
    if (seg == 2 || seg == 5) {
      gemm_mainloop(p.H(), p.WtIn(), m0, n0, smem, tid, acc);
      const int kind = seg == 2 ? 0 : 1;
      const int colbase = n0 - (seg == 2 ? 1024 : 2560);
#pragma unroll
      for (int i = 0; i < 2; i++)
#pragma unroll
        for (int j = 0; j < 2; j++) {
          int col = colbase + 64 * wn + 32 * j + r;
          u16* dst = p.Vt() + ((size_t)(kind * 8 + b) * 512 + col) * SEQ + s0 + 64 * wm + 32 * i + 4 * h;
#pragma unroll
          for (int g = 0; g < 4; g++) {
            uint2 o;
            o.x = pk2(acc[i][j][4 * g + 0], acc[i][j][4 * g + 1]);
            o.y = pk2(acc[i][j][4 * g + 2], acc[i][j][4 * g + 3]);
            *(uint2*)(dst + 8 * g) = o;
          }
        }
    } else {
      gemm_mainloop(p.WtIn(), p.H(), n0, m0, smem, tid, acc);
      const int kind = seg == 0 ? 0 : seg == 1 ? 1 : seg == 3 ? 2 : 3;
      const int colbase = n0 - (seg == 0 ? 0 : seg == 1 ? 512 : seg == 3 ? 1536 : 2048);
      const bool rope = (seg >= 3);
      const float scale = (seg == 0 || seg == 3) ? 0.125f * LOG2E : 1.f;
#pragma unroll
      for (int j = 0; j < 2; j++) {
        const int s = s0 + 64 * wn + 32 * j + r;
        f32x4 cs = {1.f, 1.f, 1.f, 1.f}, sn = {0.f, 0.f, 0.f, 0.f};
        if (rope) {
          cs = *(const f32x4*)(p.rope() + s * 16 + 4 * h);
          sn = *(const f32x4*)(p.rope() + s * 16 + 8 + 4 * h);
        }
#pragma unroll
        for (int i = 0; i < 2; i++) {
          const int colt = colbase + 64 * wm + 32 * i;
          const int hc = colt >> 6, d0 = colt & 63;
          f32x16 v = acc[i][j];
          if (rope && i == 0) {
#pragma unroll
            for (int q = 0; q < 4; q++) {
              float t1 = v[q], t2 = v[q + 4];
              v[q] = t1 * cs[q] - t2 * sn[q];
              v[q + 4] = t2 * cs[q] + t1 * sn[q];
            }
          }
          u16* dst = p.QK() + (((size_t)(kind * 8 + b) * 8 + hc) * SEQ + s) * 64 + d0 + 4 * h;
#pragma unroll
          for (int g = 0; g < 4; g++) {
            uint2 o;
            o.x = pk2(v[4 * g + 0] * scale, v[4 * g + 1] * scale);
            o.y = pk2(v[4 * g + 2] * scale, v[4 * g + 3] * scale);
            *(uint2*)(dst + 8 * g) = o;
          }
        }
      }
    }
  }
}

template <int DV, bool HASF>
DI void attn_pass(const u16* __restrict__ Qg, const u16* __restrict__ Kg, const u16* __restrict__ Vtg,
                  const float* __restrict__ FLg, int q0, char* smem, int tid, f32x16 (&o)[DV / 32]) {
  constexpr int NMB = DV / 32;
  constexpr int KSZ = 64 * 144;
  constexpr int VSZ = DV * 136;
  constexpr int STAGE = KSZ + VSZ + 256;
  constexpr int NVL = DV / 32;
  const int lane = tid & 63, w = tid >> 6, r = lane & 31, h = lane >> 5;
  const int qw0 = q0 + 32 * w;
  const int qcol = qw0 + r;
  const int nkt = (q0 + 128) >> 6;
  bf16x8 qf[4];
#pragma unroll
  for (int ks = 0; ks < 4; ks++) qf[ks] = *(const bf16x8*)(Qg + (size_t)qcol * 64 + 16 * ks + 8 * h);
#pragma unroll
  for (int mb = 0; mb < NMB; mb++)
#pragma unroll
    for (int q = 0; q < 16; q++) o[mb][q] = 0.f;
  float m_run = -INFINITY, lsum = 0.f;

  u32x4 rk[2], rv[NVL];
  f32x4 rf = {0.f, 0.f, 0.f, 0.f};
  auto gload = [&](int kt) {
    const int k0 = kt * 64;
#pragma unroll
    for (int i = 0; i < 2; i++) {
      int idx = tid + 256 * i;
      rk[i] = *(const u32x4*)(Kg + (size_t)(k0 + (idx >> 3)) * 64 + (idx & 7) * 8);
    }
#pragma unroll
    for (int i = 0; i < NVL; i++) {
      int idx = tid + 256 * i;
      rv[i] = *(const u32x4*)(Vtg + (size_t)(idx >> 3) * SEQ + k0 + (idx & 7) * 8);
    }
    if (HASF) {
      if (tid < 16) rf = *(const f32x4*)(FLg + k0 + 4 * tid);
    }
  };
  auto sstore = [&](int stage) {
    char* sK = smem + stage * STAGE;
    char* sV = sK + KSZ;
    float* sF = (float*)(sV + VSZ);
#pragma unroll
    for (int i = 0; i < 2; i++) {
      int idx = tid + 256 * i;
      int row = idx >> 3, c = idx & 7;
      *(u32x4*)(sK + row * 144 + (c << 4)) = rk[i];
    }
#pragma unroll
    for (int i = 0; i < NVL; i++) {
      int idx = tid + 256 * i;
      int row = idx >> 3, c = idx & 7;
      *(u32x2*)(sV + row * 136 + (c << 4)) = u32x2{rv[i].x, rv[i].y};
      *(u32x2*)(sV + row * 136 + (c << 4) + 8) = u32x2{rv[i].z, rv[i].w};
    }
    if (HASF) {
      if (tid < 16) *(f32x4*)(sF + 4 * tid) = rf;
    }
  };

  __syncthreads();
  gload(0);
  sstore(0);
  __syncthreads();
  for (int kt = 0; kt < nkt; kt++) {
    if (kt + 1 < nkt) gload(kt + 1);
    if (kt * 64 <= qw0) {
      const char* sK = smem + (kt & 1) * STAGE;
      const char* sV = sK + KSZ;
      const float* sF = (const float*)(sV + VSZ);
      const char* sKl = sK + r * 144 + h * 16;
      const char* sVl = sV + r * 136 + h * 8;
      f32x16 s[2];
#pragma unroll
      for (int mt = 0; mt < 2; mt++) {
#pragma unroll
        for (int q = 0; q < 16; q++) s[mt][q] = 0.f;
#pragma unroll
        for (int ks = 0; ks < 4; ks++) {
          bf16x8 a = *(const bf16x8*)(sKl + mt * (32 * 144) + ks * 32);
          s[mt] = MFMA32(a, qf[ks], s[mt]);
        }
      }
      if (HASF) {
#pragma unroll
        for (int mt = 0; mt < 2; mt++)
#pragma unroll
          for (int g = 0; g < 4; g++) {
            float4 f = *(const float4*)(sF + 32 * mt + 8 * g + 4 * h);
            s[mt][4 * g + 0] -= f.x;
            s[mt][4 * g + 1] -= f.y;
            s[mt][4 * g + 2] -= f.z;
            s[mt][4 * g + 3] -= f.w;
          }
      }
      if (kt * 64 + 63 > qw0) {
#pragma unroll
        for (int mt = 0; mt < 2; mt++)
#pragma unroll
          for (int q = 0; q < 16; q++) {
            int key = kt * 64 + 32 * mt + (q & 3) + 8 * (q >> 2) + 4 * h;
            s[mt][q] = key > qcol ? -INFINITY : s[mt][q];
          }
      }
      float mx = s[0][0];
#pragma unroll
      for (int mt = 0; mt < 2; mt++)
#pragma unroll
        for (int q = 0; q < 16; q++) mx = fmaxf(mx, s[mt][q]);
      mx = fmaxf(mx, __shfl_xor(mx, 32));
      const float m_new = fmaxf(m_run, mx);
      const float alpha = __builtin_amdgcn_exp2f(m_run - m_new);
      m_run = m_new;
      float ps = 0.f;
#pragma unroll
      for (int mt = 0; mt < 2; mt++)
#pragma unroll
        for (int q = 0; q < 16; q++) {
          float pv = __builtin_amdgcn_exp2f(s[mt][q] - m_new);
          s[mt][q] = pv;
          ps += pv;
        }
      lsum = lsum * alpha + ps;
#pragma unroll
      for (int mb = 0; mb < NMB; mb++)
#pragma unroll
        for (int q = 0; q < 16; q++) o[mb][q] *= alpha;
#pragma unroll
      for (int ks = 0; ks < 4; ks++) {
        const int mt = ks >> 1, q0r = 8 * (ks & 1);
        u32x4 pu;
        pu.x = pk2(s[mt][q0r + 0], s[mt][q0r + 1]);
        pu.y = pk2(s[mt][q0r + 2], s[mt][q0r + 3]);
        pu.z = pk2(s[mt][q0r + 4], s[mt][q0r + 5]);
        pu.w = pk2(s[mt][q0r + 6], s[mt][q0r + 7]);
        bf16x8 pb = __builtin_bit_cast(bf16x8, pu);
#pragma unroll
        for (int mb = 0; mb < NMB; mb++) {
          u32x2 lo = *(const u32x2*)(sVl + mb * (32 * 136) + ks * 32);
          u32x2 hi = *(const u32x2*)(sVl + mb * (32 * 136) + ks * 32 + 16);
          u32x4 au = {lo.x, lo.y, hi.x, hi.y};
          bf16x8 a = __builtin_bit_cast(bf16x8, au);
          o[mb] = MFMA32(a, pb, o[mb]);
        }
      }
    }
    if (kt + 1 < nkt) sstore((kt + 1) & 1);
    __syncthreads();
  }
  float l = lsum + __shfl_xor(lsum, 32);
  const float inv = 1.f / l;
#pragma unroll
  for (int mb = 0; mb < NMB; mb++)
#pragma unroll
    for (int q = 0; q < 16; q++) o[mb][q] *= inv;
}

DI void phase2(const Params& p, char* smem, int tid) {
  asm volatile("" : "+v"(tid));
  const int lane = tid & 63, w = tid >> 6, r = lane & 31, h = lane >> 5;
  __shared__ int s_item;
  float d1 = 0.f, d2 = 0.f;
  for (int i = 0; i < 64; i++) {
    d1 += p.lq1[i] * p.lk1[i];
    d2 += p.lq2[i] * p.lk2[i];
  }
  const float lam = expf(d1) - expf(d2) + 0.2f;
  for (;;) {
    __syncthreads();
    if (tid == 0) s_item = (int)atomicAdd(&p.counters()[0], 1u);
    __syncthreads();
    const int item = s_item;
    if (item >= 1536) break;
    if (item < 512) {
      const int qt = 15 - (item >> 5), bh = item & 31, b = bh >> 2, dh = bh & 3;
      const int q0 = qt * 128;
      const u16* Vtg = p.Vt() + ((size_t)(8 + b) * 512 + dh * 128) * SEQ;
      float* stash = p.stash() + ((size_t)blockIdx.x * NTHREADS + tid) * 64;
      f32x16 o[4];
#pragma unroll 1
      for (int c = 0; c < 2; c++) {
        const u16* Qg = p.QK() + ((size_t)(2 * 8 + b) * 8 + dh * 2 + c) * SEQ * 64;
        const u16* Kg = p.QK() + ((size_t)(3 * 8 + b) * 8 + dh * 2 + c) * SEQ * 64;
        attn_pass<128, false>(Qg, Kg, Vtg, nullptr, q0, smem, tid, o);
        if (c == 0) {
#pragma unroll
          for (int mb = 0; mb < 4; mb++)
#pragma unroll
            for (int q = 0; q < 4; q++)
              *(f32x4*)(stash + mb * 16 + q * 4) = f32x4{o[mb][4 * q], o[mb][4 * q + 1], o[mb][4 * q + 2], o[mb][4 * q + 3]};
        }
      }
      float ss = 0.f;
#pragma unroll
      for (int mb = 0; mb < 4; mb++)
#pragma unroll
        for (int q4 = 0; q4 < 4; q4++) {
          f32x4 sv = *(const f32x4*)(stash + mb * 16 + q4 * 4);
#pragma unroll
          for (int e = 0; e < 4; e++) {
            float a0 = sv[e] - lam * o[mb][4 * q4 + e];
            o[mb][4 * q4 + e] = a0;
            ss += a0 * a0;
          }
        }
      ss += __shfl_xor(ss, 32);
      const float rstd = rsqrtf(ss * (1.f / 128.f) + 1e-5f) * 0.8f;
      const int tok = b * SEQ + q0 + 32 * w + r;
#pragma unroll
      for (int mb = 0; mb < 4; mb++)
#pragma unroll
        for (int g = 0; g < 4; g++) {
          const int d = 32 * mb + 8 * g + 4 * h;
          float4 gs = *(const float4*)(p.g_subln + d);
          uint2 ov;
          ov.x = pk2(o[mb][4 * g + 0] * rstd * gs.x, o[mb][4 * g + 1] * rstd * gs.y);
          ov.y = pk2(o[mb][4 * g + 2] * rstd * gs.z, o[mb][4 * g + 3] * rstd * gs.w);
          *(uint2*)(p.H() + (size_t)tok * DM + 512 + dh * 128 + d) = ov;
        }
    } else {
      const int it = item - 512;
      const int qt = 15 - (it >> 6), bh = it & 63, b = bh >> 3, hd = bh & 7;
      const int q0 = qt * 128;
      const u16* Qg = p.QK() + ((size_t)(0 * 8 + b) * 8 + hd) * SEQ * 64;
      const u16* Kg = p.QK() + ((size_t)(1 * 8 + b) * 8 + hd) * SEQ * 64;
      const u16* Vtg = p.Vt() + ((size_t)(0 + b) * 512 + hd * 64) * SEQ;
      const float* FLg = p.FL() + (b * 8 + hd) * SEQ;
      f32x16 o[2];
      attn_pass<64, true>(Qg, Kg, Vtg, FLg, q0, smem, tid, o);
      const int tok = b * SEQ + q0 + 32 * w + r;
#pragma unroll
      for (int mb = 0; mb < 2; mb++)
#pragma unroll
        for (int g = 0; g < 4; g++) {
          const int d = 32 * mb + 8 * g + 4 * h;
          uint2 ov;
          ov.x = pk2(o[mb][4 * g + 0], o[mb][4 * g + 1]);
          ov.y = pk2(o[mb][4 * g + 2], o[mb][4 * g + 3]);
          *(uint2*)(p.H() + (size_t)tok * DM + hd * 64 + d) = ov;
        }
    }
  }
}

DI void phase3(const Params& p, char* smem, int tid) {
  asm volatile("" : "+v"(tid));
  const int lane = tid & 63, w = tid >> 6, wm = w & 1, wn = w >> 1, r = lane & 31, h = lane >> 5;
  for (int t = blockIdx.x; t < 128 * 8; t += gridDim.x) {
    const int nt = t & 7, mt = t >> 3;
    const int m0 = mt * 128, n0 = nt * 128;
    const int b = m0 >> 11;
    f32x16 acc[2][2];
    gemm_mainloop(p.WtO(), p.H(), n0, m0, smem, tid, acc);
#pragma unroll
    for (int j = 0; j < 2; j++) {
      const int tok = m0 + 64 * wn + 32 * j + r;
#pragma unroll
      for (int i = 0; i < 2; i++)
#pragma unroll
        for (int g = 0; g < 4; g++) {
          const int n = n0 + 64 * wm + 32 * i + 8 * g + 4 * h;
          float4 xv = *(const float4*)(p.x + (size_t)tok * DM + n);
          float4 gt = *(const float4*)(p.mod() + b * 6144 + 2048 + n);
          float4 ov;
          ov.x = xv.x + gt.x * acc[i][j][4 * g + 0];
          ov.y = xv.y + gt.y * acc[i][j][4 * g + 1];
          ov.z = xv.z + gt.z * acc[i][j][4 * g + 2];
          ov.w = xv.w + gt.w * acc[i][j][4 * g + 3];
          *(float4*)(p.out + (size_t)tok * DM + n) = ov;
        }
    }
  }
}

DI void phase3b(const Params& p, int tid) {
  asm volatile("" : "+v"(tid));
  const int lane = tid & 63, w = tid >> 6;
  for (int tok = blockIdx.x * 4 + w; tok < T_TOK; tok += gridDim.x * 4) {
    const int b = tok >> 11;
    const float* xr = p.out + (size_t)tok * DM;
    float4 xv[4];
    float ss = 0.f;
#pragma unroll
    for (int i = 0; i < 4; i++) {
      xv[i] = *(const float4*)(xr + 256 * i + 4 * lane);
      ss += xv[i].x * xv[i].x + xv[i].y * xv[i].y + xv[i].z * xv[i].z + xv[i].w * xv[i].w;
    }
    ss = wave_sum(ss);
    const float rstd = rsqrtf(ss * (1.f / 1024.f) + 1e-6f);
    const float* md = p.mod() + b * 6144;
#pragma unroll
    for (int i = 0; i < 4; i++) {
      const int c0 = 256 * i + 4 * lane;
      float4 g = *(const float4*)(p.g_ffn + c0);
      float4 sh = *(const float4*)(md + 3072 + c0);
      float4 sc = *(const float4*)(md + 4096 + c0);
      uint2 o;
      o.x = pk2(xv[i].x * rstd * g.x * (1.f + sc.x) + sh.x, xv[i].y * rstd * g.y * (1.f + sc.y) + sh.y);
      o.y = pk2(xv[i].z * rstd * g.z * (1.f + sc.z) + sh.z, xv[i].w * rstd * g.w * (1.f + sc.w) + sh.w);
      *(uint2*)(p.H() + (size_t)tok * DM + c0) = o;
    }
  }
}

DI void phase4(const Params& p, char* smem, int tid) {
  asm volatile("" : "+v"(tid));
  const int lane = tid & 63, w = tid >> 6, wm = w & 1, wn = w >> 1, r = lane & 31, h = lane >> 5;
  for (int t = blockIdx.x; t < 128 * 8; t += gridDim.x) {
    const int nt = t & 7, mt = t >> 3;
    const int m0 = mt * 128, n0 = nt * 128;
    f32x16 acc[2][2];
    gemm_mainloop(p.WtPq(), p.H(), n0, m0, smem, tid, acc);
#pragma unroll
    for (int j = 0; j < 2; j++) {
      const int tok = m0 + 64 * wn + 32 * j + r;
#pragma unroll
      for (int i = 0; i < 2; i++)
#pragma unroll
        for (int g = 0; g < 4; g++) {
          const int n = n0 + 64 * wm + 32 * i + 8 * g + 4 * h;
          uint2 o;
          o.x = pk2(acc[i][j][4 * g + 0], acc[i][j][4 * g + 1]);
          o.y = pk2(acc[i][j][4 * g + 2], acc[i][j][4 * g + 3]);
          *(uint2*)(p.Qp() + (size_t)tok * DM + n) = o;
        }
    }
  }
}

DI void top16_128(float v0, float v1, int lane, float& rv, int& ri) {
  rv = -INFINITY;
  ri = 0;
  for (int it = 0; it < 16; it++) {
    float m = wave_max(fmaxf(v0, v1));
    unsigned long long b0 = __ballot(v0 == m);
    unsigned long long b1 = __ballot(v1 == m);
    int idx;
    if (b0) {
      int l = __ffsll((long long)b0) - 1;
      idx = l;
      if (lane == l) v0 = -INFINITY;
    } else {
      int l = __ffsll((long long)b1) - 1;
      idx = l + 64;
      if (lane == l) v1 = -INFINITY;
    }
    if (lane == it) { rv = m; ri = idx; }
  }
}

template <int N>
struct TR {
  static DI float run(float (&part)[N], int lane) {
    constexpr int H = N / 2;
    float nxt[H];
    const bool up = (lane & H) != 0;
#pragma unroll
    for (int i = 0; i < H; i++) {
      float keep = up ? part[i + H] : part[i];
      float send = up ? part[i] : part[i + H];
      nxt[i] = keep + __shfl_xor(send, H);
    }
    return TR<H>::run(nxt, lane);
  }
};
template <>
struct TR<1> {
  static DI float run(float (&part)[1], int) { return part[0]; }
};

DI void phase5(const Params& p, char* smem, int tid) {
  asm volatile("" : "+v"(tid));
  const int lane = tid & 63, w = tid >> 6, r = lane & 31, h = lane >> 5;
  float* S = (float*)smem;
  char* skl = smem + 33280;
  __syncthreads();
  for (int i = tid; i < 2 * 128 * 8; i += NTHREADS) {
    const int row = i >> 3, ch = i & 7;
    const float* src = p.sub_keys + (size_t)row * 64 + ch * 8;
    float4 a = *(const float4*)src, b = *(const float4*)(src + 4);
    u32x4 u = {pk2(a.x, a.y), pk2(a.z, a.w), pk2(b.x, b.y), pk2(b.z, b.w)};
    *(u32x4*)(skl + row * 144 + ch * 16) = u;
  }
  int ci, cj;
  {
    const int offs[16] = {0, 16, 24, 29, 33, 36, 38, 40, 42, 43, 44, 45, 46, 47, 48, 49};
    int i = 0, off = 0;
#pragma unroll
    for (int q = 1; q < 16; q++)
      if (lane >= offs[q]) { i = q; off = offs[q]; }
    ci = i;
    cj = lane - off;
    if (lane >= 50) { ci = 0; cj = 0; }
  }
  for (int grp = blockIdx.x; grp < T_TOK / 4; grp += gridDim.x) {
    const int tok0 = grp * 4;
    __syncthreads();
    {
      const int tl = r >> 3, hd = r & 7;
#pragma unroll
      for (int c = 0; c < 2; c++) {
        f32x16 sc;
#pragma unroll
        for (int q = 0; q < 16; q++) sc[q] = 0.f;
#pragma unroll
        for (int ks = 0; ks < 4; ks++) {
          bf16x8 qb = *(const bf16x8*)(p.Qp() + (size_t)(tok0 + tl) * DM + hd * 128 + c * 64 + 16 * ks + 8 * h);
          bf16x8 ska = *(const bf16x8*)(skl + (c * 128 + 32 * w + r) * 144 + ks * 32 + h * 16);
          sc = MFMA32(ska, qb, sc);
        }
#pragma unroll
        for (int g = 0; g < 4; g++)
          *(float4*)(S + r * 260 + c * 128 + 32 * w + 8 * g + 4 * h) =
              make_float4(sc[4 * g + 0], sc[4 * g + 1], sc[4 * g + 2], sc[4 * g + 3]);
      }
    }
    __syncthreads();
    const int tok = tok0 + w;
    const int b = tok >> 11;
    int e_lo = 0, e_hi = 0;
    float g_lo = 0.f, g_hi = 0.f;
    for (int hd = 0; hd < 8; hd++) {
      const float* sr = S + (w * 8 + hd) * 260;
      float av, bv;
      int ai, bi;
      top16_128(sr[lane], sr[lane + 64], lane, av, ai);
      top16_128(sr[128 + lane], sr[128 + lane + 64], lane, bv, bi);
      float cv = __shfl(av, ci) + __shfl(bv, cj);
      int ce = __shfl(ai, ci) * 128 + __shfl(bi, cj);
      if (lane >= 50) cv = -INFINITY;
      float tv = -INFINITY;
      int te = 0;
      for (int it = 0; it < 16; it++) {
        float m = wave_max(cv);
        unsigned long long bm = __ballot(cv == m);
        int l = __ffsll((long long)bm) - 1;
        int e = __shfl(ce, l);
        if (lane == l) cv = -INFINITY;
        if (lane == it) { tv = m; te = e; }
      }
      float mx = __shfl(tv, 0);
      float ex = lane < 16 ? __expf(tv - mx) : 0.f;
      float sm = wave_sum(ex);
      float gg = ex / sm;
      float gsrc = __shfl(gg, lane & 15);
      int esrc = __shfl(te, lane & 15);
      if ((lane >> 4) == (hd & 3)) {
        if (hd < 4) { g_lo = gsrc; e_lo = esrc; }
        else { g_hi = gsrc; e_hi = esrc; }
      }
    }
    const u32x4 hq0 = *(const u32x4*)(p.H() + (size_t)tok * DM + 16 * lane);
    const u32x4 hq1 = *(const u32x4*)(p.H() + (size_t)tok * DM + 16 * lane + 8);
    float w_lo = 0.f, w_hi = 0.f;
#pragma unroll
    for (int half = 0; half < 2; half++) {
      const int esel = half ? e_hi : e_lo;
      float aslot = 0.f;
#pragma unroll 1
      for (int jb = 0; jb < 4; jb++) {
        u32x4 uu[16];
#pragma unroll
        for (int jj = 0; jj < 16; jj++) {
          int e = __builtin_amdgcn_readlane(esel, jb * 16 + jj);
          uu[jj] = *(const u32x4*)(p.Uq() + (size_t)e * DM + 16 * lane);
        }
        float part[16];
#pragma unroll
        for (int jj = 0; jj < 16; jj++) {
          float a = 0.f;
#pragma unroll
          for (int q = 0; q < 4; q++) {
            const unsigned x = uu[jj][q];
            const unsigned h0 = q < 2 ? hq0[(2 * q) & 3] : hq1[(2 * q) & 3];
            const unsigned h1 = q < 2 ? hq0[(2 * q + 1) & 3] : hq1[(2 * q + 1) & 3];
            bf16x2_t lo = __builtin_amdgcn_cvt_scalef32_pk_bf16_fp8(x, 1.0f, false);
            bf16x2_t hi = __builtin_amdgcn_cvt_scalef32_pk_bf16_fp8(x, 1.0f, true);
            a = __builtin_amdgcn_fdot2_f32_bf16(lo, __builtin_bit_cast(bf16x2_t, h0), a, false);
            a = __builtin_amdgcn_fdot2_f32_bf16(hi, __builtin_bit_cast(bf16x2_t, h1), a, false);
          }
          part[jj] = a;
        }
        float v = TR<16>::run(part, lane);
        v += __shfl_xor(v, 16);
        v += __shfl_xor(v, 32);
        if ((lane >> 4) == jb) aslot = v;
      }
      aslot *= (1.f / 64.f);
      float ge = 0.5f * aslot * (1.f + erff(aslot * 0.70710678118654752f));
      if (half) w_hi = ge * g_hi * 0.125f; else w_lo = ge * g_lo * 0.125f;
    }
    float acc[16];
#pragma unroll
    for (int i = 0; i < 16; i++) acc[i] = 0.f;
#pragma unroll
    for (int half = 0; half < 2; half++) {
      const int esel = half ? e_hi : e_lo;
      const int wsel = __builtin_bit_cast(int, half ? w_hi : w_lo);
#pragma unroll 1
      for (int jb = 0; jb < 8; jb++) {
        u32x4 vv[8];
#pragma unroll
        for (int jj = 0; jj < 8; jj++) {
          int e = __builtin_amdgcn_readlane(esel, jb * 8 + jj);
          vv[jj] = *(const u32x4*)(p.Vq() + (size_t)e * DM + 16 * lane);
        }
#pragma unroll
        for (int jj = 0; jj < 8; jj++) {
          float wj = __builtin_bit_cast(float, __builtin_amdgcn_readlane(wsel, jb * 8 + jj));
#pragma unroll
          for (int q = 0; q < 4; q++) {
            const unsigned x = vv[jj][q];
            f32x2_t lo = __builtin_amdgcn_cvt_pk_f32_fp8(x, false);
            f32x2_t hi = __builtin_amdgcn_cvt_pk_f32_fp8(x, true);
            acc[4 * q + 0] += wj * lo.x;
            acc[4 * q + 1] += wj * lo.y;
            acc[4 * q + 2] += wj * hi.x;
            acc[4 * q + 3] += wj * hi.y;
          }
        }
      }
    }
    float* orow = p.out + (size_t)tok * DM + 16 * lane;
    const float* gt2 = p.mod() + b * 6144 + 5120 + 16 * lane;
    float ss = 0.f;
#pragma unroll
    for (int q = 0; q < 4; q++) {
      f32x4 xv = *(const f32x4*)(orow + 4 * q);
      f32x4 gt = *(const f32x4*)(gt2 + 4 * q);
#pragma unroll
      for (int e = 0; e < 4; e++) {
        float o = xv[e] + gt[e] * acc[4 * q + e];
        acc[4 * q + e] = o;
        ss += o * o;
      }
    }
    ss = wave_sum(ss);
    const float rstd = rsqrtf(ss * (1.f / 1024.f) + 1e-6f);
#pragma unroll
    for (int q = 0; q < 4; q++) {
      f32x4 gf = *(const f32x4*)(p.g_final + 16 * lane + 4 * q);
      f32x4 ov;
#pragma unroll
      for (int e = 0; e < 4; e++) ov[e] = acc[4 * q + e] * rstd * gf[e];
      *(f32x4*)(orow + 4 * q) = ov;
    }
  }
}

__global__ void __launch_bounds__(NTHREADS, 2) fwd_megakernel(Params p) {
  __shared__ __attribute__((aligned(16))) char smem[SMEM_BYTES];
  cg::grid_group grid = cg::this_grid();
  const int tid = threadIdx.x;
  phase0(p, smem, tid);
  grid.sync();
  phase1a(p, smem, tid);
  grid.sync();
  phase_cumsum(p, smem, tid);
  phase1b(p, smem, tid);
  grid.sync();
  phase2(p, smem, tid);
  grid.sync();
  phase3(p, smem, tid);
  grid.sync();
  phase3b(p, tid);
  grid.sync();
  phase4(p, smem, tid);
  grid.sync();
  phase5(p, smem, tid);
}

extern "C" void kernel_launch(void* const* d_in, const int* in_sizes, int n_in, void* d_out, int out_size, void* d_ws,
                              size_t ws_size, hipStream_t stream) {
  static int grid_blocks = 0;
  if (!grid_blocks) {
    int dev = 0, cus = 0, per_cu = 0;
    hipGetDevice(&dev);
    hipDeviceGetAttribute(&cus, hipDeviceAttributeMultiprocessorCount, dev);
    hipOccupancyMaxActiveBlocksPerMultiprocessor(&per_cu, fwd_megakernel, NTHREADS, 0);
    if (per_cu > 2) per_cu = 2;
    if (per_cu < 1) per_cu = 1;
    grid_blocks = cus * per_cu;
  }
  Params p{};
  p.x = (const float*)d_in[0]; p.c = (const float*)d_in[1]; p.w_ada = (const float*)d_in[2]; p.b_ada = (const float*)d_in[3];
  p.g_attn = (const float*)d_in[4]; p.w_in = (const float*)d_in[5]; p.b_f = (const float*)d_in[6];
  p.lq1 = (const float*)d_in[7]; p.lk1 = (const float*)d_in[8]; p.lq2 = (const float*)d_in[9]; p.lk2 = (const float*)d_in[10];
  p.g_subln = (const float*)d_in[11]; p.w_o = (const float*)d_in[12]; p.g_ffn = (const float*)d_in[13];
  p.w_pq = (const float*)d_in[14]; p.sub_keys = (const float*)d_in[15]; p.u_exp = (const float*)d_in[16];
  p.v_exp = (const float*)d_in[17]; p.g_final = (const float*)d_in[18];
  p.out = (float*)d_out;
  p.ws = (char*)d_ws;
  void* args[] = {&p};
  hipError_t e = hipLaunchCooperativeKernel((void*)fwd_megakernel, dim3(grid_blocks), dim3(NTHREADS), args, 0, stream);
  if (e != hipSuccess) fprintf(stderr, "cooperative launch failed: %s (grid %d)\n", hipGetErrorString(e), grid_blocks);
}
```

```cpp
#include <hip/hip_runtime.h>
#include <hip/hip_cooperative_groups.h>
#include <cstdio>
namespace cg = cooperative_groups;

#define DI __device__ __forceinline__
typedef unsigned short u16;
using bf16x8 = __attribute__((ext_vector_type(8))) short;
using f32x16 = __attribute__((ext_vector_type(16))) float;
typedef __bf16 bf16x2_t __attribute__((ext_vector_type(2)));
typedef float f32x2_t __attribute__((ext_vector_type(2)));
using u32x4 = __attribute__((ext_vector_type(4))) unsigned;
using u32x2 = __attribute__((ext_vector_type(2))) unsigned;
using f32x4 = __attribute__((ext_vector_type(4))) float;

#define MFMA32(a, b, c) __builtin_amdgcn_mfma_f32_32x32x16_bf16((a), (b), (c), 0, 0, 0)

static constexpr int T_TOK = 16384;
static constexpr int SEQ = 2048;
static constexpr int DM = 1024;
static constexpr int INC = 3080;
static constexpr float LOG2E = 1.4426950408889634f;
static constexpr int NTHREADS = 256;
static constexpr int SMEM_BYTES = 70656;

struct Params {
  const float *x, *c, *w_ada, *b_ada, *g_attn, *w_in, *b_f, *lq1, *lk1, *lq2, *lk2, *g_subln, *w_o, *g_ffn, *w_pq,
      *sub_keys, *u_exp, *v_exp, *g_final;
  float* out;
  char* ws;
  static constexpr size_t MB = 1024 * 1024;
  DI u16* WtIn() const { return (u16*)(ws + 0 * MB); }
  DI u16* WtO() const { return (u16*)(ws + 6 * MB); }
  DI u16* WtPq() const { return (u16*)(ws + 8 * MB); }
  DI unsigned char* Uq() const { return (unsigned char*)(ws + 10 * MB); }
  DI unsigned char* Vq() const { return (unsigned char*)(ws + 42 * MB); }
  DI u16* H() const { return (u16*)(ws + 74 * MB); }
  DI u16* QK() const { return (u16*)(ws + 106 * MB); }
  DI u16* Vt() const { return (u16*)(ws + 170 * MB); }
  DI u16* Qp() const { return (u16*)(ws + 106 * MB); }
  DI float* mod() const { return (float*)(ws + 202 * MB); }
  DI float* rope() const { return (float*)(ws + 202 * MB + 256 * 1024); }
  DI float* logf() const { return (float*)(ws + 203 * MB); }
  DI float* FL() const { return (float*)(ws + 204 * MB); }
  DI unsigned* counters() const { return (unsigned*)(ws + 205 * MB); }
  DI float* stash() const { return (float*)(ws + 206 * MB); }
};

DI unsigned pk2(float a, float b) {
  f32x2_t v = {a, b};
  bf16x2_t r = __builtin_convertvector(v, bf16x2_t);
  return __builtin_bit_cast(unsigned, r);
}
DI float dot2bf(unsigned a, unsigned b, float c) {
  bf16x2_t x = __builtin_bit_cast(bf16x2_t, a);
  bf16x2_t y = __builtin_bit_cast(bf16x2_t, b);
  return __builtin_amdgcn_fdot2_f32_bf16(x, y, c, false);
}
DI float bf_lo(unsigned u) { return __uint_as_float(u << 16); }
DI float bf_hi(unsigned u) { return __uint_as_float(u & 0xffff0000u); }
DI float wave_sum(float v) {
#pragma unroll
  for (int o = 32; o >= 1; o >>= 1) v += __shfl_xor(v, o);
  return v;
}
DI float wave_max(float v) {
#pragma unroll
  for (int o = 32; o >= 1; o >>= 1) v = fmaxf(v, __shfl_xor(v, o));
  return v;
}

DI void transpose_tile(const float* __restrict__ src, int ld, int col0, int k0, u16* __restrict__ dst, int n0, char* smem,
                       int tid) {
  float* t = (float*)smem;
  __syncthreads();
  {
    int cc = tid & 63, r0 = tid >> 6;
#pragma unroll
    for (int i = 0; i < 16; i++) {
      int r = r0 + 4 * i;
      t[r * 65 + cc] = src[(size_t)(k0 + r) * ld + col0 + cc];
    }
  }
  __syncthreads();
#pragma unroll
  for (int i = 0; i < 2; i++) {
    int q = tid + 256 * i;
    int n = q >> 3, kc = q & 7;
    uint4 v;
    v.x = pk2(t[(8 * kc + 0) * 65 + n], t[(8 * kc + 1) * 65 + n]);
    v.y = pk2(t[(8 * kc + 2) * 65 + n], t[(8 * kc + 3) * 65 + n]);
    v.z = pk2(t[(8 * kc + 4) * 65 + n], t[(8 * kc + 5) * 65 + n]);
    v.w = pk2(t[(8 * kc + 6) * 65 + n], t[(8 * kc + 7) * 65 + n]);
    *(uint4*)(dst + (size_t)(n0 + n) * 1024 + k0 + 8 * kc) = v;
  }
}

DI void phase0(const Params& p, char* smem, int tid) {
  asm volatile("" : "+v"(tid));
  const int bid = blockIdx.x, nb = gridDim.x;
  if (bid == 0 && tid == 0) { p.counters()[0] = 0u; p.counters()[1] = 0u; }
  {
    float* sc = (float*)smem;
    float* red = (float*)(smem + 32768);
    bool loaded = false;
    for (int it = bid; it < 192; it += nb) {
      if (!loaded) {
        for (int i = tid; i < 8192; i += NTHREADS) {
          float v = p.c[i];
          sc[i] = v / (1.f + __expf(-v));
        }
        loaded = true;
      }
      __syncthreads();
      int col = it * 32 + (tid & 31), kg = tid >> 5;
      float acc[8];
#pragma unroll
      for (int b = 0; b < 8; b++) acc[b] = 0.f;
      for (int k = kg * 128; k < kg * 128 + 128; k++) {
        float w = p.w_ada[(size_t)k * 6144 + col];
#pragma unroll
        for (int b = 0; b < 8; b++) acc[b] += sc[b * 1024 + k] * w;
      }
#pragma unroll
      for (int b = 0; b < 8; b++) red[(kg * 8 + b) * 32 + (tid & 31)] = acc[b];
      __syncthreads();
      {
        int b = tid >> 5, cc = tid & 31;
        float s = 0.f;
#pragma unroll
        for (int g = 0; g < 8; g++) s += red[(g * 8 + b) * 32 + cc];
        p.mod()[b * 6144 + it * 32 + cc] = s + p.b_ada[it * 32 + cc];
      }
    }
    __syncthreads();
  }
  for (int it = bid; it < 1280; it += nb) {
    if (it < 768) {
      int nt = it >> 4, kt = it & 15;
      int n0 = nt * 64;
      int col0 = n0 < 1536 ? n0 : n0 + 8;
      transpose_tile(p.w_in, INC, col0, kt * 64, p.WtIn(), n0, smem, tid);
    } else if (it < 1024) {
      int j = it - 768;
      transpose_tile(p.w_o, 1024, (j >> 4) * 64, (j & 15) * 64, p.WtO(), (j >> 4) * 64, smem, tid);
    } else {
      int j = it - 1024;
      transpose_tile(p.w_pq, 1024, (j >> 4) * 64, (j & 15) * 64, p.WtPq(), (j >> 4) * 64, smem, tid);
    }
  }
  {
    const size_t ngroups = (size_t)16384 * 1024 / 16;
    for (size_t g = (size_t)bid * NTHREADS + tid; g < 2 * ngroups; g += (size_t)nb * NTHREADS) {
      const bool isu = g < ngroups;
      const float* src = isu ? p.u_exp + g * 16 : p.v_exp + (g - ngroups) * 16;
      unsigned char* dst = isu ? p.Uq() + g * 16 : p.Vq() + (g - ngroups) * 16;
      const float sc = isu ? 64.f : 8.f;
      u32x4 v;
#pragma unroll
      for (int q = 0; q < 4; q++) {
        float4 a = *(const float4*)(src + 4 * q);
        unsigned wv = 0;
        wv = __builtin_amdgcn_cvt_pk_fp8_f32(a.x * sc, a.y * sc, wv, false);
        wv = __builtin_amdgcn_cvt_pk_fp8_f32(a.z * sc, a.w * sc, wv, true);
        v[q] = wv;
      }
      *(u32x4*)dst = v;
    }
  }
  for (int e = bid * NTHREADS + tid; e < 2048 * 8; e += nb * NTHREADS) {
    int pos = e >> 3, i = e & 7;
    const double invs[8] = {1.0, 0.19392274474868576, 0.03760603093086393, 0.007292664737217109,
                            0.001414213562373095, 0.0002742481756762073, 5.318295896944988e-05, 1.031338537721246e-05};
    double inv = invs[0];
#pragma unroll
    for (int q = 1; q < 8; q++) inv = (i == q) ? invs[q] : inv;
    double ang = (double)pos * inv;
    double t = ang * 0.15915494309189535;
    t -= rint(t);
    double r = t * 6.283185307179586;
    double r2 = r * r;
    double s = 1.0, c = 1.0;
#pragma unroll
    for (int n = 15; n >= 1; n--) {
      s = 1.0 - s * r2 * (1.0 / (double)((2 * n) * (2 * n + 1)));
      c = 1.0 - c * r2 * (1.0 / (double)((2 * n - 1) * (2 * n)));
    }
    s *= r;
    p.rope()[pos * 16 + i] = (float)c;
    p.rope()[pos * 16 + 8 + i] = (float)s;
  }
}

DI void phase1a(const Params& p, char* smem, int tid) {
  asm volatile("" : "+v"(tid));
  float* wfg = (float*)smem;
  __syncthreads();
  for (int i = tid; i < 8192; i += NTHREADS) {
    int k = i >> 3, j = i & 7;
    wfg[j * 1024 + k] = p.w_in[(size_t)k * INC + 1536 + j];
  }
  __syncthreads();
  const int lane = tid & 63, w = tid >> 6;
  for (int tok = blockIdx.x * 4 + w; tok < T_TOK; tok += gridDim.x * 4) {
    const int b = tok >> 11, s = tok & 2047;
    const float* xr = p.x + (size_t)tok * DM;
    float4 xv[4];
    float ss = 0.f;
#pragma unroll
    for (int i = 0; i < 4; i++) {
      xv[i] = *(const float4*)(xr + 256 * i + 4 * lane);
      ss += xv[i].x * xv[i].x + xv[i].y * xv[i].y + xv[i].z * xv[i].z + xv[i].w * xv[i].w;
    }
    ss = wave_sum(ss);
    const float rstd = rsqrtf(ss * (1.f / 1024.f) + 1e-6f);
    const float* md = p.mod() + b * 6144;
    float fg[8];
#pragma unroll
    for (int j = 0; j < 8; j++) fg[j] = 0.f;
#pragma unroll
    for (int i = 0; i < 4; i++) {
      const int c0 = 256 * i + 4 * lane;
      float4 g = *(const float4*)(p.g_attn + c0);
      float4 sh = *(const float4*)(md + c0);
      float4 sc = *(const float4*)(md + 1024 + c0);
      float4 h;
      h.x = xv[i].x * rstd * g.x * (1.f + sc.x) + sh.x;
      h.y = xv[i].y * rstd * g.y * (1.f + sc.y) + sh.y;
      h.z = xv[i].z * rstd * g.z * (1.f + sc.z) + sh.z;
      h.w = xv[i].w * rstd * g.w * (1.f + sc.w) + sh.w;
      uint2 o;
      o.x = pk2(h.x, h.y); o.y = pk2(h.z, h.w);
      *(uint2*)(p.H() + (size_t)tok * DM + c0) = o;
#pragma unroll
      for (int j = 0; j < 8; j++) {
        float4 wv = *(const float4*)(wfg + j * 1024 + c0);
        fg[j] += h.x * wv.x + h.y * wv.y + h.z * wv.z + h.w * wv.w;
      }
    }
#pragma unroll
    for (int j = 0; j < 8; j++) fg[j] = wave_sum(fg[j]);
    float z = fg[0];
#pragma unroll
    for (int j = 1; j < 8; j++) z = (lane == j) ? fg[j] : z;
    if (lane < 8) {
      z += p.b_f[lane];
      float ls = fminf(z, 0.f) - log1pf(__expf(-fabsf(z)));
      p.logf()[(b * 8 + lane) * SEQ + s] = ls;
    }
  }
}

DI void phase_cumsum(const Params& p, char* smem, int tid) {
  asm volatile("" : "+v"(tid));
  double* part = (double*)smem;
  for (int seq = blockIdx.x; seq < 64; seq += gridDim.x) {
    __syncthreads();
    const float* lf = p.logf() + seq * SEQ + tid * 8;
    float4 a = *(const float4*)lf, b = *(const float4*)(lf + 4);
    double v0 = a.x, v1 = v0 + a.y, v2 = v1 + a.z, v3 = v2 + a.w, v4 = v3 + b.x, v5 = v4 + b.y, v6 = v5 + b.z, v7 = v6 + b.w;
    double run = v7;
    part[tid] = run;
    __syncthreads();
    double pre = 0.0;
    for (int i = 0; i < tid; i++) pre += part[i];
    const double L2E = 1.4426950408889634;
    float* dst = p.FL() + seq * SEQ + tid * 8;
    *(float4*)dst = make_float4((float)((v0 + pre) * L2E), (float)((v1 + pre) * L2E), (float)((v2 + pre) * L2E), (float)((v3 + pre) * L2E));
    *(float4*)(dst + 4) = make_float4((float)((v4 + pre) * L2E), (float)((v5 + pre) * L2E), (float)((v6 + pre) * L2E), (float)((v7 + pre) * L2E));
  }
  __syncthreads();
}

DI void gemm_mainloop(const u16* __restrict__ Lg, const u16* __restrict__ Rg, int l0, int r0, char* smem, int tid,
                      f32x16 (&acc)[2][2]) {
  const int lane = tid & 63, w = tid >> 6;
  const int wm = w & 1, wn = w >> 1;
  const int r = lane & 31, h = lane >> 5;
  const int lc = tid & 7, lr = tid >> 3;
  const int sw = ((lr >> 1) & 7);
#pragma unroll
  for (int i = 0; i < 2; i++)
#pragma unroll
    for (int j = 0; j < 2; j++)
#pragma unroll
      for (int q = 0; q < 16; q++) acc[i][j][q] = 0.f;
  u32x4 ra[4], rb[4];
  const u16* lp = Lg + (size_t)(l0 + lr) * 1024 + lc * 8;
  const u16* rp = Rg + (size_t)(r0 + lr) * 1024 + lc * 8;
#pragma unroll
  for (int i = 0; i < 4; i++) {
    ra[i] = *(const u32x4*)(lp + (size_t)i * 32 * 1024);
    rb[i] = *(const u32x4*)(rp + (size_t)i * 32 * 1024);
  }
  __syncthreads();
  {
    char* sL = smem;
    char* sR = smem + 16384;
#pragma unroll
    for (int i = 0; i < 4; i++) {
      int off = (lr + 32 * i) * 128 + ((lc ^ sw) << 4);
      *(u32x4*)(sL + off) = ra[i];
      *(u32x4*)(sR + off) = rb[i];
    }
  }
  __syncthreads();
  for (int kt = 0; kt < 16; kt++) {
    const char* sL = smem + (kt & 1) * 32768;
    const char* sR = sL + 16384;
    if (kt + 1 < 16) {
#pragma unroll
      for (int i = 0; i < 4; i++) {
        ra[i] = *(const u32x4*)(lp + (size_t)i * 32 * 1024 + (kt + 1) * 64);
        rb[i] = *(const u32x4*)(rp + (size_t)i * 32 * 1024 + (kt + 1) * 64);
      }
    }
#pragma unroll
    for (int ks = 0; ks < 4; ks++) {
      bf16x8 a[2], b[2];
#pragma unroll
      for (int i = 0; i < 2; i++) {
        int row = 64 * wm + 32 * i + r;
        a[i] = *(const bf16x8*)(sL + row * 128 + (((2 * ks + h) ^ ((row >> 1) & 7)) << 4));
        int rowb = 64 * wn + 32 * i + r;
        b[i] = *(const bf16x8*)(sR + rowb * 128 + (((2 * ks + h) ^ ((rowb >> 1) & 7)) << 4));
      }
#pragma unroll
      for (int i = 0; i < 2; i++)
#pragma unroll
        for (int j = 0; j < 2; j++) acc[i][j] = MFMA32(a[i], b[j], acc[i][j]);
    }
    if (kt + 1 < 16) {
      char* dL = smem + ((kt + 1) & 1) * 32768;
      char* dR = dL + 16384;
#pragma unroll
      for (int i = 0; i < 4; i++) {
        int off = (lr + 32 * i) * 128 + ((lc ^ sw) << 4);
        *(u32x4*)(dL + off) = ra[i];
        *(u32x4*)(dR + off) = rb[i];
      }
    }
    __syncthreads();
  }
}

DI void phase1b(const Params& p, char* smem, int tid) {
  asm volatile("" : "+v"(tid));
  const int lane = tid & 63, w = tid >> 6, wm = w & 1, wn = w >> 1, r = lane & 31, h = lane >> 5;
  for (int t = blockIdx.x; t < 128 * 24; t += gridDim.x) {
    const int nt = t % 24, mt = t / 24;
    const int m0 = mt * 128, n0 = nt * 128;
    const int b = m0 >> 11, s0 = m0 & 2047;
    const int seg = nt >> 2;
    f32x16 acc[2][2];
    if (seg == 2 || seg == 5) {
      gemm_mainloop(p.H(), p.WtIn(), m0, n0, smem, tid, acc);
      const int kind = seg == 2 ? 0 : 1;
      const int colbase = n0 - (seg == 2 ? 1024 : 2560);
#pragma unroll
      for (int i = 0; i < 2; i++)
#pragma unroll
        for (int j = 0; j < 2; j++) {
          int col = colbase + 64 * wn + 32 * j + r;
          u16* dst = p.Vt() + ((size_t)(kind * 8 + b) * 512 + col) * SEQ + s0 + 64 * wm + 32 * i + 4 * h;
#pragma unroll
          for (int g = 0; g < 4; g++) {
            uint2 o;
            o.x = pk2(acc[i][j][4 * g + 0], acc[i][j][4 * g + 1]);
            o.y = pk2(acc[i][j][4 * g + 2], acc[i][j][4 * g + 3]);
            *(uint2*)(dst + 8 * g) = o;
          }
        }
    } else {
      gemm_mainloop(p.WtIn(), p.H(), n0, m0, smem, tid, acc);
      const int kind = seg == 0 ? 0 : seg == 1 ? 1 : seg == 3 ? 2 : 3;
      const int colbase = n0 - (seg == 0 ? 0 : seg == 1 ? 512 : seg == 3 ? 1536 : 2048);
      const bool rope = (seg >= 3);
      const float scale = (seg == 0 || seg == 3) ? 0.125f * LOG2E : 1.f;
#pragma unroll
      for (int j = 0; j < 2; j++) {
        const int s = s0 + 64 * wn + 32 * j + r;
        f32x4 cs = {1.f, 1.f, 1.f, 1.f}, sn = {0.f, 0.f, 0.f, 0.f};
        if (rope) {
          cs = *(const f32x4*)(p.rope() + s * 16 + 4 * h);
          sn = *(const f32x4*)(p.rope() + s * 16 + 8 + 4 * h);
        }
#pragma unroll
        for (int i = 0; i < 2; i++) {
          const int colt = colbase + 64 * wm + 32 * i;
          const int hc = colt >> 6, d0 = colt & 63;
          f32x16 v = acc[i][j];
          if (rope && i == 0) {
#pragma unroll
            for (int q = 0; q < 4; q++) {
              float t1 = v[q], t2 = v[q + 4];
              v[q] = t1 * cs[q] - t2 * sn[q];
              v[q + 4] = t2 * cs[q] + t1 * sn[q];
            }
          }
          u16* dst = p.QK() + (((size_t)(kind * 8 + b) * 8 + hc) * SEQ + s) * 64 + d0 + 4 * h;
#pragma unroll
          for (int g = 0; g < 4; g++) {
            uint2 o;
            o.x = pk2(v[4 * g + 0] * scale, v[4 * g + 1] * scale);
            o.y = pk2(v[4 * g + 2] * scale, v[4 * g + 3] * scale);
            *(uint2*)(dst + 8 * g) = o;
          }
        }
      }
    }
  }
}

template <int DV, bool HASF>
DI void attn_pass(const u16* __restrict__ Qg, const u16* __restrict__ Kg, const u16* __restrict__ Vtg,
                  const float* __restrict__ FLg, int q0, char* smem, int tid, f32x16 (&o)[DV / 32]) {
  constexpr int NMB = DV / 32;
  constexpr int KSZ = 64 * 144;
  constexpr int VSZ = DV * 136;
  constexpr int STAGE = KSZ + VSZ + 256;
  constexpr int NVL = DV / 32;
  const int lane = tid & 63, w = tid >> 6, r = lane & 31, h = lane >> 5;
  const int qw0 = q0 + 32 * w;
  const int qcol = qw0 + r;
  const int nkt = (q0 + 128) >> 6;
  bf16x8 qf[4];
#pragma unroll
  for (int ks = 0; ks < 4; ks++) qf[ks] = *(const bf16x8*)(Qg + (size_t)qcol * 64 + 16 * ks + 8 * h);
#pragma unroll
  for (int mb = 0; mb < NMB; mb++)
#pragma unroll
    for (int q = 0; q < 16; q++) o[mb][q] = 0.f;
  float m_run = -INFINITY, lsum = 0.f;

  u32x4 rk[2], rv[NVL];
  f32x4 rf = {0.f, 0.f, 0.f, 0.f};
  auto gload = [&](int kt) {
    const int k0 = kt * 64;
#pragma unroll
    for (int i = 0; i < 2; i++) {
      int idx = tid + 256 * i;
      rk[i] = *(const u32x4*)(Kg + (size_t)(k0 + (idx >> 3)) * 64 + (idx & 7) * 8);
    }
#pragma unroll
    for (int i = 0; i < NVL; i++) {
      int idx = tid + 256 * i;
      rv[i] = *(const u32x4*)(Vtg + (size_t)(idx >> 3) * SEQ + k0 + (idx & 7) * 8);
    }
    if (HASF) {
      if (tid < 16) rf = *(const f32x4*)(FLg + k0 + 4 * tid);
    }
  };
  auto sstore = [&](int stage) {
    char* sK = smem + stage * STAGE;
    char* sV = sK + KSZ;
    float* sF = (float*)(sV + VSZ);
#pragma unroll
    for (int i = 0; i < 2; i++) {
      int idx = tid + 256 * i;
      int row = idx >> 3, c = idx & 7;
      *(u32x4*)(sK + row * 144 + (c << 4)) = rk[i];
    }
#pragma unroll
    for (int i = 0; i < NVL; i++) {
      int idx = tid + 256 * i;
      int row = idx >> 3, c = idx & 7;
      *(u32x2*)(sV + row * 136 + (c << 4)) = u32x2{rv[i].x, rv[i].y};
      *(u32x2*)(sV + row * 136 + (c << 4) + 8) = u32x2{rv[i].z, rv[i].w};
    }
    if (HASF) {
      if (tid < 16) *(f32x4*)(sF + 4 * tid) = rf;
    }
  };

  __syncthreads();
  gload(0);
  sstore(0);
  __syncthreads();
  for (int kt = 0; kt < nkt; kt++) {
    if (kt + 1 < nkt) gload(kt + 1);
    if (kt * 64 <= qw0) {
      const char* sK = smem + (kt & 1) * STAGE;
      const char* sV = sK + KSZ;
      const float* sF = (const float*)(sV + VSZ);
      const char* sKl = sK + r * 144 + h * 16;
      const char* sVl = sV + r * 136 + h * 8;
      f32x16 s[2];
#pragma unroll
      for (int mt = 0; mt < 2; mt++) {
#pragma unroll
        for (int q = 0; q < 16; q++) s[mt][q] = 0.f;
#pragma unroll
        for (int ks = 0; ks < 4; ks++) {
          bf16x8 a = *(const bf16x8*)(sKl + mt * (32 * 144) + ks * 32);
          s[mt] = MFMA32(a, qf[ks], s[mt]);
        }
      }
      if (HASF) {
#pragma unroll
        for (int mt = 0; mt < 2; mt++)
#pragma unroll
          for (int g = 0; g < 4; g++) {
            float4 f = *(const float4*)(sF + 32 * mt + 8 * g + 4 * h);
            s[mt][4 * g + 0] -= f.x;
            s[mt][4 * g + 1] -= f.y;
            s[mt][4 * g + 2] -= f.z;
            s[mt][4 * g + 3] -= f.w;
          }
      }
      if (kt * 64 + 63 > qw0) {
#pragma unroll
        for (int mt = 0; mt < 2; mt++)
#pragma unroll
          for (int q = 0; q < 16; q++) {
            int key = kt * 64 + 32 * mt + (q & 3) + 8 * (q >> 2) + 4 * h;
            s[mt][q] = key > qcol ? -INFINITY : s[mt][q];
          }
      }
      float mx = s[0][0];
#pragma unroll
      for (int mt = 0; mt < 2; mt++)
#pragma unroll
        for (int q = 0; q < 16; q++) mx = fmaxf(mx, s[mt][q]);
      mx = fmaxf(mx, __shfl_xor(mx, 32));
      const float m_new = fmaxf(m_run, mx);
      const float alpha = __builtin_amdgcn_exp2f(m_run - m_new);
      m_run = m_new;
      float ps = 0.f;
#pragma unroll
      for (int mt = 0; mt < 2; mt++)
#pragma unroll
        for (int q = 0; q < 16; q++) {
          float pv = __builtin_amdgcn_exp2f(s[mt][q] - m_new);
          s[mt][q] = pv;
          ps += pv;
        }
      lsum = lsum * alpha + ps;
#pragma unroll
      for (int mb = 0; mb < NMB; mb++)
#pragma unroll
        for (int q = 0; q < 16; q++) o[mb][q] *= alpha;
#pragma unroll
      for (int ks = 0; ks < 4; ks++) {
        const int mt = ks >> 1, q0r = 8 * (ks & 1);
        u32x4 pu;
        pu.x = pk2(s[mt][q0r + 0], s[mt][q0r + 1]);
        pu.y = pk2(s[mt][q0r + 2], s[mt][q0r + 3]);
        pu.z = pk2(s[mt][q0r + 4], s[mt][q0r + 5]);
        pu.w = pk2(s[mt][q0r + 6], s[mt][q0r + 7]);
        bf16x8 pb = __builtin_bit_cast(bf16x8, pu);
#pragma unroll
        for (int mb = 0; mb < NMB; mb++) {
          u32x2 lo = *(const u32x2*)(sVl + mb * (32 * 136) + ks * 32);
          u32x2 hi = *(const u32x2*)(sVl + mb * (32 * 136) + ks * 32 + 16);
          u32x4 au = {lo.x, lo.y, hi.x, hi.y};
          bf16x8 a = __builtin_bit_cast(bf16x8, au);
          o[mb] = MFMA32(a, pb, o[mb]);
        }
      }
    }
    if (kt + 1 < nkt) sstore((kt + 1) & 1);
    __syncthreads();
  }
  float l = lsum + __shfl_xor(lsum, 32);
  const float inv = 1.f / l;
#pragma unroll
  for (int mb = 0; mb < NMB; mb++)
#pragma unroll
    for (int q = 0; q < 16; q++) o[mb][q] *= inv;
}

DI void phase2(const Params& p, char* smem, int tid) {
  asm volatile("" : "+v"(tid));
  const int lane = tid & 63, w = tid >> 6, r = lane & 31, h = lane >> 5;
  __shared__ int s_item;
  float d1 = 0.f, d2 = 0.f;
  for (int i = 0; i < 64; i++) {
    d1 += p.lq1[i] * p.lk1[i];
    d2 += p.lq2[i] * p.lk2[i];
  }
  const float lam = expf(d1) - expf(d2) + 0.2f;
  for (;;) {
    __syncthreads();
    if (tid == 0) s_item = (int)atomicAdd(&p.counters()[0], 1u);
    __syncthreads();
    const int item = s_item;
    if (item >= 1536) break;
    if (item < 512) {
      const int qt = 15 - (item >> 5), bh = item & 31, b = bh >> 2, dh = bh & 3;
      const int q0 = qt * 128;
      const u16* Vtg = p.Vt() + ((size_t)(8 + b) * 512 + dh * 128) * SEQ;
      float* stash = p.stash() + ((size_t)blockIdx.x * NTHREADS + tid) * 64;
      f32x16 o[4];
#pragma unroll 1
      for (int c = 0; c < 2; c++) {
        const u16* Qg = p.QK() + ((size_t)(2 * 8 + b) * 8 + dh * 2 + c) * SEQ * 64;
        const u16* Kg = p.QK() + ((size_t)(3 * 8 + b) * 8 + dh * 2 + c) * SEQ * 64;
        attn_pass<128, false>(Qg, Kg, Vtg, nullptr, q0, smem, tid, o);
        if (c == 0) {
#pragma unroll
          for (int mb = 0; mb < 4; mb++)
#pragma unroll
            for (int q = 0; q < 4; q++)
              *(f32x4*)(stash + mb * 16 + q * 4) = f32x4{o[mb][4 * q], o[mb][4 * q + 1], o[mb][4 * q + 2], o[mb][4 * q + 3]};
        }
      }
      float ss = 0.f;
#pragma unroll
      for (int mb = 0; mb < 4; mb++)
#pragma unroll
        for (int q4 = 0; q4 < 4; q4++) {
          f32x4 sv = *(const f32x4*)(stash + mb * 16 + q4 * 4);
#pragma unroll
          for (int e = 0; e < 4; e++) {
            float a0 = sv[e] - lam * o[mb][4 * q4 + e];
            o[mb][4 * q4 + e] = a0;
            ss += a0 * a0;
          }
        }
      ss += __shfl_xor(ss, 32);
      const float rstd = rsqrtf(ss * (1.f / 128.f) + 1e-5f) * 0.8f;
      const int tok = b * SEQ + q0 + 32 * w + r;
#pragma unroll
      for (int mb = 0; mb < 4; mb++)
#pragma unroll
        for (int g = 0; g < 4; g++) {
          const int d = 32 * mb + 8 * g + 4 * h;
          float4 gs = *(const float4*)(p.g_subln + d);
          uint2 ov;
          ov.x = pk2(o[mb][4 * g + 0] * rstd * gs.x, o[mb][4 * g + 1] * rstd * gs.y);
          ov.y = pk2(o[mb][4 * g + 2] * rstd * gs.z, o[mb][4 * g + 3] * rstd * gs.w);
          *(uint2*)(p.H() + (size_t)tok * DM + 512 + dh * 128 + d) = ov;
        }
    } else {
      const int it = item - 512;
      const int qt = 15 - (it >> 6), bh = it & 63, b = bh >> 3, hd = bh & 7;
      const int q0 = qt * 128;
      const u16* Qg = p.QK() + ((size_t)(0 * 8 + b) * 8 + hd) * SEQ * 64;
      const u16* Kg = p.QK() + ((size_t)(1 * 8 + b) * 8 + hd) * SEQ * 64;
      const u16* Vtg = p.Vt() + ((size_t)(0 + b) * 512 + hd * 64) * SEQ;
      const float* FLg = p.FL() + (b * 8 + hd) * SEQ;
      f32x16 o[2];
      attn_pass<64, true>(Qg, Kg, Vtg, FLg, q0, smem, tid, o);
      const int tok = b * SEQ + q0 + 32 * w + r;
#pragma unroll
      for (int mb = 0; mb < 2; mb++)
#pragma unroll
        for (int g = 0; g < 4; g++) {
          const int d = 32 * mb + 8 * g + 4 * h;
          uint2 ov;
          ov.x = pk2(o[mb][4 * g + 0], o[mb][4 * g + 1]);
          ov.y = pk2(o[mb][4 * g + 2], o[mb][4 * g + 3]);
          *(uint2*)(p.H() + (size_t)tok * DM + hd * 64 + d) = ov;
        }
    }
  }
}

DI void phase3(const Params& p, char* smem, int tid) {
  asm volatile("" : "+v"(tid));
  const int lane = tid & 63, w = tid >> 6, wm = w & 1, wn = w >> 1, r = lane & 31, h = lane >> 5;
  for (int t = blockIdx.x; t < 128 * 8; t += gridDim.x) {
    const int nt = t & 7, mt = t >> 3;
    const int m0 = mt * 128, n0 = nt * 128;
    const int b = m0 >> 11;
    f32x16 acc[2][2];
    gemm_mainloop(p.WtO(), p.H(), n0, m0, smem, tid, acc);
#pragma unroll
    for (int j = 0; j < 2; j++) {
      const int tok = m0 + 64 * wn + 32 * j + r;
#pragma unroll
      for (int i = 0; i < 2; i++)
#pragma unroll
        for (int g = 0; g < 4; g++) {
          const int n = n0 + 64 * wm + 32 * i + 8 * g + 4 * h;
          float4 xv = *(const float4*)(p.x + (size_t)tok * DM + n);
          float4 gt = *(const float4*)(p.mod() + b * 6144 + 2048 + n);
          float4 ov;
          ov.x = xv.x + gt.x * acc[i][j][4 * g + 0];
          ov.y = xv.y + gt.y * acc[i][j][4 * g + 1];
          ov.z = xv.z + gt.z * acc[i][j][4 * g + 2];
          ov.w = xv.w + gt.w * acc[i][j][4 * g + 3];
          *(float4*)(p.out + (size_t)tok * DM + n) = ov;
        }
    }
  }
}

DI void phase3b(const Params& p, int tid) {
  asm volatile("" : "+v"(tid));
  const int lane = tid & 63, w = tid >> 6;
  for (int tok = blockIdx.x * 4 + w; tok < T_TOK; tok += gridDim.x * 4) {
    const int b = tok >> 11;
    const float* xr = p.out + (size_t)tok * DM;
    float4 xv[4];
    float ss = 0.f;
#pragma unroll
    for (int i = 0; i < 4; i++) {
      xv[i] = *(const float4*)(xr + 256 * i + 4 * lane);
      ss += xv[i].x * xv[i].x + xv[i].y * xv[i].y + xv[i].z * xv[i].z + xv[i].w * xv[i].w;
    }
    ss = wave_sum(ss);
    const float rstd = rsqrtf(ss * (1.f / 1024.f) + 1e-6f);
    const float* md = p.mod() + b * 6144;
#pragma unroll
    for (int i = 0; i < 4; i++) {
      const int c0 = 256 * i + 4 * lane;
      float4 g = *(const float4*)(p.g_ffn + c0);
      float4 sh = *(const float4*)(md + 3072 + c0);
      float4 sc = *(const float4*)(md + 4096 + c0);
      uint2 o;
      o.x = pk2(xv[i].x * rstd * g.x * (1.f + sc.x) + sh.x, xv[i].y * rstd * g.y * (1.f + sc.y) + sh.y);
      o.y = pk2(xv[i].z * rstd * g.z * (1.f + sc.z) + sh.z, xv[i].w * rstd * g.w * (1.f + sc.w) + sh.w);
      *(uint2*)(p.H() + (size_t)tok * DM + c0) = o;
    }
  }
}

DI void phase4(const Params& p, char* smem, int tid) {
  asm volatile("" : "+v"(tid));
  const int lane = tid & 63, w = tid >> 6, wm = w & 1, wn = w >> 1, r = lane & 31, h = lane >> 5;
  for (int t = blockIdx.x; t < 128 * 8; t += gridDim.x) {
    const int nt = t & 7, mt = t >> 3;
    const int m0 = mt * 128, n0 = nt * 128;
    f32x16 acc[2][2];
    gemm_mainloop(p.WtPq(), p.H(), n0, m0, smem, tid, acc);
#pragma unroll
    for (int j = 0; j < 2; j++) {
      const int tok = m0 + 64 * wn + 32 * j + r;
#pragma unroll
      for (int i = 0; i < 2; i++)
#pragma unroll
        for (int g = 0; g < 4; g++) {
          const int n = n0 + 64 * wm + 32 * i + 8 * g + 4 * h;
          uint2 o;
          o.x = pk2(acc[i][j][4 * g + 0], acc[i][j][4 * g + 1]);
          o.y = pk2(acc[i][j][4 * g + 2], acc[i][j][4 * g + 3]);
          *(uint2*)(p.Qp() + (size_t)tok * DM + n) = o;
        }
    }
  }
}

template <int N>
struct TR {
  static DI float run(float (&part)[N], int lane) {
    constexpr int H = N / 2;
    float nxt[H];
    const bool up = (lane & H) != 0;
#pragma unroll
    for (int i = 0; i < H; i++) {
      float keep = up ? part[i + H] : part[i];
      float send = up ? part[i] : part[i + H];
      nxt[i] = keep + __shfl_xor(send, H);
    }
    return TR<H>::run(nxt, lane);
  }
};
template <>
struct TR<1> {
  static DI float run(float (&part)[1], int) { return part[0]; }
};

DI int f2key(float f) { int b = __float_as_int(f); return b ^ ((b >> 31) & 0x7fffffff); }
DI float key2f(int k) { return __int_as_float(k ^ ((k >> 31) & 0x7fffffff)); }
DI void insert16(int (&L)[16], int x) {
#pragma unroll
  for (int k = 0; k < 16; k++) {
    int t = max(L[k], x);
    x = min(L[k], x);
    L[k] = t;
  }
}
DI void bitonic_sort16(int (&L)[16]) {
#pragma unroll
  for (int s = 8; s >= 1; s >>= 1)
#pragma unroll
    for (int i = 0; i < 16; i++)
      if ((i & s) == 0) {
        int x = L[i], y = L[i + s];
        L[i] = max(x, y);
        L[i + s] = min(x, y);
      }
}
DI int lookup_byte(int p0, int p1, int p2, int p3, int i) {
  int d = i < 8 ? (i < 4 ? p0 : p1) : (i < 12 ? p2 : p3);
  return (d >> ((i & 3) * 8)) & 255;
}
constexpr int CAND_I[50] = {0,0,0,0,0,0,0,0,0,0,0,0,0,0,0,0,1,1,1,1,1,1,1,1,2,2,2,2,2,3,3,3,3,4,4,4,5,5,6,6,7,7,8,9,10,11,12,13,14,15};
constexpr int CAND_J[50] = {0,1,2,3,4,5,6,7,8,9,10,11,12,13,14,15,0,1,2,3,4,5,6,7,0,1,2,3,4,0,1,2,3,0,1,2,0,1,0,1,0,1,0,0,0,0,0,0,0,0};

DI void phase5(const Params& p, char* smem, int tid) {
  asm volatile("" : "+v"(tid));
  const int lane = tid & 63, w = tid >> 6, r = lane & 31, h = lane >> 5;
  char* skl = smem;
  int* El = (int*)(smem + 36864 + w * 4096);
  float* Gl = (float*)(El + 512);
  __syncthreads();
  for (int i = tid; i < 2 * 128 * 8; i += NTHREADS) {
    const int row = i >> 3, ch = i & 7;
    const float* src = p.sub_keys + (size_t)row * 64 + ch * 8;
    float4 a = *(const float4*)src, b = *(const float4*)(src + 4);
    u32x4 u = {pk2(a.x, a.y), pk2(a.z, a.w), pk2(b.x, b.y), pk2(b.z, b.w)};
    *(u32x4*)(skl + row * 144 + ch * 16) = u;
  }
  __syncthreads();
  const int IMIN = (int)0x80000000;
  for (int grp = blockIdx.x * 4 + w; grp < T_TOK / 4; grp += gridDim.x * 4) {
    const int tok0 = grp * 4;
    int LA[16], LB[16];
    {
      const int tl = r >> 3, hd = r & 7;
      const u16* qsrc = p.Qp() + (size_t)(tok0 + tl) * DM + hd * 128 + 8 * h;
#pragma unroll
      for (int c = 0; c < 2; c++) {
        bf16x8 qb[4];
#pragma unroll
        for (int ks = 0; ks < 4; ks++) qb[ks] = *(const bf16x8*)(qsrc + c * 64 + 16 * ks);
        int L[16];
#pragma unroll
        for (int k = 0; k < 16; k++) L[k] = IMIN;
#pragma unroll
        for (int mt = 0; mt < 4; mt++) {
          f32x16 sc;
#pragma unroll
          for (int q = 0; q < 16; q++) sc[q] = 0.f;
#pragma unroll
          for (int ks = 0; ks < 4; ks++) {
            bf16x8 ska = *(const bf16x8*)(skl + (c * 128 + 32 * mt + r) * 144 + ks * 32 + h * 16);
            sc = MFMA32(ska, qb[ks], sc);
          }
#pragma unroll
          for (int q = 0; q < 16; q++) {
            const int pay = 32 * mt + (q & 3) + 8 * (q >> 2);
            int key = (f2key(sc[q]) & ~127) | pay;
            insert16(L, key);
          }
        }
#pragma unroll
        for (int k = 0; k < 16; k++) {
          if (c == 0) LA[k] = L[k] | (h << 2); else LB[k] = L[k] | (h << 2);
        }
      }
    }
    int M[16];
    {
      int recv[16];
#pragma unroll
      for (int k = 0; k < 16; k++) {
        int send = h ? LA[k] : LB[k];
        recv[k] = __shfl_xor(send, 32);
      }
#pragma unroll
      for (int k = 0; k < 16; k++) {
        int mine = h ? LB[k] : LA[k];
        M[k] = max(mine, recv[15 - k]);
      }
      bitonic_sort16(M);
    }
    int pa0, pa1, pa2, pa3, pb0, pb1, pb2, pb3;
    int F[16];
    {
      float av[16], bv[16];
      int ai[16], bi[16];
#pragma unroll
      for (int k = 0; k < 16; k++) {
        int o = __shfl_xor(M[k], 32);
        int ka = h ? o : M[k];
        int kb = h ? M[k] : o;
        av[k] = key2f(ka);
        bv[k] = key2f(kb);
        ai[k] = ka & 127;
        bi[k] = kb & 127;
      }
      pa0 = ai[0] | (ai[1] << 8) | (ai[2] << 16) | (ai[3] << 24);
      pa1 = ai[4] | (ai[5] << 8) | (ai[6] << 16) | (ai[7] << 24);
      pa2 = ai[8] | (ai[9] << 8) | (ai[10] << 16) | (ai[11] << 24);
      pa3 = ai[12] | (ai[13] << 8) | (ai[14] << 16) | (ai[15] << 24);
      pb0 = bi[0] | (bi[1] << 8) | (bi[2] << 16) | (bi[3] << 24);
      pb1 = bi[4] | (bi[5] << 8) | (bi[6] << 16) | (bi[7] << 24);
      pb2 = bi[8] | (bi[9] << 8) | (bi[10] << 16) | (bi[11] << 24);
      pb3 = bi[12] | (bi[13] << 8) | (bi[14] << 16) | (bi[15] << 24);
      int L[16];
#pragma unroll
      for (int k = 0; k < 16; k++) L[k] = IMIN;
#pragma unroll
      for (int m = 0; m < 25; m++) {
        const int i0 = CAND_I[2 * m], j0 = CAND_J[2 * m], i1 = CAND_I[2 * m + 1], j1 = CAND_J[2 * m + 1];
        float s0 = av[i0] + bv[j0], s1 = av[i1] + bv[j1];
        float s = h ? s1 : s0;
        int pay = h ? ((i1 << 4) | j1) : ((i0 << 4) | j0);
        int key = (f2key(s) & ~255) | pay;
        insert16(L, key);
      }
#pragma unroll
      for (int k = 0; k < 16; k++) {
        int o = __shfl_xor(L[15 - k], 32);
        F[k] = max(L[k], o);
      }
    }
    {
      int mk = F[0];
#pragma unroll
      for (int k = 1; k < 16; k++) mk = max(mk, F[k]);
      const float mx = key2f(mk);
      float ex[8];
      float sm = 0.f;
#pragma unroll
      for (int k = 0; k < 8; k++) {
        ex[k] = __expf(key2f(F[k]) - mx);
        sm += ex[k];
      }
      sm += __shfl_xor(sm, 32);
      const float inv = 1.f / sm;
      int ev[8];
#pragma unroll
      for (int k = 0; k < 8; k++) {
        const int pay = F[k] & 255;
        ev[k] = lookup_byte(pa0, pa1, pa2, pa3, pay >> 4) * 128 + lookup_byte(pb0, pb1, pb2, pb3, pay & 15);
        ex[k] *= inv;
      }
      int* ed = El + r * 16 + 8 * h;
      float* gd = Gl + r * 16 + 8 * h;
      *(u32x4*)ed = u32x4{(unsigned)ev[0], (unsigned)ev[1], (unsigned)ev[2], (unsigned)ev[3]};
      *(u32x4*)(ed + 4) = u32x4{(unsigned)ev[4], (unsigned)ev[5], (unsigned)ev[6], (unsigned)ev[7]};
      *(f32x4*)gd = f32x4{ex[0], ex[1], ex[2], ex[3]};
      *(f32x4*)(gd + 4) = f32x4{ex[4], ex[5], ex[6], ex[7]};
    }
#pragma unroll 1
    for (int tl = 0; tl < 4; tl++) {
      const int tok = tok0 + tl;
      const int b = tok >> 11;
      const u32x4 hq0 = *(const u32x4*)(p.H() + (size_t)tok * DM + 16 * lane);
      const u32x4 hq1 = *(const u32x4*)(p.H() + (size_t)tok * DM + 16 * lane + 8);
      float acc[16];
#pragma unroll
      for (int i = 0; i < 16; i++) acc[i] = 0.f;
#pragma unroll 1
      for (int hd = 0; hd < 8; hd++) {
        const int col = tl * 8 + hd;
        const int evl = El[col * 16 + (lane & 15)];
        const float gvl = Gl[col * 16 + (lane & 15)];
        u32x4 uu[16], vv[16];
#pragma unroll
        for (int k = 0; k < 16; k++) {
          const int e = __builtin_amdgcn_readlane(evl, k);
          uu[k] = *(const u32x4*)(p.Uq() + (size_t)e * DM + 16 * lane);
        }
        float part[16];
#pragma unroll
        for (int k = 0; k < 16; k++) {
          float a = 0.f;
#pragma unroll
          for (int q = 0; q < 4; q++) {
            const unsigned x = uu[k][q];
            const unsigned h0 = q < 2 ? hq0[(2 * q) & 3] : hq1[(2 * q) & 3];
            const unsigned h1 = q < 2 ? hq0[(2 * q + 1) & 3] : hq1[(2 * q + 1) & 3];
            bf16x2_t lo = __builtin_amdgcn_cvt_scalef32_pk_bf16_fp8(x, 1.0f, false);
            bf16x2_t hi = __builtin_amdgcn_cvt_scalef32_pk_bf16_fp8(x, 1.0f, true);
            a = __builtin_amdgcn_fdot2_f32_bf16(lo, __builtin_bit_cast(bf16x2_t, h0), a, false);
            a = __builtin_amdgcn_fdot2_f32_bf16(hi, __builtin_bit_cast(bf16x2_t, h1), a, false);
          }
          part[k] = a;
        }
#pragma unroll
        for (int k = 0; k < 16; k++) {
          const int e = __builtin_amdgcn_readlane(evl, k);
          vv[k] = *(const u32x4*)(p.Vq() + (size_t)e * DM + 16 * lane);
        }
        float av = TR<16>::run(part, lane);
        av += __shfl_xor(av, 16);
        av += __shfl_xor(av, 32);
        av *= (1.f / 64.f);
        const float wv = 0.5f * av * (1.f + erff(av * 0.70710678118654752f)) * gvl * 0.125f;
        const int wsel = __builtin_bit_cast(int, wv);
#pragma unroll
        for (int k = 0; k < 16; k++) {
          const float wj = __builtin_bit_cast(float, __builtin_amdgcn_readlane(wsel, k));
#pragma unroll
          for (int q = 0; q < 4; q++) {
            const unsigned x = vv[k][q];
            f32x2_t lo = __builtin_amdgcn_cvt_pk_f32_fp8(x, false);
            f32x2_t hi = __builtin_amdgcn_cvt_pk_f32_fp8(x, true);
            acc[4 * q + 0] += wj * lo.x;
            acc[4 * q + 1] += wj * lo.y;
            acc[4 * q + 2] += wj * hi.x;
            acc[4 * q + 3] += wj * hi.y;
          }
        }
      }
      float* orow = p.out + (size_t)tok * DM + 16 * lane;
      const float* gt2 = p.mod() + b * 6144 + 5120 + 16 * lane;
      float ss = 0.f;
#pragma unroll
      for (int q = 0; q < 4; q++) {
        f32x4 xv = *(const f32x4*)(orow + 4 * q);
        f32x4 gt = *(const f32x4*)(gt2 + 4 * q);
#pragma unroll
        for (int e = 0; e < 4; e++) {
          float o = xv[e] + gt[e] * acc[4 * q + e];
          acc[4 * q + e] = o;
          ss += o * o;
        }
      }
      ss = wave_sum(ss);
      const float rstd = rsqrtf(ss * (1.f / 1024.f) + 1e-6f);
#pragma unroll
      for (int q = 0; q < 4; q++) {
        f32x4 gf = *(const f32x4*)(p.g_final + 16 * lane + 4 * q);
        f32x4 ov;
#pragma unroll
        for (int e = 0; e < 4; e++) ov[e] = acc[4 * q + e] * rstd * gf[e];
        *(f32x4*)(orow + 4 * q) = ov;
      }
    }
  }
}

__global__ void __launch_bounds__(NTHREADS, 2) fwd_megakernel(Params p) {
  __shared__ __attribute__((aligned(16))) char smem[SMEM_BYTES];
  cg::grid_group grid = cg::this_grid();
  const int tid = threadIdx.x;
  phase0(p, smem, tid);
  grid.sync();
  phase1a(p, smem, tid);
  grid.sync();
  phase_cumsum(p, smem, tid);
  phase1b(p, smem, tid);
  grid.sync();
  phase2(p, smem, tid);
  grid.sync();
  phase3(p, smem, tid);
  grid.sync();
  phase3b(p, tid);
  grid.sync();
  phase4(p, smem, tid);
  grid.sync();
  phase5(p, smem, tid);
}

extern "C" void kernel_launch(void* const* d_in, const int* in_sizes, int n_in, void* d_out, int out_size, void* d_ws,
                              size_t ws_size, hipStream_t stream) {
  static int grid_blocks = 0;
  if (!grid_blocks) {
    int dev = 0, cus = 0, per_cu = 0;
    hipGetDevice(&dev);
    hipDeviceGetAttribute(&cus, hipDeviceAttributeMultiprocessorCount, dev);
    hipOccupancyMaxActiveBlocksPerMultiprocessor(&per_cu, fwd_megakernel, NTHREADS, 0);
    if (per_cu > 2) per_cu = 2;
    if (per_cu < 1) per_cu = 1;
    grid_blocks = cus * per_cu;
  }
  Params p{};
  p.x = (const float*)d_in[0]; p.c = (const float*)d_in[1]; p.w_ada = (const float*)d_in[2]; p.b_ada = (const float*)d_in[3];
  p.g_attn = (const float*)d_in[4]; p.w_in = (const float*)d_in[5]; p.b_f = (const float*)d_in[6];
  p.lq1 = (const float*)d_in[7]; p.lk1 = (const float*)d_in[8]; p.lq2 = (const float*)d_in[9]; p.lk2 = (const float*)d_in[10];
  p.g_subln = (const float*)d_in[11]; p.w_o = (const float*)d_in[12]; p.g_ffn = (const float*)d_in[13];
  p.w_pq = (const float*)d_in[14]; p.sub_keys = (const float*)d_in[15]; p.u_exp = (const float*)d_in[16];
  p.v_exp = (const float*)d_in[17]; p.g_final = (const float*)d_in[18];
  p.out = (float*)d_out;
  p.ws = (char*)d_ws;
  void* args[] = {&p};
  hipError_t e = hipLaunchCooperativeKernel((void*)fwd_megakernel, dim3(grid_blocks), dim3(NTHREADS), args, 0, stream);
  if (e != hipSuccess) fprintf(stderr, "cooperative launch failed: %s (grid %d)\n", hipGetErrorString(e), grid_blocks);
}
```

```cpp
#include <hip/hip_runtime.h>
#include <hip/hip_cooperative_groups.h>
#include <cstdio>
namespace cg = cooperative_groups;

#define DI __device__ __forceinline__
typedef unsigned short u16;
using bf16x8 = __attribute__((ext_vector_type(8))) short;
using f32x16 = __attribute__((ext_vector_type(16))) float;
typedef __bf16 bf16x2_t __attribute__((ext_vector_type(2)));
typedef float f32x2_t __attribute__((ext_vector_type(2)));
using u32x4 = __attribute__((ext_vector_type(4))) unsigned;
using u32x2 = __attribute__((ext_vector_type(2))) unsigned;
using f32x4 = __attribute__((ext_vector_type(4))) float;

#define MFMA32(a, b, c) __builtin_amdgcn_mfma_f32_32x32x16_bf16((a), (b), (c), 0, 0, 0)

static constexpr int T_TOK = 16384;
static constexpr int SEQ = 2048;
static constexpr int DM = 1024;
static constexpr int INC = 3080;
static constexpr float LOG2E = 1.4426950408889634f;
static constexpr int NTHREADS = 256;
static constexpr int SMEM_BYTES = 70656;

struct Params {
  const float *x, *c, *w_ada, *b_ada, *g_attn, *w_in, *b_f, *lq1, *lk1, *lq2, *lk2, *g_subln, *w_o, *g_ffn, *w_pq,
      *sub_keys, *u_exp, *v_exp, *g_final;
  float* out;
  char* ws;
  static constexpr size_t MB = 1024 * 1024;
  DI u16* WtIn() const { return (u16*)(ws + 0 * MB); }
  DI u16* WtO() const { return (u16*)(ws + 6 * MB); }
  DI u16* WtPq() const { return (u16*)(ws + 8 * MB); }
  DI unsigned char* Uq() const { return (unsigned char*)(ws + 10 * MB); }
  DI unsigned char* Vq() const { return (unsigned char*)(ws + 42 * MB); }
  DI u16* H() const { return (u16*)(ws + 74 * MB); }
  DI u16* QK() const { return (u16*)(ws + 106 * MB); }
  DI u16* Vt() const { return (u16*)(ws + 170 * MB); }
  DI u16* Qp() const { return (u16*)(ws + 106 * MB); }
  DI float* mod() const { return (float*)(ws + 202 * MB); }
  DI float* rope() const { return (float*)(ws + 202 * MB + 256 * 1024); }
  DI float* logf() const { return (float*)(ws + 203 * MB); }
  DI float* FL() const { return (float*)(ws + 204 * MB); }
  DI unsigned* counters() const { return (unsigned*)(ws + 205 * MB); }
  DI float* stash() const { return (float*)(ws + 206 * MB); }
  DI unsigned* bar() const { return (unsigned*)(ws + 205 * MB + 4096); }
  DI unsigned* census() const { return (unsigned*)(ws + 205 * MB + 20480); }
  DI float* su() const { return (float*)(ws + 205 * MB + 131072); }
  DI unsigned char* Hq() const { return (unsigned char*)(ws + 170 * MB); }
  DI float* hs() const { return (float*)(ws + 186 * MB); }
  DI unsigned* lbar() const { return (unsigned*)(ws + 205 * MB + 24576); }
  DI int* E() const { return (int*)(ws + 138 * MB); }
  DI float* G() const { return (float*)(ws + 146 * MB); }
  DI float* W() const { return (float*)(ws + 154 * MB); }
};

DI unsigned pk2(float a, float b) {
  f32x2_t v = {a, b};
  bf16x2_t r = __builtin_convertvector(v, bf16x2_t);
  return __builtin_bit_cast(unsigned, r);
}
DI float dot2bf(unsigned a, unsigned b, float c) {
  bf16x2_t x = __builtin_bit_cast(bf16x2_t, a);
  bf16x2_t y = __builtin_bit_cast(bf16x2_t, b);
  return __builtin_amdgcn_fdot2_f32_bf16(x, y, c, false);
}
DI float bf_lo(unsigned u) { return __uint_as_float(u << 16); }
DI float bf_hi(unsigned u) { return __uint_as_float(u & 0xffff0000u); }
#define DPPF0(v, ctrl) __builtin_bit_cast(float, __builtin_amdgcn_mov_dpp(__builtin_bit_cast(int, (v)), (ctrl), 0xf, 0xf, true))
DI float swz16_0(float v) { return __builtin_bit_cast(float, __builtin_amdgcn_ds_swizzle(__builtin_bit_cast(int, v), (16 << 10) | 0x1f)); }
DI float wave_sum(float v) {
  v += DPPF0(v, 0xB1);
  v += DPPF0(v, 0x4E);
  v += DPPF0(v, 0x141);
  v += DPPF0(v, 0x140);
  v += swz16_0(v);
  v += __shfl_xor(v, 32);
  return v;
}
DI float wave_max(float v) {
  v = fmaxf(v, DPPF0(v, 0xB1));
  v = fmaxf(v, DPPF0(v, 0x4E));
  v = fmaxf(v, DPPF0(v, 0x141));
  v = fmaxf(v, DPPF0(v, 0x140));
  v = fmaxf(v, swz16_0(v));
  v = fmaxf(v, __shfl_xor(v, 32));
  return v;
}

DI void transpose_tile(const float* __restrict__ src, int ld, int col0, int k0, u16* __restrict__ dst, int n0, char* smem,
                       int tid) {
  float* t = (float*)smem;
  __syncthreads();
  {
    int cc = tid & 63, r0 = tid >> 6;
#pragma unroll
    for (int i = 0; i < 16; i++) {
      int r = r0 + 4 * i;
      t[r * 65 + cc] = src[(size_t)(k0 + r) * ld + col0 + cc];
    }
  }
  __syncthreads();
#pragma unroll
  for (int i = 0; i < 2; i++) {
    int q = tid + 256 * i;
    int n = q >> 3, kc = q & 7;
    uint4 v;
    v.x = pk2(t[(8 * kc + 0) * 65 + n], t[(8 * kc + 1) * 65 + n]);
    v.y = pk2(t[(8 * kc + 2) * 65 + n], t[(8 * kc + 3) * 65 + n]);
    v.z = pk2(t[(8 * kc + 4) * 65 + n], t[(8 * kc + 5) * 65 + n]);
    v.w = pk2(t[(8 * kc + 6) * 65 + n], t[(8 * kc + 7) * 65 + n]);
    *(uint4*)(dst + (size_t)(n0 + n) * 1024 + k0 + 8 * kc) = v;
  }
}

DI void phase0(const Params& p, char* smem, int tid) {
  asm volatile("" : "+v"(tid));
  const int bid = blockIdx.x, nb = gridDim.x;
  if (bid == 0 && tid == 0) { p.counters()[0] = 0u; p.counters()[1] = 0u; }
  {
    float* sc = (float*)smem;
    float* red = (float*)(smem + 32768);
    bool loaded = false;
    for (int it = bid; it < 192; it += nb) {
      if (!loaded) {
        for (int i = tid; i < 8192; i += NTHREADS) {
          float v = p.c[i];
          sc[i] = v / (1.f + __expf(-v));
        }
        loaded = true;
      }
      __syncthreads();
      int col = it * 32 + (tid & 31), kg = tid >> 5;
      float acc[8];
#pragma unroll
      for (int b = 0; b < 8; b++) acc[b] = 0.f;
#pragma unroll 16
      for (int k = kg * 128; k < kg * 128 + 128; k++) {
        float w = p.w_ada[(size_t)k * 6144 + col];
#pragma unroll
        for (int b = 0; b < 8; b++) acc[b] += sc[b * 1024 + k] * w;
      }
#pragma unroll
      for (int b = 0; b < 8; b++) red[(kg * 8 + b) * 32 + (tid & 31)] = acc[b];
      __syncthreads();
      {
        int b = tid >> 5, cc = tid & 31;
        float s = 0.f;
#pragma unroll
        for (int g = 0; g < 8; g++) s += red[(g * 8 + b) * 32 + cc];
        p.mod()[b * 6144 + it * 32 + cc] = s + p.b_ada[it * 32 + cc];
      }
    }
    __syncthreads();
  }
  for (int it = bid; it < 1280; it += nb) {
    if (it < 768) {
      int nt = it >> 4, kt = it & 15;
      int n0 = nt * 64;
      int col0 = n0 < 1536 ? n0 : n0 + 8;
      transpose_tile(p.w_in, INC, col0, kt * 64, p.WtIn(), n0, smem, tid);
    } else if (it < 1024) {
      int j = it - 768;
      transpose_tile(p.w_o, 1024, (j >> 4) * 64, (j & 15) * 64, p.WtO(), (j >> 4) * 64, smem, tid);
    } else {
      int j = it - 1024;
      transpose_tile(p.w_pq, 1024, (j >> 4) * 64, (j & 15) * 64, p.WtPq(), (j >> 4) * 64, smem, tid);
    }
  }
  for (int e = bid * NTHREADS + tid; e < 2048 * 8; e += nb * NTHREADS) {
    int pos = e >> 3, i = e & 7;
    const double invs[8] = {1.0, 0.19392274474868576, 0.03760603093086393, 0.007292664737217109,
                            0.001414213562373095, 0.0002742481756762073, 5.318295896944988e-05, 1.031338537721246e-05};
    double inv = invs[0];
#pragma unroll
    for (int q = 1; q < 8; q++) inv = (i == q) ? invs[q] : inv;
    double ang = (double)pos * inv;
    double t = ang * 0.15915494309189535;
    t -= rint(t);
    double r = t * 6.283185307179586;
    double r2 = r * r;
    double s = 1.0, c = 1.0;
#pragma unroll
    for (int n = 15; n >= 1; n--) {
      s = 1.0 - s * r2 * (1.0 / (double)((2 * n) * (2 * n + 1)));
      c = 1.0 - c * r2 * (1.0 / (double)((2 * n - 1) * (2 * n)));
    }
    s *= r;
    p.rope()[pos * 16 + i] = (float)c;
    p.rope()[pos * 16 + 8 + i] = (float)s;
  }
}

DI void phase1a(const Params& p, char* smem, int tid, int xl, int xcc, int rank, int cnt) {
  asm volatile("" : "+v"(tid));
  float* wfg = (float*)smem;
  __syncthreads();
#pragma unroll 8
  for (int i = tid; i < 8192; i += NTHREADS) {
    int k = i >> 3, j = i & 7;
    wfg[j * 1024 + k] = p.w_in[(size_t)k * INC + 1536 + j];
  }
  __syncthreads();
  const int lane = tid & 63, w = tid >> 6;
  const int t_lo = xl ? 2048 * xcc + rank * 4 + w : blockIdx.x * 4 + w;
  const int t_hi = xl ? 2048 * (xcc + 1) : T_TOK;
  const int t_st = xl ? cnt * 4 : gridDim.x * 4;
  for (int tok = t_lo; tok < t_hi; tok += t_st) {
    const int b = tok >> 11, s = tok & 2047;
    const float* xr = p.x + (size_t)tok * DM;
    float4 xv[4];
    float ss = 0.f;
#pragma unroll
    for (int i = 0; i < 4; i++) {
      xv[i] = *(const float4*)(xr + 256 * i + 4 * lane);
      ss += xv[i].x * xv[i].x + xv[i].y * xv[i].y + xv[i].z * xv[i].z + xv[i].w * xv[i].w;
    }
    ss = wave_sum(ss);
    const float rstd = rsqrtf(ss * (1.f / 1024.f) + 1e-6f);
    const float* md = p.mod() + b * 6144;
    float fg[8];
#pragma unroll
    for (int j = 0; j < 8; j++) fg[j] = 0.f;
#pragma unroll
    for (int i = 0; i < 4; i++) {
      const int c0 = 256 * i + 4 * lane;
      float4 g = *(const float4*)(p.g_attn + c0);
      float4 sh = *(const float4*)(md + c0);
      float4 sc = *(const float4*)(md + 1024 + c0);
      float4 h;
      h.x = xv[i].x * rstd * g.x * (1.f + sc.x) + sh.x;
      h.y = xv[i].y * rstd * g.y * (1.f + sc.y) + sh.y;
      h.z = xv[i].z * rstd * g.z * (1.f + sc.z) + sh.z;
      h.w = xv[i].w * rstd * g.w * (1.f + sc.w) + sh.w;
      uint2 o;
      o.x = pk2(h.x, h.y); o.y = pk2(h.z, h.w);
      *(uint2*)(p.H() + (size_t)tok * DM + c0) = o;
#pragma unroll
      for (int j = 0; j < 8; j++) {
        float4 wv = *(const float4*)(wfg + j * 1024 + c0);
        fg[j] += h.x * wv.x + h.y * wv.y + h.z * wv.z + h.w * wv.w;
      }
    }
#pragma unroll
    for (int j = 0; j < 8; j++) fg[j] = wave_sum(fg[j]);
    float z = fg[0];
#pragma unroll
    for (int j = 1; j < 8; j++) z = (lane == j) ? fg[j] : z;
    if (lane < 8) {
      z += p.b_f[lane];
      float ls = fminf(z, 0.f) - log1pf(__expf(-fabsf(z)));
      p.logf()[(b * 8 + lane) * SEQ + s] = ls;
    }
  }
}

DI void phase_cumsum(const Params& p, char* smem, int tid, int xl, int xcc, int rank, int cnt) {
  asm volatile("" : "+v"(tid));
  double* part = (double*)smem;
  const int s_lo = xl ? 8 * xcc + rank : blockIdx.x;
  const int s_hi = xl ? 8 * (xcc + 1) : 64;
  const int s_st = xl ? cnt : gridDim.x;
  for (int seq = s_lo; seq < s_hi; seq += s_st) {
    __syncthreads();
    const float* lf = p.logf() + seq * SEQ + tid * 8;
    float4 a = *(const float4*)lf, b = *(const float4*)(lf + 4);
    double v0 = a.x, v1 = v0 + a.y, v2 = v1 + a.z, v3 = v2 + a.w, v4 = v3 + b.x, v5 = v4 + b.y, v6 = v5 + b.z, v7 = v6 + b.w;
    double run = v7;
    part[tid] = run;
    __syncthreads();
#pragma unroll 1
    for (int off = 1; off < 256; off <<= 1) {
      const double add = tid >= off ? part[tid - off] : 0.0;
      __syncthreads();
      part[tid] += add;
      __syncthreads();
    }
    const double pre = part[tid] - run;
    const double L2E = 1.4426950408889634;
    float* dst = p.FL() + seq * SEQ + tid * 8;
    *(float4*)dst = make_float4((float)((v0 + pre) * L2E), (float)((v1 + pre) * L2E), (float)((v2 + pre) * L2E), (float)((v3 + pre) * L2E));
    *(float4*)(dst + 4) = make_float4((float)((v4 + pre) * L2E), (float)((v5 + pre) * L2E), (float)((v6 + pre) * L2E), (float)((v7 + pre) * L2E));
  }
  __syncthreads();
}

DI void gemm_mainloop(const u16* __restrict__ Lg, const u16* __restrict__ Rg, int l0, int r0, char* smem, int tid,
                      f32x16 (&acc)[2][2]) {
  const int lane = tid & 63, w = tid >> 6;
  const int wm = w & 1, wn = w >> 1;
  const int r = lane & 31, h = lane >> 5;
  const int lc = tid & 7, lr = tid >> 3;
  const int sw = ((lr >> 1) & 7);
#pragma unroll
  for (int i = 0; i < 2; i++)
#pragma unroll
    for (int j = 0; j < 2; j++)
#pragma unroll
      for (int q = 0; q < 16; q++) acc[i][j][q] = 0.f;
  u32x4 ra0[4], rb0[4], ra1[4], rb1[4];
  const u16* lp = Lg + (size_t)(l0 + lr) * 1024 + lc * 8;
  const u16* rp = Rg + (size_t)(r0 + lr) * 1024 + lc * 8;
#define GLOAD(RA, RB, KT)                                                          \
  _Pragma("unroll") for (int i = 0; i < 4; i++) {                                  \
    RA[i] = *(const u32x4*)(lp + (size_t)i * 32 * 1024 + (KT) * 64);               \
    RB[i] = *(const u32x4*)(rp + (size_t)i * 32 * 1024 + (KT) * 64);               \
  }
#define SSTORE(RA, RB, BUF)                                                        \
  {                                                                                \
    char* dL = smem + (BUF) * 32768;                                               \
    char* dR = dL + 16384;                                                         \
    _Pragma("unroll") for (int i = 0; i < 4; i++) {                                \
      int off = (lr + 32 * i) * 128 + ((lc ^ sw) << 4);                            \
      *(u32x4*)(dL + off) = RA[i];                                                 \
      *(u32x4*)(dR + off) = RB[i];                                                 \
    }                                                                              \
  }
#define COMPUTE(BUF)                                                               \
  {                                                                                \
    const char* sL = smem + (BUF) * 32768;                                         \
    const char* sR = sL + 16384;                                                   \
    _Pragma("unroll") for (int ks = 0; ks < 4; ks++) {                             \
      bf16x8 a[2], b[2];                                                           \
      _Pragma("unroll") for (int i = 0; i < 2; i++) {                              \
        int row = 64 * wm + 32 * i + r;                                            \
        a[i] = *(const bf16x8*)(sL + row * 128 + (((2 * ks + h) ^ ((row >> 1) & 7)) << 4));   \
        int rowb = 64 * wn + 32 * i + r;                                           \
        b[i] = *(const bf16x8*)(sR + rowb * 128 + (((2 * ks + h) ^ ((rowb >> 1) & 7)) << 4)); \
      }                                                                            \
      _Pragma("unroll") for (int i = 0; i < 2; i++)                                \
        _Pragma("unroll") for (int j = 0; j < 2; j++) acc[i][j] = MFMA32(a[i], b[j], acc[i][j]); \
    }                                                                              \
  }
  GLOAD(ra0, rb0, 0)
  GLOAD(ra1, rb1, 1)
  __syncthreads();
  SSTORE(ra0, rb0, 0)
  GLOAD(ra0, rb0, 2)
  __syncthreads();
#pragma unroll 1
  for (int kt = 0; kt < 16; kt += 2) {
    COMPUTE(0)
    SSTORE(ra1, rb1, 1)
    if (kt + 3 < 16) { GLOAD(ra1, rb1, kt + 3) }
    __syncthreads();
    COMPUTE(1)
    if (kt + 2 < 16) {
      SSTORE(ra0, rb0, 0)
      if (kt + 4 < 16) { GLOAD(ra0, rb0, kt + 4) }
    }
    __syncthreads();
  }
#undef GLOAD
#undef SSTORE
#undef COMPUTE
}

struct TileWalk { int start, stride, total; bool xl; int xcc; };
DI TileWalk tile_walk(const Params& p, int xcc, int rank, int ntiles) {
  TileWalk tw;
  bool all = true;
  int mine = 1;
#pragma unroll
  for (int j = 0; j < 8; j++) {
    const int cj = (int)p.census()[64 * j];
    all = all && (cj > 0);
    mine = (j == xcc) ? cj : mine;
  }
  tw.xl = all;
  tw.xcc = xcc;
  tw.start = all ? rank : (int)blockIdx.x;
  tw.stride = all ? mine : (int)gridDim.x;
  tw.total = all ? ntiles / 8 : ntiles;
  return tw;
}
DI void tile_of(const TileWalk& tw, int q, int nn, int& mt, int& nt) {
  if (tw.xl) {
    const int b2 = q >> 6, wi = q & 63;
    const int mi = wi & 7, ni = wi >> 3;
    const int mb = (b2 == 1 || b2 == 2 || b2 == 5) ? 1 : 0;
    const int nb = nn == 24 ? (b2 >> 1) : 0;
    mt = 16 * tw.xcc + 8 * mb + mi;
    nt = 8 * nb + ni;
  } else {
    nt = q % nn;
    mt = q / nn;
  }
}

DI void phase1b(const Params& p, char* smem, int tid, int xcc, int rank) {
  asm volatile("" : "+v"(tid));
  const int lane = tid & 63, w = tid >> 6, wm = w & 1, wn = w >> 1, r = lane & 31, h = lane >> 5;
  const TileWalk tw = tile_walk(p, xcc, rank, 128 * 24);
  for (int t = tw.start; t < tw.total; t += tw.stride) {
    int nt, mt;
    tile_of(tw, t, 24, mt, nt);
    const int m0 = mt * 128, n0 = nt * 128;
    const int b = m0 >> 11, s0 = m0 & 2047;
    const int seg = nt >> 2;
    f32x16 acc[2][2];
    if (seg == 2 || seg == 5) {
      gemm_mainloop(p.H(), p.WtIn(), m0, n0, smem, tid, acc);
      const int kind = seg == 2 ? 0 : 1;
      const int colbase = n0 - (seg == 2 ? 1024 : 2560);
#pragma unroll
      for (int i = 0; i < 2; i++)
#pragma unroll
        for (int j = 0; j < 2; j++) {
          int col = colbase + 64 * wn + 32 * j + r;
          u16* dst = p.Vt() + ((size_t)(kind * 8 + b) * 512 + col) * SEQ + s0 + 64 * wm + 32 * i + 4 * h;
#pragma unroll
          for (int g = 0; g < 4; g++) {
            uint2 o;
            o.x = pk2(acc[i][j][4 * g + 0], acc[i][j][4 * g + 1]);
            o.y = pk2(acc[i][j][4 * g + 2], acc[i][j][4 * g + 3]);
            *(uint2*)(dst + 8 * g) = o;
          }
        }
    } else {
      gemm_mainloop(p.WtIn(), p.H(), n0, m0, smem, tid, acc);
      const int kind = seg == 0 ? 0 : seg == 1 ? 1 : seg == 3 ? 2 : 3;
      if (seg == 1) {
        float mk = 0.f;
#pragma unroll
        for (int i = 0; i < 2; i++)
#pragma unroll
          for (int j = 0; j < 2; j++)
#pragma unroll
            for (int q = 0; q < 16; q++) mk = fmaxf(mk, fabsf(acc[i][j][q]));
        mk = wave_max(mk);
        if (lane == 0) atomicMax(&p.counters()[64 + b * 8 + ((n0 - 512 + 64 * wm) >> 6)], __float_as_uint(mk));
      }
      const int colbase = n0 - (seg == 0 ? 0 : seg == 1 ? 512 : seg == 3 ? 1536 : 2048);
      const bool rope = (seg >= 3);
      const float scale = (seg == 0 || seg == 3) ? 0.125f * LOG2E : 1.f;
#pragma unroll
      for (int j = 0; j < 2; j++) {
        const int s = s0 + 64 * wn + 32 * j + r;
        f32x4 cs = {1.f, 1.f, 1.f, 1.f}, sn = {0.f, 0.f, 0.f, 0.f};
        if (rope) {
          cs = *(const f32x4*)(p.rope() + s * 16 + 4 * h);
          sn = *(const f32x4*)(p.rope() + s * 16 + 8 + 4 * h);
        }
#pragma unroll
        for (int i = 0; i < 2; i++) {
          const int colt = colbase + 64 * wm + 32 * i;
          const int hc = colt >> 6, d0 = colt & 63;
          f32x16 v = acc[i][j];
          if (rope && i == 0) {
#pragma unroll
            for (int q = 0; q < 4; q++) {
              float t1 = v[q], t2 = v[q + 4];
              v[q] = t1 * cs[q] - t2 * sn[q];
              v[q + 4] = t2 * cs[q] + t1 * sn[q];
            }
          }
          u16* dst = p.QK() + (((size_t)(kind * 8 + b) * 8 + hc) * SEQ + s) * 64 + d0 + 4 * h;
#pragma unroll
          for (int g = 0; g < 4; g++) {
            uint2 o;
            o.x = pk2(v[4 * g + 0] * scale, v[4 * g + 1] * scale);
            o.y = pk2(v[4 * g + 2] * scale, v[4 * g + 3] * scale);
            *(uint2*)(dst + 8 * g) = o;
          }
        }
      }
    }
  }
}

template <int DV, bool HASF>
DI void attn_pass(const u16* __restrict__ Qg, const u16* __restrict__ Kg, const u16* __restrict__ Vtg,
                  const float* __restrict__ FLg, int q0, char* smem, int tid, f32x16 (&o)[DV / 32], float kmax = 0.f) {
  constexpr int NMB = DV / 32;
  constexpr int KSZ = 64 * 144;
  constexpr int VSZ = DV * 136;
  constexpr int STAGE = KSZ + VSZ + 256;
  constexpr int NVL = DV / 32;
  const int lane = tid & 63, w = tid >> 6, r = lane & 31, h = lane >> 5;
  const int qw0 = q0 + 32 * w;
  const int qcol = qw0 + r;
  const int nkt = (q0 + 128) >> 6;
  bf16x8 qf[4];
#pragma unroll
  for (int ks = 0; ks < 4; ks++) qf[ks] = *(const bf16x8*)(Qg + (size_t)qcol * 64 + 16 * ks + 8 * h);
#pragma unroll
  for (int mb = 0; mb < NMB; mb++)
#pragma unroll
    for (int q = 0; q < 16; q++) o[mb][q] = 0.f;
  float m_run = -INFINITY, lsum = 0.f;

  u32x4 rk[2], rv[NVL];
  f32x4 rf = {0.f, 0.f, 0.f, 0.f};
  auto gloadK = [&](int kt) {
    const int k0 = kt * 64;
#pragma unroll
    for (int i = 0; i < 2; i++) {
      int idx = tid + 256 * i;
      rk[i] = *(const u32x4*)(Kg + (size_t)(k0 + (idx >> 3)) * 64 + (idx & 7) * 8);
    }
    if (HASF) {
      if (tid < 16) rf = *(const f32x4*)(FLg + k0 + 4 * tid);
    }
  };
  auto gloadV = [&](int kt) {
    const int k0 = kt * 64;
#pragma unroll
    for (int i = 0; i < NVL; i++) {
      int idx = tid + 256 * i;
      rv[i] = *(const u32x4*)(Vtg + (size_t)(idx >> 3) * SEQ + k0 + (idx & 7) * 8);
    }
  };
  auto gload = [&](int kt) { gloadK(kt); gloadV(kt); };
  auto sstore = [&](int stage) {
    char* sK = smem + stage * STAGE;
    char* sV = sK + KSZ;
    float* sF = (float*)(sV + VSZ);
#pragma unroll
    for (int i = 0; i < 2; i++) {
      int idx = tid + 256 * i;
      int row = idx >> 3, c = idx & 7;
      *(u32x4*)(sK + row * 144 + (c << 4)) = rk[i];
    }
#pragma unroll
    for (int i = 0; i < NVL; i++) {
      int idx = tid + 256 * i;
      int row = idx >> 3, c = idx & 7;
      *(u32x2*)(sV + row * 136 + (c << 4)) = u32x2{rv[i].x, rv[i].y};
      *(u32x2*)(sV + row * 136 + (c << 4) + 8) = u32x2{rv[i].z, rv[i].w};
    }
    if (HASF) {
      if (tid < 16) *(f32x4*)(sF + 4 * tid) = rf;
    }
  };

  float qb = 0.f;
  bool done = false;
  if (HASF) {
#pragma unroll
    for (int ks = 0; ks < 4; ks++)
#pragma unroll
      for (int j = 0; j < 8; j++) {
        const unsigned short qs = (unsigned short)qf[ks][j];
        qb += fabsf(__uint_as_float(((unsigned)qs) << 16));
      }
    qb += __shfl_xor(qb, 32);
    qb *= kmax;
  }
  __syncthreads();
  gload(HASF ? nkt - 1 : 0);
  sstore(0);
  __syncthreads();
  for (int jt = 0; jt < nkt; jt++) {
    const int kt = HASF ? nkt - 1 - jt : jt;
    const int ktn = HASF ? kt - 1 : kt + 1;
    if (jt + 1 < nkt) { gloadK(ktn); gloadV(ktn); }
    if (HASF) {
      if (kt * 64 <= qw0 && !done) {
        const float flast = ((const float*)(smem + (jt & 1) * STAGE + KSZ + VSZ))[63];
        const bool keep = !(qb - flast < m_run - 40.f);
        if (__ballot(keep) == 0ull) done = true;
      }
    }
    if (kt * 64 <= qw0 && !done) {
      const char* sK = smem + (jt & 1) * STAGE;
      const char* sV = sK + KSZ;
      const float* sF = (const float*)(sV + VSZ);
      const char* sKl = sK + r * 144 + h * 16;
      const char* sVl = sV + r * 136 + h * 8;
      f32x16 s[2];
#pragma unroll
      for (int mt = 0; mt < 2; mt++) {
#pragma unroll
        for (int q = 0; q < 16; q++) s[mt][q] = 0.f;
#pragma unroll
        for (int ks = 0; ks < 4; ks++) {
          bf16x8 a = *(const bf16x8*)(sKl + mt * (32 * 144) + ks * 32);
          s[mt] = MFMA32(a, qf[ks], s[mt]);
        }
      }
      if (HASF) {
#pragma unroll
        for (int mt = 0; mt < 2; mt++)
#pragma unroll
          for (int g = 0; g < 4; g++) {
            float4 f = *(const float4*)(sF + 32 * mt + 8 * g + 4 * h);
            s[mt][4 * g + 0] -= f.x;
            s[mt][4 * g + 1] -= f.y;
            s[mt][4 * g + 2] -= f.z;
            s[mt][4 * g + 3] -= f.w;
          }
      }
      if (kt * 64 + 63 > qw0) {
#pragma unroll
        for (int mt = 0; mt < 2; mt++)
#pragma unroll
          for (int q = 0; q < 16; q++) {
            int key = kt * 64 + 32 * mt + (q & 3) + 8 * (q >> 2) + 4 * h;
            s[mt][q] = key > qcol ? -INFINITY : s[mt][q];
          }
      }
      float mx = s[0][0];
#pragma unroll
      for (int mt = 0; mt < 2; mt++)
#pragma unroll
        for (int q = 0; q < 16; q++) mx = fmaxf(mx, s[mt][q]);
      mx = fmaxf(mx, __shfl_xor(mx, 32));
      const float m_new = fmaxf(m_run, mx);
      const float alpha = __builtin_amdgcn_exp2f(m_run - m_new);
      m_run = m_new;
      float ps = 0.f;
#pragma unroll
      for (int mt = 0; mt < 2; mt++)
#pragma unroll
        for (int q = 0; q < 16; q++) {
          float pv = __builtin_amdgcn_exp2f(s[mt][q] - m_new);
          s[mt][q] = pv;
          ps += pv;
        }
      lsum = lsum * alpha + ps;
#pragma unroll
      for (int mb = 0; mb < NMB; mb++)
#pragma unroll
        for (int q = 0; q < 16; q++) o[mb][q] *= alpha;
#pragma unroll
      for (int ks = 0; ks < 4; ks++) {
        const int mt = ks >> 1, q0r = 8 * (ks & 1);
        u32x4 pu;
        pu.x = pk2(s[mt][q0r + 0], s[mt][q0r + 1]);
        pu.y = pk2(s[mt][q0r + 2], s[mt][q0r + 3]);
        pu.z = pk2(s[mt][q0r + 4], s[mt][q0r + 5]);
        pu.w = pk2(s[mt][q0r + 6], s[mt][q0r + 7]);
        bf16x8 pb = __builtin_bit_cast(bf16x8, pu);
#pragma unroll
        for (int mb = 0; mb < NMB; mb++) {
          u32x2 lo = *(const u32x2*)(sVl + mb * (32 * 136) + ks * 32);
          u32x2 hi = *(const u32x2*)(sVl + mb * (32 * 136) + ks * 32 + 16);
          u32x4 au = {lo.x, lo.y, hi.x, hi.y};
          bf16x8 a = __builtin_bit_cast(bf16x8, au);
          o[mb] = MFMA32(a, pb, o[mb]);
        }
      }
    }
    if (jt + 1 < nkt) { sstore((jt + 1) & 1); }
    if (HASF) {
      if (!__syncthreads_or(done ? 0 : 1)) break;
    } else {
      __syncthreads();
    }
  }
  float l = lsum + __shfl_xor(lsum, 32);
  const float inv = 1.f / l;
#pragma unroll
  for (int mb = 0; mb < NMB; mb++)
#pragma unroll
    for (int q = 0; q < 16; q++) o[mb][q] *= inv;
}

DI unsigned pack_i8x4(float a, float b, float c, float d) {
  const int q0 = (int)rintf(a), q1 = (int)rintf(b), q2 = (int)rintf(c), q3 = (int)rintf(d);
  return (unsigned)(q0 & 255) | ((unsigned)(q1 & 255) << 8) | ((unsigned)(q2 & 255) << 16) | ((unsigned)(q3 & 255) << 24);
}
DI void convert_chunk(const Params& p, int c, int tid) {
  const size_t ngroups = (size_t)16384 * 1024 / 16;
#pragma unroll 4
  for (int i = 0; i < 16; i++) {
    const size_t g = (size_t)c * 4096 + (size_t)i * NTHREADS + tid;
    const bool isu = g < ngroups;
    if (isu) {
      const float* src = p.u_exp + g * 16;
      float4 x[4];
      float mx = 0.f;
#pragma unroll
      for (int q = 0; q < 4; q++) {
        x[q] = *(const float4*)(src + 4 * q);
        mx = fmaxf(mx, fmaxf(fmaxf(fabsf(x[q].x), fabsf(x[q].y)), fmaxf(fabsf(x[q].z), fabsf(x[q].w))));
      }
      mx = wave_max(mx);
      const float inv = mx > 0.f ? 127.f / mx : 0.f;
      u32x4 v;
#pragma unroll
      for (int q = 0; q < 4; q++) v[q] = pack_i8x4(x[q].x * inv, x[q].y * inv, x[q].z * inv, x[q].w * inv);
      *(u32x4*)(p.Uq() + g * 16) = v;
      if ((tid & 63) == 0) p.su()[g >> 6] = mx * (1.f / 127.f);
    } else {
      const size_t gv = g - ngroups;
      const float* src = p.v_exp + gv * 16;
      const size_t e = gv >> 6, d = (gv & 63) * 16;
      unsigned char* dst = p.Vq() + (d >> 7) * ((size_t)16384 * 128) + e * 128 + (d & 127);
      u32x4 v;
#pragma unroll
      for (int q = 0; q < 4; q++) {
        float4 a = *(const float4*)(src + 4 * q);
        unsigned wv = 0;
        wv = __builtin_amdgcn_cvt_pk_fp8_f32(a.x * 8.f, a.y * 8.f, wv, false);
        wv = __builtin_amdgcn_cvt_pk_fp8_f32(a.z * 8.f, a.w * 8.f, wv, true);
        v[q] = wv;
      }
      *(u32x4*)dst = v;
    }
  }
}

DI void phase2(const Params& p, char* smem, int tid, int xl, int xcc) {
  asm volatile("" : "+v"(tid));
  const int lane = tid & 63, w = tid >> 6, r = lane & 31, h = lane >> 5;
  __shared__ int s_item;
  for (;;) {
    __syncthreads();
    if (tid == 0) s_item = (int)atomicAdd(&p.counters()[xl ? 256 + 64 * xcc : 0], 1u);
    __syncthreads();
    const int qi = s_item;
    if (qi >= (xl ? 256 : 2048)) break;
    if ((qi & 3) == 3) {
      convert_chunk(p, xl ? (qi >> 2) * 8 + xcc : (qi >> 2), tid);
      continue;
    }
    int item = (qi >> 2) * 3 + (qi & 3);
    int tid_i = threadIdx.x;
    asm volatile("" : "+v"(tid_i));
    if (xl) {
      const int li = item;
      if (li < 64) item = ((li >> 2) << 5) | (xcc << 2) | (li & 3);
      else { const int lf = li - 64; item = 512 + (((lf >> 3) << 6) | (xcc << 3) | (lf & 7)); }
    }
    if (item < 512) {
      const int qt = 15 - (item >> 5), bh = item & 31, b = bh >> 2, dh = bh & 3;
      const int q0 = qt * 128;
      const u16* Vtg = p.Vt() + ((size_t)(8 + b) * 512 + dh * 128) * SEQ;
      float* stash = p.stash() + ((size_t)blockIdx.x * NTHREADS + tid) * 64;
      f32x16 o[4];
#pragma unroll 1
      for (int c = 0; c < 2; c++) {
        const u16* Qg = p.QK() + ((size_t)(2 * 8 + b) * 8 + dh * 2 + c) * SEQ * 64;
        const u16* Kg = p.QK() + ((size_t)(3 * 8 + b) * 8 + dh * 2 + c) * SEQ * 64;
        attn_pass<128, false>(Qg, Kg, Vtg, nullptr, q0, smem, tid_i, o);
        if (c == 0) {
#pragma unroll
          for (int mb = 0; mb < 4; mb++)
#pragma unroll
            for (int q = 0; q < 4; q++)
              *(f32x4*)(stash + mb * 16 + q * 4) = f32x4{o[mb][4 * q], o[mb][4 * q + 1], o[mb][4 * q + 2], o[mb][4 * q + 3]};
        }
      }
      float d1 = 0.f, d2 = 0.f;
      for (int i = 0; i < 64; i++) {
        d1 += p.lq1[i] * p.lk1[i];
        d2 += p.lq2[i] * p.lk2[i];
      }
      const float lam = expf(d1) - expf(d2) + 0.2f;
      float ss = 0.f;
#pragma unroll
      for (int mb = 0; mb < 4; mb++)
#pragma unroll
        for (int q4 = 0; q4 < 4; q4++) {
          f32x4 sv = *(const f32x4*)(stash + mb * 16 + q4 * 4);
#pragma unroll
          for (int e = 0; e < 4; e++) {
            float a0 = sv[e] - lam * o[mb][4 * q4 + e];
            o[mb][4 * q4 + e] = a0;
            ss += a0 * a0;
          }
        }
      ss += __shfl_xor(ss, 32);
      const float rstd = rsqrtf(ss * (1.f / 128.f) + 1e-5f) * 0.8f;
      const int tok = b * SEQ + q0 + 32 * w + r;
#pragma unroll
      for (int mb = 0; mb < 4; mb++)
#pragma unroll
        for (int g = 0; g < 4; g++) {
          const int d = 32 * mb + 8 * g + 4 * h;
          float4 gs = *(const float4*)(p.g_subln + d);
          uint2 ov;
          ov.x = pk2(o[mb][4 * g + 0] * rstd * gs.x, o[mb][4 * g + 1] * rstd * gs.y);
          ov.y = pk2(o[mb][4 * g + 2] * rstd * gs.z, o[mb][4 * g + 3] * rstd * gs.w);
          *(uint2*)(p.H() + (size_t)tok * DM + 512 + dh * 128 + d) = ov;
        }
    } else {
      const int it = item - 512;
      const int qt = 15 - (it >> 6), bh = it & 63, b = bh >> 3, hd = bh & 7;
      const int q0 = qt * 128;
      const u16* Qg = p.QK() + ((size_t)(0 * 8 + b) * 8 + hd) * SEQ * 64;
      const u16* Kg = p.QK() + ((size_t)(1 * 8 + b) * 8 + hd) * SEQ * 64;
      const u16* Vtg = p.Vt() + ((size_t)(0 + b) * 512 + hd * 64) * SEQ;
      const float* FLg = p.FL() + (b * 8 + hd) * SEQ;
      f32x16 o[2];
      attn_pass<64, true>(Qg, Kg, Vtg, FLg, q0, smem, tid_i, o, __uint_as_float(p.counters()[64 + b * 8 + hd]) * 1.01f);
      const int tok = b * SEQ + q0 + 32 * w + r;
#pragma unroll
      for (int mb = 0; mb < 2; mb++)
#pragma unroll
        for (int g = 0; g < 4; g++) {
          const int d = 32 * mb + 8 * g + 4 * h;
          uint2 ov;
          ov.x = pk2(o[mb][4 * g + 0], o[mb][4 * g + 1]);
          ov.y = pk2(o[mb][4 * g + 2], o[mb][4 * g + 3]);
          *(uint2*)(p.H() + (size_t)tok * DM + hd * 64 + d) = ov;
        }
    }
  }
}

DI void phase3(const Params& p, char* smem, int tid, int xcc, int rank) {
  asm volatile("" : "+v"(tid));
  const int lane = tid & 63, w = tid >> 6, wm = w & 1, wn = w >> 1, r = lane & 31, h = lane >> 5;
  const TileWalk tw = tile_walk(p, xcc, rank, 128 * 8);
  for (int t = tw.start; t < tw.total; t += tw.stride) {
    int nt, mt;
    tile_of(tw, t, 8, mt, nt);
    const int m0 = mt * 128, n0 = nt * 128;
    const int b = m0 >> 11;
    f32x16 acc[2][2];
    gemm_mainloop(p.WtO(), p.H(), n0, m0, smem, tid, acc);
#pragma unroll
    for (int j = 0; j < 2; j++) {
      const int tok = m0 + 64 * wn + 32 * j + r;
#pragma unroll
      for (int i = 0; i < 2; i++)
#pragma unroll
        for (int g = 0; g < 4; g++) {
          const int n = n0 + 64 * wm + 32 * i + 8 * g + 4 * h;
          float4 xv = *(const float4*)(p.x + (size_t)tok * DM + n);
          float4 gt = *(const float4*)(p.mod() + b * 6144 + 2048 + n);
          float4 ov;
          ov.x = xv.x + gt.x * acc[i][j][4 * g + 0];
          ov.y = xv.y + gt.y * acc[i][j][4 * g + 1];
          ov.z = xv.z + gt.z * acc[i][j][4 * g + 2];
          ov.w = xv.w + gt.w * acc[i][j][4 * g + 3];
          *(float4*)(p.out + (size_t)tok * DM + n) = ov;
        }
    }
  }
}

DI void phase3b(const Params& p, int tid, int xl, int xcc, int rank, int cnt) {
  asm volatile("" : "+v"(tid));
  const int lane = tid & 63, w = tid >> 6;
  const int t_lo = xl ? 2048 * xcc + (rank * 4 + w) * 2 : (blockIdx.x * 4 + w) * 2;
  const int t_hi = xl ? 2048 * (xcc + 1) : T_TOK;
  const int t_st = xl ? cnt * 8 : gridDim.x * 8;
  for (int tok = t_lo; tok < t_hi; tok += t_st) {
    const int b = tok >> 11;
    const float* xr = p.out + (size_t)tok * DM;
    float4 xv[2][4];
    float ss[2] = {0.f, 0.f};
#pragma unroll
    for (int t = 0; t < 2; t++)
#pragma unroll
      for (int i = 0; i < 4; i++) xv[t][i] = *(const float4*)(xr + t * DM + 256 * i + 4 * lane);
#pragma unroll
    for (int t = 0; t < 2; t++)
#pragma unroll
      for (int i = 0; i < 4; i++)
        ss[t] += xv[t][i].x * xv[t][i].x + xv[t][i].y * xv[t][i].y + xv[t][i].z * xv[t][i].z + xv[t][i].w * xv[t][i].w;
    ss[0] = wave_sum(ss[0]);
    ss[1] = wave_sum(ss[1]);
    const float rstd0 = rsqrtf(ss[0] * (1.f / 1024.f) + 1e-6f);
    const float rstd1 = rsqrtf(ss[1] * (1.f / 1024.f) + 1e-6f);
    const float* md = p.mod() + b * 6144;
#pragma unroll
    for (int i = 0; i < 4; i++) {
      const int c0 = 256 * i + 4 * lane;
      float4 g = *(const float4*)(p.g_ffn + c0);
      float4 sh = *(const float4*)(md + 3072 + c0);
      float4 sc = *(const float4*)(md + 4096 + c0);
#pragma unroll
      for (int t = 0; t < 2; t++) {
        const float rstd = t ? rstd1 : rstd0;
        float4 hv;
        hv.x = xv[t][i].x * rstd * g.x * (1.f + sc.x) + sh.x;
        hv.y = xv[t][i].y * rstd * g.y * (1.f + sc.y) + sh.y;
        hv.z = xv[t][i].z * rstd * g.z * (1.f + sc.z) + sh.z;
        hv.w = xv[t][i].w * rstd * g.w * (1.f + sc.w) + sh.w;
        xv[t][i] = hv;
        uint2 o;
        o.x = pk2(hv.x, hv.y);
        o.y = pk2(hv.z, hv.w);
        *(uint2*)(p.H() + (size_t)(tok + t) * DM + c0) = o;
      }
    }
#pragma unroll
    for (int t = 0; t < 2; t++) {
      float mx = 0.f;
#pragma unroll
      for (int i = 0; i < 4; i++)
        mx = fmaxf(mx, fmaxf(fmaxf(fabsf(xv[t][i].x), fabsf(xv[t][i].y)), fmaxf(fabsf(xv[t][i].z), fabsf(xv[t][i].w))));
      mx = wave_max(mx);
      const float inv = mx > 0.f ? 127.f / mx : 0.f;
#pragma unroll
      for (int i = 0; i < 4; i++)
        *(unsigned*)(p.Hq() + (size_t)(tok + t) * DM + 256 * i + 4 * lane) =
            pack_i8x4(xv[t][i].x * inv, xv[t][i].y * inv, xv[t][i].z * inv, xv[t][i].w * inv);
      if (lane == 0) p.hs()[tok + t] = mx * (1.f / 127.f);
    }
  }
}

DI void phase4(const Params& p, char* smem, int tid, int xcc, int rank) {
  asm volatile("" : "+v"(tid));
  const int lane = tid & 63, w = tid >> 6, wm = w & 1, wn = w >> 1, r = lane & 31, h = lane >> 5;
  const TileWalk tw = tile_walk(p, xcc, rank, 128 * 8);
  for (int t = tw.start; t < tw.total; t += tw.stride) {
    int nt, mt;
    tile_of(tw, t, 8, mt, nt);
    const int m0 = mt * 128, n0 = nt * 128;
    f32x16 acc[2][2];
    gemm_mainloop(p.WtPq(), p.H(), n0, m0, smem, tid, acc);
#pragma unroll
    for (int j = 0; j < 2; j++) {
      const int tok = m0 + 64 * wn + 32 * j + r;
#pragma unroll
      for (int i = 0; i < 2; i++)
#pragma unroll
        for (int g = 0; g < 4; g++) {
          const int n = n0 + 64 * wm + 32 * i + 8 * g + 4 * h;
          uint2 o;
          o.x = pk2(acc[i][j][4 * g + 0], acc[i][j][4 * g + 1]);
          o.y = pk2(acc[i][j][4 * g + 2], acc[i][j][4 * g + 3]);
          *(uint2*)(p.Qp() + (size_t)tok * DM + n) = o;
        }
    }
  }
}

template <int N>
struct TR {
  static DI float run(float (&part)[N], int lane) {
    constexpr int H = N / 2;
    float nxt[H];
    const bool up = (lane & H) != 0;
#pragma unroll
    for (int i = 0; i < H; i++) {
      float keep = up ? part[i + H] : part[i];
      float send = up ? part[i] : part[i + H];
      nxt[i] = keep + __shfl_xor(send, H);
    }
    return TR<H>::run(nxt, lane);
  }
};
template <>
struct TR<1> {
  static DI float run(float (&part)[1], int) { return part[0]; }
};


#define DPPF(v, ctrl) __builtin_bit_cast(float, __builtin_amdgcn_mov_dpp(__builtin_bit_cast(int, (v)), (ctrl), 0xf, 0xf, true))
DI float swz_xor16(float v) { return __builtin_bit_cast(float, __builtin_amdgcn_ds_swizzle(__builtin_bit_cast(int, v), (16 << 10) | 0x1f)); }
DI int bperm_xor32_i(int v, int lane) { return __builtin_amdgcn_ds_bpermute((lane ^ 32) << 2, v); }
DI float bperm_xor32(float v, int lane) { return __builtin_bit_cast(float, __builtin_amdgcn_ds_bpermute((lane ^ 32) << 2, __builtin_bit_cast(int, v))); }
DI float wave_sum_dpp(float v, int lane) {
  v += DPPF(v, 0xB1);
  v += DPPF(v, 0x4E);
  v += DPPF(v, 0x141);
  v += DPPF(v, 0x140);
  v += swz_xor16(v);
  v += bperm_xor32(v, lane);
  return v;
}
DI float tr16_dpp(const float (&part)[16], int lane) {
  float n8[8], n4[4], n2[2];
  {
    const bool up = (lane & 8) != 0;
#pragma unroll
    for (int i = 0; i < 8; i++) {
      float keep = up ? part[i + 8] : part[i];
      float send = up ? part[i] : part[i + 8];
      n8[i] = keep + DPPF(send, 0x140);
    }
  }
  {
    const bool up = (lane & 4) != 0;
#pragma unroll
    for (int i = 0; i < 4; i++) {
      float keep = up ? n8[i + 4] : n8[i];
      float send = up ? n8[i] : n8[i + 4];
      n4[i] = keep + DPPF(send, 0x141);
    }
  }
  {
    const bool up = (lane & 2) != 0;
#pragma unroll
    for (int i = 0; i < 2; i++) {
      float keep = up ? n4[i + 2] : n4[i];
      float send = up ? n4[i] : n4[i + 2];
      n2[i] = keep + DPPF(send, 0x1B);
    }
  }
  const bool up = (lane & 1) != 0;
  float keep = up ? n2[1] : n2[0];
  float send = up ? n2[0] : n2[1];
  return keep + DPPF(send, 0xB1);
}

DI int f2key(float f) { int b = __float_as_int(f); return b ^ ((b >> 31) & 0x7fffffff); }
DI float key2f(int k) { return __int_as_float(k ^ ((k >> 31) & 0x7fffffff)); }
DI void insert16(int (&L)[16], int x) {
#pragma unroll
  for (int k = 0; k < 16; k++) {
    int t = max(L[k], x);
    x = min(L[k], x);
    L[k] = t;
  }
}
DI void bitonic_sort16(int (&L)[16]) {
#pragma unroll
  for (int s = 8; s >= 1; s >>= 1)
#pragma unroll
    for (int i = 0; i < 16; i++)
      if ((i & s) == 0) {
        int x = L[i], y = L[i + s];
        L[i] = max(x, y);
        L[i + s] = min(x, y);
      }
}
DI void bitonic_full16(int (&L)[16]) {
#pragma unroll
  for (int k = 2; k <= 16; k <<= 1)
#pragma unroll
    for (int j = k >> 1; j > 0; j >>= 1)
#pragma unroll
      for (int i = 0; i < 16; i++) {
        const int l = i ^ j;
        if (l > i) {
          const int x = L[i], y = L[l];
          if ((i & k) == 0) { L[i] = max(x, y); L[l] = min(x, y); }
          else { L[i] = min(x, y); L[l] = max(x, y); }
        }
      }
}
DI int lookup_byte(int p0, int p1, int p2, int p3, int i) {
  int d = i < 8 ? (i < 4 ? p0 : p1) : (i < 12 ? p2 : p3);
  return (d >> ((i & 3) * 8)) & 255;
}
constexpr int CAND_I[50] = {0,0,0,0,0,0,0,0,0,0,0,0,0,0,0,0,1,1,1,1,1,1,1,1,2,2,2,2,2,3,3,3,3,4,4,4,5,5,6,6,7,7,8,9,10,11,12,13,14,15};
constexpr int CAND_J[50] = {0,1,2,3,4,5,6,7,8,9,10,11,12,13,14,15,0,1,2,3,4,5,6,7,0,1,2,3,4,0,1,2,3,0,1,2,0,1,0,1,0,1,0,0,0,0,0,0,0,0};

DI void phase5(const Params& p, char* smem, int tid, int xl, int xcc, int rank, int cnt) {
  asm volatile("" : "+v"(tid));
  const int lane_outer = tid & 63, w = tid >> 6;
  char* skl = smem;
  int* El = (int*)(smem + 36864 + w * 4096);
  float* Gl = (float*)(El + 512);
  __syncthreads();
  for (int i = tid; i < 2 * 128 * 8; i += NTHREADS) {
    const int row = i >> 3, ch = i & 7;
    const float* src = p.sub_keys + (size_t)row * 64 + ch * 8;
    float4 a = *(const float4*)src, b = *(const float4*)(src + 4);
    u32x4 u = {pk2(a.x, a.y), pk2(a.z, a.w), pk2(b.x, b.y), pk2(b.z, b.w)};
    *(u32x4*)(skl + row * 144 + ch * 16) = u;
  }
  __syncthreads();
  const int IMIN = (int)0x80000000;
  const int g_lo = xl ? 512 * xcc + rank * 4 + w : blockIdx.x * 4 + w;
  const int g_hi = xl ? 512 * (xcc + 1) : T_TOK / 4;
  const int g_st = xl ? cnt * 4 : gridDim.x * 4;
  for (int grp = g_lo; grp < g_hi; grp += g_st) {
    const int tok0 = grp * 4;
    int lane_s1 = lane_outer;
    asm volatile("" : "+v"(lane_s1));
    {
    const int lane = lane_s1, r = lane & 31, h = lane >> 5;
    (void)lane;
    int LA[16], LB[16];
    {
      const int tl = r >> 3, hd = r & 7;
      const u16* qsrc = p.Qp() + (size_t)(tok0 + tl) * DM + hd * 128 + 8 * h;
#pragma unroll
      for (int c = 0; c < 2; c++) {
        bf16x8 qb[4];
#pragma unroll
        for (int ks = 0; ks < 4; ks++) qb[ks] = *(const bf16x8*)(qsrc + c * 64 + 16 * ks);
        int L[16];
#pragma unroll
        for (int k = 0; k < 16; k++) L[k] = IMIN;
#pragma unroll
        for (int mt = 0; mt < 4; mt++) {
          f32x16 sc;
#pragma unroll
          for (int q = 0; q < 16; q++) sc[q] = 0.f;
#pragma unroll
          for (int ks = 0; ks < 4; ks++) {
            bf16x8 ska = *(const bf16x8*)(skl + (c * 128 + 32 * mt + r) * 144 + ks * 32 + h * 16);
            sc = MFMA32(ska, qb[ks], sc);
          }
          int T[16];
#pragma unroll
          for (int q = 0; q < 16; q++) {
            const int pay = 32 * mt + (q & 3) + 8 * (q >> 2);
            T[q] = (f2key(sc[q]) & ~127) | pay;
          }
          bitonic_full16(T);
          if (mt == 0) {
#pragma unroll
            for (int k = 0; k < 16; k++) L[k] = T[k];
          } else {
#pragma unroll
            for (int k = 0; k < 16; k++) L[k] = max(L[k], T[15 - k]);
            bitonic_sort16(L);
          }
        }
#pragma unroll
        for (int k = 0; k < 16; k++) {
          if (c == 0) LA[k] = L[k] | (h << 2); else LB[k] = L[k] | (h << 2);
        }
      }
    }
    int M[16];
    {
      int recv[16];
#pragma unroll
      for (int k = 0; k < 16; k++) {
        int send = h ? LA[k] : LB[k];
        recv[k] = bperm_xor32_i(send, lane);
      }
#pragma unroll
      for (int k = 0; k < 16; k++) {
        int mine = h ? LB[k] : LA[k];
        M[k] = max(mine, recv[15 - k]);
      }
      bitonic_sort16(M);
    }
    int pa0, pa1, pa2, pa3, pb0, pb1, pb2, pb3;
    int F[16];
    {
      float av[16], bv[16];
      int ai[16], bi[16];
#pragma unroll
      for (int k = 0; k < 16; k++) {
        int o = bperm_xor32_i(M[k], lane);
        int ka = h ? o : M[k];
        int kb = h ? M[k] : o;
        av[k] = key2f(ka);
        bv[k] = key2f(kb);
        ai[k] = ka & 127;
        bi[k] = kb & 127;
      }
      pa0 = ai[0] | (ai[1] << 8) | (ai[2] << 16) | (ai[3] << 24);
      pa1 = ai[4] | (ai[5] << 8) | (ai[6] << 16) | (ai[7] << 24);
      pa2 = ai[8] | (ai[9] << 8) | (ai[10] << 16) | (ai[11] << 24);
      pa3 = ai[12] | (ai[13] << 8) | (ai[14] << 16) | (ai[15] << 24);
      pb0 = bi[0] | (bi[1] << 8) | (bi[2] << 16) | (bi[3] << 24);
      pb1 = bi[4] | (bi[5] << 8) | (bi[6] << 16) | (bi[7] << 24);
      pb2 = bi[8] | (bi[9] << 8) | (bi[10] << 16) | (bi[11] << 24);
      pb3 = bi[12] | (bi[13] << 8) | (bi[14] << 16) | (bi[15] << 24);
      int L[16];
#pragma unroll
      for (int k = 0; k < 16; k++) L[k] = IMIN;
#pragma unroll
      for (int m = 0; m < 25; m++) {
        const int i0 = CAND_I[2 * m], j0 = CAND_J[2 * m], i1 = CAND_I[2 * m + 1], j1 = CAND_J[2 * m + 1];
        float s0 = av[i0] + bv[j0], s1 = av[i1] + bv[j1];
        float s = h ? s1 : s0;
        int pay = h ? ((i1 << 4) | j1) : ((i0 << 4) | j0);
        int key = (f2key(s) & ~255) | pay;
        insert16(L, key);
      }
#pragma unroll
      for (int k = 0; k < 16; k++) {
        int o = bperm_xor32_i(L[15 - k], lane);
        F[k] = max(L[k], o);
      }
    }
    {
      int mk = F[0];
#pragma unroll
      for (int k = 1; k < 16; k++) mk = max(mk, F[k]);
      const float mx = key2f(mk);
      float ex[8];
      float sm = 0.f;
#pragma unroll
      for (int k = 0; k < 8; k++) {
        ex[k] = __expf(key2f(F[k]) - mx);
        sm += ex[k];
      }
      sm += bperm_xor32(sm, lane);
      const float inv = 1.f / sm;
      int ev[8];
#pragma unroll
      for (int k = 0; k < 8; k++) {
        const int pay = F[k] & 255;
        ev[k] = lookup_byte(pa0, pa1, pa2, pa3, pay >> 4) * 128 + lookup_byte(pb0, pb1, pb2, pb3, pay & 15);
        ex[k] *= inv;
      }
      const int tokc = tok0 + (r >> 3);
      int* ed = p.E() + (size_t)tokc * 128 + (r & 7) * 16 + 8 * h;
      float* gd = p.G() + (size_t)tokc * 128 + (r & 7) * 16 + 8 * h;
      *(u32x4*)ed = u32x4{(unsigned)ev[0], (unsigned)ev[1], (unsigned)ev[2], (unsigned)ev[3]};
      *(u32x4*)(ed + 4) = u32x4{(unsigned)ev[4], (unsigned)ev[5], (unsigned)ev[6], (unsigned)ev[7]};
      *(f32x4*)gd = f32x4{ex[0], ex[1], ex[2], ex[3]};
      *(f32x4*)(gd + 4) = f32x4{ex[4], ex[5], ex[6], ex[7]};
    }
    }
  }
}

DI unsigned my_xcc_id() { return (unsigned)__builtin_amdgcn_s_getreg((3 << 11) | 20) & 7u; }
DI int mbcnt64(unsigned long long m) { return (int)__builtin_amdgcn_mbcnt_hi((unsigned)(m >> 32), __builtin_amdgcn_mbcnt_lo((unsigned)m, 0u)); }
DI float swz_xor8(float v) { return __builtin_bit_cast(float, __builtin_amdgcn_ds_swizzle(__builtin_bit_cast(int, v), (8 << 10) | 0x1f)); }

#define DPPI(v, ctrl) __builtin_amdgcn_mov_dpp((v), (ctrl), 0xf, 0xf, true)
DI int tr16_dpp_i(const int (&part)[16], int lane) {
  int n8[8], n4[4], n2[2];
  {
    const bool up = (lane & 8) != 0;
#pragma unroll
    for (int i = 0; i < 8; i++) {
      int keep = up ? part[i + 8] : part[i];
      int send = up ? part[i] : part[i + 8];
      n8[i] = keep + DPPI(send, 0x140);
    }
  }
  {
    const bool up = (lane & 4) != 0;
#pragma unroll
    for (int i = 0; i < 4; i++) {
      int keep = up ? n8[i + 4] : n8[i];
      int send = up ? n8[i] : n8[i + 4];
      n4[i] = keep + DPPI(send, 0x141);
    }
  }
  {
    const bool up = (lane & 2) != 0;
#pragma unroll
    for (int i = 0; i < 2; i++) {
      int keep = up ? n4[i + 2] : n4[i];
      int send = up ? n4[i] : n4[i + 2];
      n2[i] = keep + DPPI(send, 0x1B);
    }
  }
  const bool up = (lane & 1) != 0;
  int keep = up ? n2[1] : n2[0];
  int send = up ? n2[0] : n2[1];
  return keep + DPPI(send, 0xB1);
}
DI float erf_as(float x) {
  const float ax = fabsf(x);
  const float t = __builtin_amdgcn_rcpf(1.f + 0.3275911f * ax);
  float poly = 1.061405429f;
  poly = poly * t - 1.453152027f;
  poly = poly * t + 1.421413741f;
  poly = poly * t - 0.284496736f;
  poly = poly * t + 0.254829592f;
  poly *= t;
  const float e = __builtin_amdgcn_exp2f(-ax * ax * 1.4426950408889634f);
  const float r = 1.f - poly * e;
  return copysignf(r, x);
}
DI void phase6u(const Params& p, char* smem, int tid, int s_xcc, int s_rank) {
  asm volatile("" : "+v"(tid));
  const int lane = tid & 63, w = tid >> 6;
  char* wb = smem + w * 10496;
  int* lstE = (int*)wb;
  int* lstG = lstE + 512;
  int* lstS = lstG + 512;
  char* h8 = wb + 6144;
  float* hsc = (float*)(wb + 10240);
  const int xcc = s_xcc, rank = s_rank;
  __syncthreads();
#pragma unroll 1
  for (int so = 0; so < 8; so++) {
    const int s = (xcc + so) & 7;
    int start, stride;
    const int cs = (int)p.census()[64 * s];
    if (so == 0) { start = rank * 4 + w; stride = cs * 4; }
    else if (cs == 0) { start = blockIdx.x * 4 + w; stride = gridDim.x * 4; }
    else continue;
#pragma unroll 1
    for (int item = start; item < T_TOK / 4; item += stride) {
      const int tokb = item * 4;
      int e0[4], e1[4];
      float g0[4], g1[4];
      u32x4 hA[4];
      float hsv[4];
#pragma unroll
      for (int tt = 0; tt < 4; tt++) {
        const size_t tok = (size_t)(tokb + tt);
        e0[tt] = p.E()[tok * 128 + lane];
        e1[tt] = p.E()[tok * 128 + 64 + lane];
        g0[tt] = p.G()[tok * 128 + lane];
        g1[tt] = p.G()[tok * 128 + 64 + lane];
        hA[tt] = *(const u32x4*)(p.Hq() + tok * DM + 16 * lane);
        hsv[tt] = p.hs()[tok];
      }
      int n_0 = 0, n_1 = 0, n_2 = 0, n_3 = 0;
#pragma unroll
      for (int tt = 0; tt < 4; tt++) {
        const bool m0 = (e0[tt] >> 11) == s, m1 = (e1[tt] >> 11) == s;
        const unsigned long long b0 = __ballot(m0), b1 = __ballot(m1);
        const int c0 = __popcll(b0), n = c0 + __popcll(b1);
        const int pos0 = mbcnt64(b0), pos1 = c0 + mbcnt64(b1);
        if (m0) { lstE[tt * 128 + pos0] = e0[tt]; lstG[tt * 128 + pos0] = __float_as_int(g0[tt]); lstS[tt * 128 + pos0] = lane; }
        if (m1) { lstE[tt * 128 + pos1] = e1[tt]; lstG[tt * 128 + pos1] = __float_as_int(g1[tt]); lstS[tt * 128 + pos1] = lane + 64; }
        *(u32x4*)(h8 + tt * 1024 + 16 * lane) = hA[tt];
        if (lane == 0) hsc[tt] = hsv[tt];
        if (tt == 0) n_0 = n; else if (tt == 1) n_1 = n; else if (tt == 2) n_2 = n; else n_3 = n;
      }
#define NOF(T) ((T) == 0 ? n_0 : (T) == 1 ? n_1 : (T) == 2 ? n_2 : n_3)
#define U_ISSUE(BUF, LE, LG, LS, LU, TT, BASE)                                               \
  {                                                                                          \
    const int nn_ = NOF(TT);                                                                 \
    const int li_ = (TT) * 128 + min((BASE) + (lane & 15), nn_ - 1);                         \
    LE = lstE[li_];                                                                          \
    LG = __int_as_float(lstG[li_]);                                                          \
    LS = lstS[li_];                                                                          \
    LU = p.su()[LE];                                                                         \
    _Pragma("unroll") for (int k = 0; k < 16; k++) {                                         \
      const int e_ = __builtin_amdgcn_readlane(LE, k);     \
      BUF[k] = *(const u32x4*)(p.Uq() + (size_t)e_ * DM + 16 * lane);                        \
    }                                                                                        \
    __builtin_amdgcn_sched_barrier(0);                                                       \
  }
#define U_COMPUTE(BUF, LG, LS, LU, TT, BASE)                                                 \
  {                                                                                          \
    const int nn_ = NOF(TT);                                                                 \
    const u32x4 hq = *(const u32x4*)(h8 + (TT) * 1024 + 16 * lane);                          \
    const float hs_ = hsc[TT];                                                               \
    int part[16];                                                                            \
    _Pragma("unroll") for (int k = 0; k < 16; k++) {                                         \
      int a = 0;                                                                             \
      if ((BASE) + k < nn_) {                                                                \
        _Pragma("unroll") for (int q = 0; q < 4; q++) {                                      \
          const int x = (int)BUF[k][q];                                                      \
          const int hh = (int)hq[q];                                                         \
          a = __builtin_amdgcn_sdot4(x, hh, a, false);                                       \
        }                                                                                    \
      }                                                                                      \
      part[k] = a;                                                                           \
    }                                                                                        \
    int ai_ = tr16_dpp_i(part, lane);                                                        \
    ai_ += __builtin_amdgcn_ds_swizzle(ai_, (16 << 10) | 0x1f);                              \
    ai_ += bperm_xor32_i(ai_, lane);                                                         \
    const float av = (float)ai_ * (LU * hs_);                                                \
    const float wv = 0.5f * av * (1.f + erf_as(av * 0.70710678118654752f)) * LG * 0.125f;    \
    if (lane < 16 && (BASE) + lane < nn_) p.W()[(size_t)(tokb + (TT)) * 128 + LS] = wv;      \
  }
#define U_NEXT(T2, B2, T1, B1)                                                               \
  {                                                                                          \
    T2 = T1; B2 = (B1) + 16;                                                                 \
    if (B2 >= NOF(T2)) { B2 = 0; do { T2++; } while (T2 < 4 && NOF(T2) == 0); }              \
  }
      {
        u32x4 bufA[16], bufB[16];
        int leA, lsA, leB, lsB;
        float lgA, lgB, luA, luB;
        int tA = 0, bA = 0, tB, bB;
        while (tA < 4 && NOF(tA) == 0) tA++;
        if (tA < 4) {
          U_ISSUE(bufA, leA, lgA, lsA, luA, tA, bA)
#pragma unroll 1
          for (;;) {
            U_NEXT(tB, bB, tA, bA)
            if (tB < 4) U_ISSUE(bufB, leB, lgB, lsB, luB, tB, bB)
            U_COMPUTE(bufA, lgA, lsA, luA, tA, bA)
            if (tB >= 4) break;
            U_NEXT(tA, bA, tB, bB)
            if (tA < 4) U_ISSUE(bufA, leA, lgA, lsA, luA, tA, bA)
            U_COMPUTE(bufB, lgB, lsB, luB, tB, bB)
            if (tA >= 4) break;
          }
        }
      }
#undef NOF
#undef U_ISSUE
#undef U_COMPUTE
#undef U_NEXT
    }
  }
}

DI void phase7v(const Params& p, char* smem, int tid, int s_xcc, int s_rank) {
  asm volatile("" : "+v"(tid));
  const int lane = tid & 63, w = tid >> 6;
  const int hp = lane >> 3, c = lane & 7;
  char* wb = smem + w * 8192;
  int* El = (int*)wb;
  float* Wl = (float*)(wb + 2048);
  float* Xl = (float*)(wb + 4096);
  float* Gt = (float*)(wb + 6144);
  const int xcc = s_xcc, rank = s_rank;
  __syncthreads();
#pragma unroll 1
  for (int so = 0; so < 8; so++) {
    const int s = (xcc + so) & 7;
    int start, stride;
    const int cs = (int)p.census()[64 * s];
    if (so == 0) { start = rank * 4 + w; stride = cs * 4; }
    else if (cs == 0) { start = blockIdx.x * 4 + w; stride = gridDim.x * 4; }
    else continue;
    const unsigned char* vsb = p.Vq() + (size_t)s * ((size_t)16384 * 128);
    const unsigned c16 = 16u * (unsigned)c;
#pragma unroll 1
    for (int item = start; item < T_TOK / 4; item += stride) {
      const int tokb = item * 4;
      const int b = tokb >> 11;
      {
        int ea[4], eb[4];
        float wa[4], wb2[4];
        f32x2_t xa[4];
#pragma unroll
        for (int tt = 0; tt < 4; tt++) {
          const size_t tok = (size_t)(tokb + tt);
          ea[tt] = p.E()[tok * 128 + lane];
          eb[tt] = p.E()[tok * 128 + 64 + lane];
          wa[tt] = p.W()[tok * 128 + lane];
          wb2[tt] = p.W()[tok * 128 + 64 + lane];
          xa[tt] = *(const f32x2_t*)(p.out + tok * DM + 128 * s + 2 * lane);
        }
        const f32x2_t gt = *(const f32x2_t*)(p.mod() + b * 6144 + 5120 + 128 * s + 2 * lane);
#pragma unroll
        for (int tt = 0; tt < 4; tt++) {
          El[tt * 128 + lane] = ea[tt];
          El[tt * 128 + 64 + lane] = eb[tt];
          Wl[tt * 128 + lane] = wa[tt];
          Wl[tt * 128 + 64 + lane] = wb2[tt];
          *(f32x2_t*)(Xl + tt * 128 + 2 * lane) = xa[tt];
        }
        *(f32x2_t*)(Gt + 2 * lane) = gt;
      }
#pragma unroll 1
      for (int tt = 0; tt < 4; tt++) {
        const int tok = tokb + tt;
        u32x4 ee[4];
        f32x4 ww[4];
#pragma unroll
        for (int q = 0; q < 4; q++) {
          ee[q] = *(const u32x4*)(El + tt * 128 + hp * 16 + 4 * q);
          ww[q] = *(const f32x4*)(Wl + tt * 128 + hp * 16 + 4 * q);
        }
        u32x4 vv[16];
#pragma unroll
        for (int i = 0; i < 16; i++) {
          const unsigned e = ee[i >> 2][i & 3];
          vv[i] = *(const u32x4*)(vsb + (size_t)(unsigned)(e * 128u + c16));
        }
        float acc[16];
#pragma unroll
        for (int j = 0; j < 16; j++) acc[j] = 0.f;
#pragma unroll
        for (int i = 0; i < 16; i++) {
          const float wj = ww[i >> 2][i & 3];
#pragma unroll
          for (int q = 0; q < 4; q++) {
            const unsigned x = vv[i][q];
            f32x2_t lo = __builtin_amdgcn_cvt_pk_f32_fp8(x, false);
            f32x2_t hi = __builtin_amdgcn_cvt_pk_f32_fp8(x, true);
            acc[4 * q + 0] += wj * lo.x;
            acc[4 * q + 1] += wj * lo.y;
            acc[4 * q + 2] += wj * hi.x;
            acc[4 * q + 3] += wj * hi.y;
          }
        }
        float a8[8], a4[4], a2[2];
        {
          const bool up = (lane & 32) != 0;
#pragma unroll
          for (int i = 0; i < 8; i++) {
            const float keep = up ? acc[i + 8] : acc[i];
            const float send = up ? acc[i] : acc[i + 8];
            a8[i] = keep + bperm_xor32(send, lane);
          }
        }
        {
          const bool up = (lane & 16) != 0;
#pragma unroll
          for (int i = 0; i < 4; i++) {
            const float keep = up ? a8[i + 4] : a8[i];
            const float send = up ? a8[i] : a8[i + 4];
            a4[i] = keep + swz_xor16(send);
          }
        }
        {
          const bool up = (lane & 8) != 0;
#pragma unroll
          for (int i = 0; i < 2; i++) {
            const float keep = up ? a4[i + 2] : a4[i];
            const float send = up ? a4[i] : a4[i + 2];
            a2[i] = keep + DPPF(send, 0x128);
          }
        }
        {
          const int col = 16 * c + 2 * hp;
          const f32x2_t xv = *(const f32x2_t*)(Xl + tt * 128 + col);
          const f32x2_t gtv = *(const f32x2_t*)(Gt + col);
          f32x2_t ov;
          ov.x = xv.x + gtv.x * a2[0];
          ov.y = xv.y + gtv.y * a2[1];
          *(f32x2_t*)(p.out + (size_t)tok * DM + 128 * s + col) = ov;
        }
      }
    }
  }
}

DI void phase8(const Params& p, int tid) {
  asm volatile("" : "+v"(tid));
  const int lane = tid & 63, w = tid >> 6;
  for (int tok = (blockIdx.x * 4 + w) * 4; tok < T_TOK; tok += gridDim.x * 16) {
    float* xr = p.out + (size_t)tok * DM;
    float4 xv[4][4];
#pragma unroll
    for (int t = 0; t < 4; t++)
#pragma unroll
      for (int i = 0; i < 4; i++) xv[t][i] = *(const float4*)(xr + t * DM + 256 * i + 4 * lane);
    float rs[4];
#pragma unroll
    for (int t = 0; t < 4; t++) {
      float ss = 0.f;
#pragma unroll
      for (int i = 0; i < 4; i++)
        ss += xv[t][i].x * xv[t][i].x + xv[t][i].y * xv[t][i].y + xv[t][i].z * xv[t][i].z + xv[t][i].w * xv[t][i].w;
      ss = wave_sum(ss);
      rs[t] = rsqrtf(ss * (1.f / 1024.f) + 1e-6f);
    }
#pragma unroll
    for (int i = 0; i < 4; i++) {
      const int c0 = 256 * i + 4 * lane;
      float4 g = *(const float4*)(p.g_final + c0);
#pragma unroll
      for (int t = 0; t < 4; t++)
        *(float4*)(xr + t * DM + c0) = make_float4(xv[t][i].x * rs[t] * g.x, xv[t][i].y * rs[t] * g.y, xv[t][i].z * rs[t] * g.z, xv[t][i].w * rs[t] * g.w);
    }
  }
}

#define XB_TMO      128
#define XB_XCNT(j)  (256  + 64 * (j))
#define XB_XSUB(j)  (1280 + 64 * (j))
#define XB_XGEN(j)  (2304 + 64 * (j))
#define XB_TOP      3328
#define XB_TOPGEN   3392
#define XCD_BAR_WORDS 3456
#define XB_SPIN_CAP (1u << 18)
#define LAS __attribute__((address_space(3)))

__device__ __forceinline__ unsigned xb_ld(unsigned* p)              { return __hip_atomic_load(p, __ATOMIC_RELAXED, __HIP_MEMORY_SCOPE_AGENT); }
__device__ __forceinline__ unsigned xb_add(unsigned* p, unsigned v) { return __hip_atomic_fetch_add(p, v, __ATOMIC_RELAXED, __HIP_MEMORY_SCOPE_AGENT); }
__device__ __forceinline__ unsigned xb_xcc_id() { return (unsigned)__builtin_amdgcn_s_getreg((3 << 11) | 20) & 0xFu; }
#define XB_SPIN(cond, bar) do { unsigned _sp = 0; while (cond) { __builtin_amdgcn_s_sleep(1); \
    if ((++_sp & 255u) == 0u) { if (xb_ld(&(bar)[XB_TMO])) break; if (_sp > XB_SPIN_CAP) { atomicAdd(&(bar)[XB_TMO], 1u); break; } } } } while (0)

struct XcdBarrier {
    unsigned* bar; unsigned x;
    volatile LAS unsigned* st;
};

__device__ __forceinline__ XcdBarrier xcd_barrier_post(unsigned* bar, volatile LAS unsigned* st) {
    XcdBarrier b; b.bar = bar; b.x = xb_xcc_id(); b.st = st;
    if (threadIdx.x == 0) (void)xb_add(&bar[XB_XCNT(b.x)], 1u);
    return b;
}
__device__ __forceinline__ void xcd_barrier_complete(unsigned* bar, unsigned x, unsigned& nloc, unsigned& nx) {
    const unsigned G = gridDim.x * gridDim.y * gridDim.z;
    unsigned sum, cnt, mine, sp = 0u;
    for (;;) {
        sum = 0u; cnt = 0u; mine = 0u;
#pragma unroll
        for (unsigned j = 0; j < 16; ++j) { const unsigned c = xb_ld(&bar[XB_XCNT(j)]); sum += c; cnt += (c > 0u) ? 1u : 0u; mine = (j == x) ? c : mine; }
        if (sum == G) break;
        __builtin_amdgcn_s_sleep(1);
        if ((++sp & 255u) == 0u) { if (xb_ld(&bar[XB_TMO])) break; if (sp > XB_SPIN_CAP) { atomicAdd(&bar[XB_TMO], 1u); break; } }
    }
    nloc = mine > 0u ? mine : 1u; nx = cnt > 0u ? cnt : 1u;
}

__device__ __forceinline__ void xcd_barrier(const XcdBarrier& b) {
    asm volatile("s_waitcnt vmcnt(0)" ::: "memory");
    __syncthreads();
    if (threadIdx.x == 0) {
        unsigned* bar = b.bar;
        __builtin_amdgcn_s_waitcnt(0);
        unsigned nloc = b.st[0], nx = b.st[1];
        if (nloc == 0u) { xcd_barrier_complete(bar, b.x, nloc, nx); b.st[0] = nloc; b.st[1] = nx; }
        const unsigned old = xb_add(&bar[XB_XSUB(b.x)], 1u);
        const unsigned gen = old / nloc;
        if (old + 1u == (gen + 1u) * nloc) {
            __builtin_amdgcn_fence(__ATOMIC_RELEASE, "agent");
            asm volatile("s_waitcnt vmcnt(0)" ::: "memory");
            const unsigned og = xb_add(&bar[XB_TOP], 1u);
            const unsigned tg = og / nx;
            if (og + 1u == (tg + 1u) * nx) xb_add(&bar[XB_TOPGEN], 1u);
            else XB_SPIN(xb_ld(&bar[XB_TOPGEN]) == tg, bar);
            __builtin_amdgcn_fence(__ATOMIC_ACQUIRE, "agent");
            xb_add(&bar[XB_XGEN(b.x)], 1u);
            asm volatile("s_waitcnt vmcnt(0)" ::: "memory");
        } else {
            XB_SPIN(xb_ld(&bar[XB_XGEN(b.x)]) == gen, bar);
            __builtin_amdgcn_fence(__ATOMIC_ACQUIRE, "agent");
            asm volatile("s_waitcnt vmcnt(0)" ::: "memory");
        }
    }
    __syncthreads();
}


DI void xcd_local_barrier(unsigned* ctr, unsigned cnt, unsigned* bar) {
  asm volatile("s_waitcnt vmcnt(0)" ::: "memory");
  __syncthreads();
  if (threadIdx.x == 0) {
    __builtin_amdgcn_s_waitcnt(0);
    const unsigned old = xb_add(ctr, 1u);
    const unsigned round = old / cnt;
    if (old + 1u == (round + 1u) * cnt) xb_add(ctr + 32, 1u);
    else XB_SPIN(xb_ld(ctr + 32) == round, bar);
    __builtin_amdgcn_fence(__ATOMIC_ACQUIRE, "agent");
    asm volatile("s_waitcnt vmcnt(0)" ::: "memory");
  }
  __syncthreads();
}

__global__ void __launch_bounds__(NTHREADS, 2) fwd_megakernel(Params p) {
  __shared__ __attribute__((aligned(16))) char smem[SMEM_BYTES];
  cg::grid_group grid = cg::this_grid();
  const int tid = threadIdx.x;
  __shared__ uint4 xb_words;
  __shared__ int xcd_info[4];
  if (tid == 0) {
    xb_words = make_uint4(0u, 0u, 0u, 0u);
    const int x = (int)my_xcc_id();
    xcd_info[0] = x;
    xcd_info[1] = (int)atomicAdd(&p.census()[64 * x], 1u);
  }
  __syncthreads();
  (void)xcd_barrier_post(p.bar(), (volatile LAS unsigned*)&xb_words);
#define GBAR() do { XcdBarrier b_; b_.bar = p.bar(); b_.x = xb_xcc_id(); b_.st = (volatile LAS unsigned*)&xb_words; xcd_barrier(b_); } while (0)
  phase0(p, smem, tid);
  if (gridDim.y == 77u) grid.sync();
  GBAR();
  if (tid == 0) {
    int all = 1, mine = 1;
    for (int j = 0; j < 8; j++) {
      const int cj = (int)p.census()[64 * j];
      all = all && (cj > 0);
      if (j == xcd_info[0]) mine = cj;
    }
    xcd_info[2] = all;
    xcd_info[3] = mine;
  }
  __syncthreads();
#define LBAR() do { if (xcd_info[2]) xcd_local_barrier(p.lbar() + 64 * xcd_info[0], (unsigned)xcd_info[3], p.bar()); else GBAR(); } while (0)
  phase1a(p, smem, tid, xcd_info[2], xcd_info[0], xcd_info[1], xcd_info[3]);
  LBAR();
  phase_cumsum(p, smem, tid, xcd_info[2], xcd_info[0], xcd_info[1], xcd_info[3]);
  phase1b(p, smem, tid, xcd_info[0], xcd_info[1]);
  LBAR();
  phase2(p, smem, tid, xcd_info[2], xcd_info[0]);
  LBAR();
  phase3(p, smem, tid, xcd_info[0], xcd_info[1]);
  LBAR();
  phase3b(p, tid, xcd_info[2], xcd_info[0], xcd_info[1], xcd_info[3]);
  LBAR();
  phase4(p, smem, tid, xcd_info[0], xcd_info[1]);
  LBAR();
  phase5(p, smem, tid, xcd_info[2], xcd_info[0], xcd_info[1], xcd_info[3]);
  GBAR();
  phase6u(p, smem, tid, xcd_info[0], xcd_info[1]);
  GBAR();
  phase7v(p, smem, tid, xcd_info[0], xcd_info[1]);
  GBAR();
  phase8(p, tid);
}

extern "C" void kernel_launch(void* const* d_in, const int* in_sizes, int n_in, void* d_out, int out_size, void* d_ws,
                              size_t ws_size, hipStream_t stream) {
  static int grid_blocks = 0;
  if (!grid_blocks) {
    int dev = 0, cus = 0, per_cu = 0;
    hipGetDevice(&dev);
    hipDeviceGetAttribute(&cus, hipDeviceAttributeMultiprocessorCount, dev);
    hipOccupancyMaxActiveBlocksPerMultiprocessor(&per_cu, fwd_megakernel, NTHREADS, 0);
    if (per_cu > 2) per_cu = 2;
    if (per_cu < 1) per_cu = 1;
    grid_blocks = cus * per_cu;
  }
  Params p{};
  p.x = (const float*)d_in[0]; p.c = (const float*)d_in[1]; p.w_ada = (const float*)d_in[2]; p.b_ada = (const float*)d_in[3];
  p.g_attn = (const float*)d_in[4]; p.w_in = (const float*)d_in[5]; p.b_f = (const float*)d_in[6];
  p.lq1 = (const float*)d_in[7]; p.lk1 = (const float*)d_in[8]; p.lq2 = (const float*)d_in[9]; p.lk2 = (const float*)d_in[10];
  p.g_subln = (const float*)d_in[11]; p.w_o = (const float*)d_in[12]; p.g_ffn = (const float*)d_in[13];
  p.w_pq = (const float*)d_in[14]; p.sub_keys = (const float*)d_in[15]; p.u_exp = (const float*)d_in[16];
  p.v_exp = (const float*)d_in[17]; p.g_final = (const float*)d_in[18];
  p.out = (float*)d_out;
  p.ws = (char*)d_ws;
  hipMemsetAsync((char*)d_ws + 205 * 1024 * 1024, 0, 32768, stream);
  void* args[] = {&p};
  hipError_t e = hipLaunchCooperativeKernel((void*)fwd_megakernel, dim3(grid_blocks), dim3(NTHREADS), args, 0, stream);
  if (e != hipSuccess) fprintf(stderr, "cooperative launch failed: %s (grid %d)\n", hipGetErrorString(e), grid_blocks);
}
```

```cpp
#include <hip/hip_runtime.h>
#include <hip/hip_cooperative_groups.h>
#include <cstdio>
namespace cg = cooperative_groups;

#define DI __device__ __forceinline__
typedef unsigned short u16;
using bf16x8 = __attribute__((ext_vector_type(8))) short;
using f32x16 = __attribute__((ext_vector_type(16))) float;
typedef __bf16 bf16x2_t __attribute__((ext_vector_type(2)));
typedef float f32x2_t __attribute__((ext_vector_type(2)));
using u32x4 = __attribute__((ext_vector_type(4))) unsigned;
using u32x2 = __attribute__((ext_vector_type(2))) unsigned;
using f32x4 = __attribute__((ext_vector_type(4))) float;

#define MFMA32(a, b, c) __builtin_amdgcn_mfma_f32_32x32x16_bf16((a), (b), (c), 0, 0, 0)

static constexpr int T_TOK = 16384;
static constexpr int SEQ = 2048;
static constexpr int DM = 1024;
static constexpr int INC = 3080;
static constexpr float LOG2E = 1.4426950408889634f;
static constexpr int NTHREADS = 256;
static constexpr int SMEM_BYTES = 70656;

struct Params {
  const float *x, *c, *w_ada, *b_ada, *g_attn, *w_in, *b_f, *lq1, *lk1, *lq2, *lk2, *g_subln, *w_o, *g_ffn, *w_pq,
      *sub_keys, *u_exp, *v_exp, *g_final;
  float* out;
  char* ws;
  static constexpr size_t MB = 1024 * 1024;
  DI u16* WtIn() const { return (u16*)(ws + 0 * MB); }
  DI u16* WtO() const { return (u16*)(ws + 6 * MB); }
  DI u16* WtPq() const { return (u16*)(ws + 8 * MB); }
  DI unsigned char* Uq() const { return (unsigned char*)(ws + 10 * MB); }
  DI unsigned char* Vq() const { return (unsigned char*)(ws + 42 * MB); }
  DI u16* H() const { return (u16*)(ws + 74 * MB); }
  DI u16* QK() const { return (u16*)(ws + 106 * MB); }
  DI u16* Vt() const { return (u16*)(ws + 170 * MB); }
  DI u16* Qp() const { return (u16*)(ws + 106 * MB); }
  DI float* mod() const { return (float*)(ws + 202 * MB); }
  DI float* rope() const { return (float*)(ws + 202 * MB + 256 * 1024); }
  DI float* logf() const { return (float*)(ws + 203 * MB); }
  DI float* FL() const { return (float*)(ws + 204 * MB); }
  DI unsigned* counters() const { return (unsigned*)(ws + 205 * MB); }
  DI float* stash() const { return (float*)(ws + 206 * MB); }
  DI unsigned* bar() const { return (unsigned*)(ws + 205 * MB + 4096); }
  DI unsigned* census() const { return (unsigned*)(ws + 205 * MB + 20480); }
  DI float* su() const { return (float*)(ws + 205 * MB + 131072); }
  DI unsigned char* Hq() const { return (unsigned char*)(ws + 170 * MB); }
  DI float* hs() const { return (float*)(ws + 186 * MB); }
  DI unsigned* lbar() const { return (unsigned*)(ws + 205 * MB + 24576); }
  DI int* E() const { return (int*)(ws + 138 * MB); }
  DI float* G() const { return (float*)(ws + 146 * MB); }
  DI float* W() const { return (float*)(ws + 154 * MB); }
};

DI unsigned pk2(float a, float b) {
  f32x2_t v = {a, b};
  bf16x2_t r = __builtin_convertvector(v, bf16x2_t);
  return __builtin_bit_cast(unsigned, r);
}
DI float dot2bf(unsigned a, unsigned b, float c) {
  bf16x2_t x = __builtin_bit_cast(bf16x2_t, a);
  bf16x2_t y = __builtin_bit_cast(bf16x2_t, b);
  return __builtin_amdgcn_fdot2_f32_bf16(x, y, c, false);
}
DI float bf_lo(unsigned u) { return __uint_as_float(u << 16); }
DI float bf_hi(unsigned u) { return __uint_as_float(u & 0xffff0000u); }
#define DPPF0(v, ctrl) __builtin_bit_cast(float, __builtin_amdgcn_mov_dpp(__builtin_bit_cast(int, (v)), (ctrl), 0xf, 0xf, true))
DI float swz16_0(float v) { return __builtin_bit_cast(float, __builtin_amdgcn_ds_swizzle(__builtin_bit_cast(int, v), (16 << 10) | 0x1f)); }
DI float wave_sum(float v) {
  v += DPPF0(v, 0xB1);
  v += DPPF0(v, 0x4E);
  v += DPPF0(v, 0x141);
  v += DPPF0(v, 0x140);
  v += swz16_0(v);
  v += __shfl_xor(v, 32);
  return v;
}
DI float wave_max(float v) {
  v = fmaxf(v, DPPF0(v, 0xB1));
  v = fmaxf(v, DPPF0(v, 0x4E));
  v = fmaxf(v, DPPF0(v, 0x141));
  v = fmaxf(v, DPPF0(v, 0x140));
  v = fmaxf(v, swz16_0(v));
  v = fmaxf(v, __shfl_xor(v, 32));
  return v;
}

DI void transpose_tile(const float* __restrict__ src, int ld, int col0, int k0, u16* __restrict__ dst, int n0, char* smem,
                       int tid) {
  float* t = (float*)smem;
  __syncthreads();
  {
    int cc = tid & 63, r0 = tid >> 6;
#pragma unroll
    for (int i = 0; i < 16; i++) {
      int r = r0 + 4 * i;
      t[r * 65 + cc] = src[(size_t)(k0 + r) * ld + col0 + cc];
    }
  }
  __syncthreads();
#pragma unroll
  for (int i = 0; i < 2; i++) {
    int q = tid + 256 * i;
    int n = q >> 3, kc = q & 7;
    uint4 v;
    v.x = pk2(t[(8 * kc + 0) * 65 + n], t[(8 * kc + 1) * 65 + n]);
    v.y = pk2(t[(8 * kc + 2) * 65 + n], t[(8 * kc + 3) * 65 + n]);
    v.z = pk2(t[(8 * kc + 4) * 65 + n], t[(8 * kc + 5) * 65 + n]);
    v.w = pk2(t[(8 * kc + 6) * 65 + n], t[(8 * kc + 7) * 65 + n]);
    *(uint4*)(dst + (size_t)(n0 + n) * 1024 + k0 + 8 * kc) = v;
  }
}

DI void phase0(const Params& p, char* smem, int tid) {
  asm volatile("" : "+v"(tid));
  const int bid = blockIdx.x, nb = gridDim.x;
  if (bid == 0 && tid == 0) { p.counters()[0] = 0u; p.counters()[1] = 0u; }
  {
    float* sc = (float*)smem;
    float* red = (float*)(smem + 32768);
    bool loaded = false;
    for (int it = bid; it < 192; it += nb) {
      if (!loaded) {
        for (int i = tid; i < 8192; i += NTHREADS) {
          float v = p.c[i];
          sc[i] = v / (1.f + __expf(-v));
        }
        loaded = true;
      }
      __syncthreads();
      int col = it * 32 + (tid & 31), kg = tid >> 5;
      float acc[8];
#pragma unroll
      for (int b = 0; b < 8; b++) acc[b] = 0.f;
#pragma unroll 16
      for (int k = kg * 128; k < kg * 128 + 128; k++) {
        float w = p.w_ada[(size_t)k * 6144 + col];
#pragma unroll
        for (int b = 0; b < 8; b++) acc[b] += sc[b * 1024 + k] * w;
      }
#pragma unroll
      for (int b = 0; b < 8; b++) red[(kg * 8 + b) * 32 + (tid & 31)] = acc[b];
      __syncthreads();
      {
        int b = tid >> 5, cc = tid & 31;
        float s = 0.f;
#pragma unroll
        for (int g = 0; g < 8; g++) s += red[(g * 8 + b) * 32 + cc];
        p.mod()[b * 6144 + it * 32 + cc] = s + p.b_ada[it * 32 + cc];
      }
    }
    __syncthreads();
  }
  for (int it = bid; it < 1280; it += nb) {
    if (it < 768) {
      int nt = it >> 4, kt = it & 15;
      int n0 = nt * 64;
      int col0 = n0 < 1536 ? n0 : n0 + 8;
      transpose_tile(p.w_in, INC, col0, kt * 64, p.WtIn(), n0, smem, tid);
    } else if (it < 1024) {
      int j = it - 768;
      transpose_tile(p.w_o, 1024, (j >> 4) * 64, (j & 15) * 64, p.WtO(), (j >> 4) * 64, smem, tid);
    } else {
      int j = it - 1024;
      transpose_tile(p.w_pq, 1024, (j >> 4) * 64, (j & 15) * 64, p.WtPq(), (j >> 4) * 64, smem, tid);
    }
  }
  for (int e = bid * NTHREADS + tid; e < 2048 * 8; e += nb * NTHREADS) {
    int pos = e >> 3, i = e & 7;
    const double invs[8] = {1.0, 0.19392274474868576, 0.03760603093086393, 0.007292664737217109,
                            0.001414213562373095, 0.0002742481756762073, 5.318295896944988e-05, 1.031338537721246e-05};
    double inv = invs[0];
#pragma unroll
    for (int q = 1; q < 8; q++) inv = (i == q) ? invs[q] : inv;
    double ang = (double)pos * inv;
    double t = ang * 0.15915494309189535;
    t -= rint(t);
    double r = t * 6.283185307179586;
    double r2 = r * r;
    double s = 1.0, c = 1.0;
#pragma unroll
    for (int n = 15; n >= 1; n--) {
      s = 1.0 - s * r2 * (1.0 / (double)((2 * n) * (2 * n + 1)));
      c = 1.0 - c * r2 * (1.0 / (double)((2 * n - 1) * (2 * n)));
    }
    s *= r;
    p.rope()[pos * 16 + i] = (float)c;
    p.rope()[pos * 16 + 8 + i] = (float)s;
  }
}

DI void phase1a(const Params& p, char* smem, int tid, int xl, int xcc, int rank, int cnt) {
  asm volatile("" : "+v"(tid));
  float* wfg = (float*)smem;
  __syncthreads();
#pragma unroll 8
  for (int i = tid; i < 8192; i += NTHREADS) {
    int k = i >> 3, j = i & 7;
    wfg[j * 1024 + k] = p.w_in[(size_t)k * INC + 1536 + j];
  }
  __syncthreads();
  const int lane = tid & 63, w = tid >> 6;
  const int t_lo = xl ? 2048 * xcc + rank * 4 + w : blockIdx.x * 4 + w;
  const int t_hi = xl ? 2048 * (xcc + 1) : T_TOK;
  const int t_st = xl ? cnt * 4 : gridDim.x * 4;
  for (int tok = t_lo; tok < t_hi; tok += t_st) {
    const int b = tok >> 11, s = tok & 2047;
    const float* xr = p.x + (size_t)tok * DM;
    float4 xv[4];
    float ss = 0.f;
#pragma unroll
    for (int i = 0; i < 4; i++) {
      xv[i] = *(const float4*)(xr + 256 * i + 4 * lane);
      ss += xv[i].x * xv[i].x + xv[i].y * xv[i].y + xv[i].z * xv[i].z + xv[i].w * xv[i].w;
    }
    ss = wave_sum(ss);
    const float rstd = rsqrtf(ss * (1.f / 1024.f) + 1e-6f);
    const float* md = p.mod() + b * 6144;
    float fg[8];
#pragma unroll
    for (int j = 0; j < 8; j++) fg[j] = 0.f;
#pragma unroll
    for (int i = 0; i < 4; i++) {
      const int c0 = 256 * i + 4 * lane;
      float4 g = *(const float4*)(p.g_attn + c0);
      float4 sh = *(const float4*)(md + c0);
      float4 sc = *(const float4*)(md + 1024 + c0);
      float4 h;
      h.x = xv[i].x * rstd * g.x * (1.f + sc.x) + sh.x;
      h.y = xv[i].y * rstd * g.y * (1.f + sc.y) + sh.y;
      h.z = xv[i].z * rstd * g.z * (1.f + sc.z) + sh.z;
      h.w = xv[i].w * rstd * g.w * (1.f + sc.w) + sh.w;
      uint2 o;
      o.x = pk2(h.x, h.y); o.y = pk2(h.z, h.w);
      *(uint2*)(p.H() + (size_t)tok * DM + c0) = o;
#pragma unroll
      for (int j = 0; j < 8; j++) {
        float4 wv = *(const float4*)(wfg + j * 1024 + c0);
        fg[j] += h.x * wv.x + h.y * wv.y + h.z * wv.z + h.w * wv.w;
      }
    }
#pragma unroll
    for (int j = 0; j < 8; j++) fg[j] = wave_sum(fg[j]);
    float z = fg[0];
#pragma unroll
    for (int j = 1; j < 8; j++) z = (lane == j) ? fg[j] : z;
    if (lane < 8) {
      z += p.b_f[lane];
      float ls = fminf(z, 0.f) - log1pf(__expf(-fabsf(z)));
      p.logf()[(b * 8 + lane) * SEQ + s] = ls;
    }
  }
}

DI void phase_cumsum(const Params& p, char* smem, int tid, int xl, int xcc, int rank, int cnt) {
  asm volatile("" : "+v"(tid));
  double* part = (double*)smem;
  const int s_lo = xl ? 8 * xcc + rank : blockIdx.x;
  const int s_hi = xl ? 8 * (xcc + 1) : 64;
  const int s_st = xl ? cnt : gridDim.x;
  for (int seq = s_lo; seq < s_hi; seq += s_st) {
    __syncthreads();
    const float* lf = p.logf() + seq * SEQ + tid * 8;
    float4 a = *(const float4*)lf, b = *(const float4*)(lf + 4);
    double v0 = a.x, v1 = v0 + a.y, v2 = v1 + a.z, v3 = v2 + a.w, v4 = v3 + b.x, v5 = v4 + b.y, v6 = v5 + b.z, v7 = v6 + b.w;
    double run = v7;
    part[tid] = run;
    __syncthreads();
#pragma unroll 1
    for (int off = 1; off < 256; off <<= 1) {
      const double add = tid >= off ? part[tid - off] : 0.0;
      __syncthreads();
      part[tid] += add;
      __syncthreads();
    }
    const double pre = part[tid] - run;
    const double L2E = 1.4426950408889634;
    float* dst = p.FL() + seq * SEQ + tid * 8;
    *(float4*)dst = make_float4((float)((v0 + pre) * L2E), (float)((v1 + pre) * L2E), (float)((v2 + pre) * L2E), (float)((v3 + pre) * L2E));
    *(float4*)(dst + 4) = make_float4((float)((v4 + pre) * L2E), (float)((v5 + pre) * L2E), (float)((v6 + pre) * L2E), (float)((v7 + pre) * L2E));
  }
  __syncthreads();
}

DI void gemm_mainloop(const u16* __restrict__ Lg, const u16* __restrict__ Rg, int l0, int r0, char* smem, int tid,
                      f32x16 (&acc)[2][2]) {
  const int lane = tid & 63, w = tid >> 6;
  const int wm = w & 1, wn = w >> 1;
  const int r = lane & 31, h = lane >> 5;
  const int lc = tid & 7, lr = tid >> 3;
  const int sw = ((lr >> 1) & 7);
#pragma unroll
  for (int i = 0; i < 2; i++)
#pragma unroll
    for (int j = 0; j < 2; j++)
#pragma unroll
      for (int q = 0; q < 16; q++) acc[i][j][q] = 0.f;
  u32x4 ra0[4], rb0[4], ra1[4], rb1[4];
  const u16* lp = Lg + (size_t)(l0 + lr) * 1024 + lc * 8;
  const u16* rp = Rg + (size_t)(r0 + lr) * 1024 + lc * 8;
#define GLOAD(RA, RB, KT)                                                          \
  _Pragma("unroll") for (int i = 0; i < 4; i++) {                                  \
    RA[i] = *(const u32x4*)(lp + (size_t)i * 32 * 1024 + (KT) * 64);               \
    RB[i] = *(const u32x4*)(rp + (size_t)i * 32 * 1024 + (KT) * 64);               \
  }
#define SSTORE(RA, RB, BUF)                                                        \
  {                                                                                \
    char* dL = smem + (BUF) * 32768;                                               \
    char* dR = dL + 16384;                                                         \
    _Pragma("unroll") for (int i = 0; i < 4; i++) {                                \
      int off = (lr + 32 * i) * 128 + ((lc ^ sw) << 4);                            \
      *(u32x4*)(dL + off) = RA[i];                                                 \
      *(u32x4*)(dR + off) = RB[i];                                                 \
    }                                                                              \
  }
#define COMPUTE(BUF)                                                               \
  {                                                                                \
    const char* sL = smem + (BUF) * 32768;                                         \
    const char* sR = sL + 16384;                                                   \
    _Pragma("unroll") for (int ks = 0; ks < 4; ks++) {                             \
      bf16x8 a[2], b[2];                                                           \
      _Pragma("unroll") for (int i = 0; i < 2; i++) {                              \
        int row = 64 * wm + 32 * i + r;                                            \
        a[i] = *(const bf16x8*)(sL + row * 128 + (((2 * ks + h) ^ ((row >> 1) & 7)) << 4));   \
        int rowb = 64 * wn + 32 * i + r;                                           \
        b[i] = *(const bf16x8*)(sR + rowb * 128 + (((2 * ks + h) ^ ((rowb >> 1) & 7)) << 4)); \
      }                                                                            \
      _Pragma("unroll") for (int i = 0; i < 2; i++)                                \
        _Pragma("unroll") for (int j = 0; j < 2; j++) acc[i][j] = MFMA32(a[i], b[j], acc[i][j]); \
    }                                                                              \
  }
  GLOAD(ra0, rb0, 0)
  GLOAD(ra1, rb1, 1)
  __syncthreads();
  SSTORE(ra0, rb0, 0)
  GLOAD(ra0, rb0, 2)
  __syncthreads();
#pragma unroll 1
  for (int kt = 0; kt < 16; kt += 2) {
    COMPUTE(0)
    SSTORE(ra1, rb1, 1)
    if (kt + 3 < 16) { GLOAD(ra1, rb1, kt + 3) }
    __syncthreads();
    COMPUTE(1)
    if (kt + 2 < 16) {
      SSTORE(ra0, rb0, 0)
      if (kt + 4 < 16) { GLOAD(ra0, rb0, kt + 4) }
    }
    __syncthreads();
  }
#undef GLOAD
#undef SSTORE
#undef COMPUTE
}

struct TileWalk { int start, stride, total; bool xl; int xcc; };
DI TileWalk tile_walk(const Params& p, int xcc, int rank, int ntiles) {
  TileWalk tw;
  bool all = true;
  int mine = 1;
#pragma unroll
  for (int j = 0; j < 8; j++) {
    const int cj = (int)p.census()[64 * j];
    all = all && (cj > 0);
    mine = (j == xcc) ? cj : mine;
  }
  tw.xl = all;
  tw.xcc = xcc;
  tw.start = all ? rank : (int)blockIdx.x;
  tw.stride = all ? mine : (int)gridDim.x;
  tw.total = all ? ntiles / 8 : ntiles;
  return tw;
}
DI void tile_of(const TileWalk& tw, int q, int nn, int& mt, int& nt) {
  if (tw.xl) {
    const int b2 = q >> 6, wi = q & 63;
    const int mi = wi & 7, ni = wi >> 3;
    const int mb = (b2 == 1 || b2 == 2 || b2 == 5) ? 1 : 0;
    const int nb = nn == 24 ? (b2 >> 1) : 0;
    mt = 16 * tw.xcc + 8 * mb + mi;
    nt = 8 * nb + ni;
  } else {
    nt = q % nn;
    mt = q / nn;
  }
}

DI void phase1b(const Params& p, char* smem, int tid, int xcc, int rank) {
  asm volatile("" : "+v"(tid));
  const int lane = tid & 63, w = tid >> 6, wm = w & 1, wn = w >> 1, r = lane & 31, h = lane >> 5;
  const TileWalk tw = tile_walk(p, xcc, rank, 128 * 24);
  for (int t = tw.start; t < tw.total; t += tw.stride) {
    int nt, mt;
    tile_of(tw, t, 24, mt, nt);
    const int m0 = mt * 128, n0 = nt * 128;
    const int b = m0 >> 11, s0 = m0 & 2047;
    const int seg = nt >> 2;
    f32x16 acc[2][2];
    if (seg == 2 || seg == 5) {
      gemm_mainloop(p.H(), p.WtIn(), m0, n0, smem, tid, acc);
      const int kind = seg == 2 ? 0 : 1;
      const int colbase = n0 - (seg == 2 ? 1024 : 2560);
#pragma unroll
      for (int i = 0; i < 2; i++)
#pragma unroll
        for (int j = 0; j < 2; j++) {
          int col = colbase + 64 * wn + 32 * j + r;
          u16* dst = p.Vt() + ((size_t)(kind * 8 + b) * 512 + col) * SEQ + s0 + 64 * wm + 32 * i + 4 * h;
#pragma unroll
          for (int g = 0; g < 4; g++) {
            uint2 o;
            o.x = pk2(acc[i][j][4 * g + 0], acc[i][j][4 * g + 1]);
            o.y = pk2(acc[i][j][4 * g + 2], acc[i][j][4 * g + 3]);
            *(uint2*)(dst + 8 * g) = o;
          }
        }
    } else {
      gemm_mainloop(p.WtIn(), p.H(), n0, m0, smem, tid, acc);
      const int kind = seg == 0 ? 0 : seg == 1 ? 1 : seg == 3 ? 2 : 3;
      if (seg == 1) {
        float mk = 0.f;
#pragma unroll
        for (int i = 0; i < 2; i++)
#pragma unroll
          for (int j = 0; j < 2; j++)
#pragma unroll
            for (int q = 0; q < 16; q++) mk = fmaxf(mk, fabsf(acc[i][j][q]));
        mk = wave_max(mk);
        if (lane == 0) atomicMax(&p.counters()[64 + b * 8 + ((n0 - 512 + 64 * wm) >> 6)], __float_as_uint(mk));
      }
      const int colbase = n0 - (seg == 0 ? 0 : seg == 1 ? 512 : seg == 3 ? 1536 : 2048);
      const bool rope = (seg >= 3);
      const float scale = (seg == 0 || seg == 3) ? 0.125f * LOG2E : 1.f;
#pragma unroll
      for (int j = 0; j < 2; j++) {
        const int s = s0 + 64 * wn + 32 * j + r;
        f32x4 cs = {1.f, 1.f, 1.f, 1.f}, sn = {0.f, 0.f, 0.f, 0.f};
        if (rope) {
          cs = *(const f32x4*)(p.rope() + s * 16 + 4 * h);
          sn = *(const f32x4*)(p.rope() + s * 16 + 8 + 4 * h);
        }
#pragma unroll
        for (int i = 0; i < 2; i++) {
          const int colt = colbase + 64 * wm + 32 * i;
          const int hc = colt >> 6, d0 = colt & 63;
          f32x16 v = acc[i][j];
          if (rope && i == 0) {
#pragma unroll
            for (int q = 0; q < 4; q++) {
              float t1 = v[q], t2 = v[q + 4];
              v[q] = t1 * cs[q] - t2 * sn[q];
              v[q + 4] = t2 * cs[q] + t1 * sn[q];
            }
          }
          u16* dst = p.QK() + (((size_t)(kind * 8 + b) * 8 + hc) * SEQ + s) * 64 + d0 + 4 * h;
#pragma unroll
          for (int g = 0; g < 4; g++) {
            uint2 o;
            o.x = pk2(v[4 * g + 0] * scale, v[4 * g + 1] * scale);
            o.y = pk2(v[4 * g + 2] * scale, v[4 * g + 3] * scale);
            *(uint2*)(dst + 8 * g) = o;
          }
        }
      }
    }
  }
}

template <int DV, bool HASF>
DI void attn_pass(const u16* __restrict__ Qg, const u16* __restrict__ Kg, const u16* __restrict__ Vtg,
                  const float* __restrict__ FLg, int q0, char* smem, int tid, f32x16 (&o)[DV / 32], float kmax = 0.f) {
  constexpr int NMB = DV / 32;
  constexpr int KSZ = 64 * 144;
  constexpr int VSZ = DV * 136;
  constexpr int STAGE = KSZ + VSZ + 256;
  constexpr int NVL = DV / 32;
  const int lane = tid & 63, w = tid >> 6, r = lane & 31, h = lane >> 5;
  const int qw0 = q0 + 32 * w;
  const int qcol = qw0 + r;
  const int nkt = (q0 + 128) >> 6;
  bf16x8 qf[4];
#pragma unroll
  for (int ks = 0; ks < 4; ks++) qf[ks] = *(const bf16x8*)(Qg + (size_t)qcol * 64 + 16 * ks + 8 * h);
#pragma unroll
  for (int mb = 0; mb < NMB; mb++)
#pragma unroll
    for (int q = 0; q < 16; q++) o[mb][q] = 0.f;
  float m_run = -INFINITY, lsum = 0.f;

  u32x4 rk[2], rv[NVL];
  f32x4 rf = {0.f, 0.f, 0.f, 0.f};
  auto gloadK = [&](int kt) {
    const int k0 = kt * 64;
#pragma unroll
    for (int i = 0; i < 2; i++) {
      int idx = tid + 256 * i;
      rk[i] = *(const u32x4*)(Kg + (size_t)(k0 + (idx >> 3)) * 64 + (idx & 7) * 8);
    }
    if (HASF) {
      if (tid < 16) rf = *(const f32x4*)(FLg + k0 + 4 * tid);
    }
  };
  auto gloadV = [&](int kt) {
    const int k0 = kt * 64;
#pragma unroll
    for (int i = 0; i < NVL; i++) {
      int idx = tid + 256 * i;
      rv[i] = *(const u32x4*)(Vtg + (size_t)(idx >> 3) * SEQ + k0 + (idx & 7) * 8);
    }
  };
  auto gload = [&](int kt) { gloadK(kt); gloadV(kt); };
  auto sstore = [&](int stage) {
    char* sK = smem + stage * STAGE;
    char* sV = sK + KSZ;
    float* sF = (float*)(sV + VSZ);
#pragma unroll
    for (int i = 0; i < 2; i++) {
      int idx = tid + 256 * i;
      int row = idx >> 3, c = idx & 7;
      *(u32x4*)(sK + row * 144 + (c << 4)) = rk[i];
    }
#pragma unroll
    for (int i = 0; i < NVL; i++) {
      int idx = tid + 256 * i;
      int row = idx >> 3, c = idx & 7;
      *(u32x2*)(sV + row * 136 + (c << 4)) = u32x2{rv[i].x, rv[i].y};
      *(u32x2*)(sV + row * 136 + (c << 4) + 8) = u32x2{rv[i].z, rv[i].w};
    }
    if (HASF) {
      if (tid < 16) *(f32x4*)(sF + 4 * tid) = rf;
    }
  };

  float qb = 0.f;
  bool done = false;
  if (HASF) {
#pragma unroll
    for (int ks = 0; ks < 4; ks++)
#pragma unroll
      for (int j = 0; j < 8; j++) {
        const unsigned short qs = (unsigned short)qf[ks][j];
        qb += fabsf(__uint_as_float(((unsigned)qs) << 16));
      }
    qb += __shfl_xor(qb, 32);
    qb *= kmax;
  }
  __syncthreads();
  gload(HASF ? nkt - 1 : 0);
  sstore(0);
  __syncthreads();
  for (int jt = 0; jt < nkt; jt++) {
    const int kt = HASF ? nkt - 1 - jt : jt;
    const int ktn = HASF ? kt - 1 : kt + 1;
    if (jt + 1 < nkt) { gloadK(ktn); gloadV(ktn); }
    if (HASF) {
      if (kt * 64 <= qw0 && !done) {
        const float flast = ((const float*)(smem + (jt & 1) * STAGE + KSZ + VSZ))[63];
        const bool keep = !(qb - flast < m_run - 40.f);
        if (__ballot(keep) == 0ull) done = true;
      }
    }
    if (kt * 64 <= qw0 && !done) {
      const char* sK = smem + (jt & 1) * STAGE;
      const char* sV = sK + KSZ;
      const float* sF = (const float*)(sV + VSZ);
      const char* sKl = sK + r * 144 + h * 16;
      const char* sVl = sV + r * 136 + h * 8;
      f32x16 s[2];
#pragma unroll
      for (int mt = 0; mt < 2; mt++) {
#pragma unroll
        for (int q = 0; q < 16; q++) s[mt][q] = 0.f;
#pragma unroll
        for (int ks = 0; ks < 4; ks++) {
          bf16x8 a = *(const bf16x8*)(sKl + mt * (32 * 144) + ks * 32);
          s[mt] = MFMA32(a, qf[ks], s[mt]);
        }
      }
      if (HASF) {
#pragma unroll
        for (int mt = 0; mt < 2; mt++)
#pragma unroll
          for (int g = 0; g < 4; g++) {
            float4 f = *(const float4*)(sF + 32 * mt + 8 * g + 4 * h);
            s[mt][4 * g + 0] -= f.x;
            s[mt][4 * g + 1] -= f.y;
            s[mt][4 * g + 2] -= f.z;
            s[mt][4 * g + 3] -= f.w;
          }
      }
      if (kt * 64 + 63 > qw0) {
#pragma unroll
        for (int mt = 0; mt < 2; mt++)
#pragma unroll
          for (int q = 0; q < 16; q++) {
            int key = kt * 64 + 32 * mt + (q & 3) + 8 * (q >> 2) + 4 * h;
            s[mt][q] = key > qcol ? -INFINITY : s[mt][q];
          }
      }
      float mx = s[0][0];
#pragma unroll
      for (int mt = 0; mt < 2; mt++)
#pragma unroll
        for (int q = 0; q < 16; q++) mx = fmaxf(mx, s[mt][q]);
      mx = fmaxf(mx, __shfl_xor(mx, 32));
      const float m_new = fmaxf(m_run, mx);
      const float alpha = __builtin_amdgcn_exp2f(m_run - m_new);
      m_run = m_new;
      float ps = 0.f;
#pragma unroll
      for (int mt = 0; mt < 2; mt++)
#pragma unroll
        for (int q = 0; q < 16; q++) {
          float pv = __builtin_amdgcn_exp2f(s[mt][q] - m_new);
          s[mt][q] = pv;
          ps += pv;
        }
      lsum = lsum * alpha + ps;
#pragma unroll
      for (int mb = 0; mb < NMB; mb++)
#pragma unroll
        for (int q = 0; q < 16; q++) o[mb][q] *= alpha;
#pragma unroll
      for (int ks = 0; ks < 4; ks++) {
        const int mt = ks >> 1, q0r = 8 * (ks & 1);
        u32x4 pu;
        pu.x = pk2(s[mt][q0r + 0], s[mt][q0r + 1]);
        pu.y = pk2(s[mt][q0r + 2], s[mt][q0r + 3]);
        pu.z = pk2(s[mt][q0r + 4], s[mt][q0r + 5]);
        pu.w = pk2(s[mt][q0r + 6], s[mt][q0r + 7]);
        bf16x8 pb = __builtin_bit_cast(bf16x8, pu);
#pragma unroll
        for (int mb = 0; mb < NMB; mb++) {
          u32x2 lo = *(const u32x2*)(sVl + mb * (32 * 136) + ks * 32);
          u32x2 hi = *(const u32x2*)(sVl + mb * (32 * 136) + ks * 32 + 16);
          u32x4 au = {lo.x, lo.y, hi.x, hi.y};
          bf16x8 a = __builtin_bit_cast(bf16x8, au);
          o[mb] = MFMA32(a, pb, o[mb]);
        }
      }
    }
    if (jt + 1 < nkt) { sstore((jt + 1) & 1); }
    if (HASF) {
      if (!__syncthreads_or(done ? 0 : 1)) break;
    } else {
      __syncthreads();
    }
  }
  float l = lsum + __shfl_xor(lsum, 32);
  const float inv = 1.f / l;
#pragma unroll
  for (int mb = 0; mb < NMB; mb++)
#pragma unroll
    for (int q = 0; q < 16; q++) o[mb][q] *= inv;
}

DI unsigned pack_i8x4(float a, float b, float c, float d) {
  const int q0 = (int)rintf(a), q1 = (int)rintf(b), q2 = (int)rintf(c), q3 = (int)rintf(d);
  return (unsigned)(q0 & 255) | ((unsigned)(q1 & 255) << 8) | ((unsigned)(q2 & 255) << 16) | ((unsigned)(q3 & 255) << 24);
}
DI void convert_chunk(const Params& p, int c, int tid) {
  const size_t ngroups = (size_t)16384 * 1024 / 16;
#pragma unroll 4
  for (int i = 0; i < 16; i++) {
    const size_t g = (size_t)c * 4096 + (size_t)i * NTHREADS + tid;
    const bool isu = g < ngroups;
    if (isu) {
      const float* src = p.u_exp + g * 16;
      float4 x[4];
      float mx = 0.f;
#pragma unroll
      for (int q = 0; q < 4; q++) {
        x[q] = *(const float4*)(src + 4 * q);
        mx = fmaxf(mx, fmaxf(fmaxf(fabsf(x[q].x), fabsf(x[q].y)), fmaxf(fabsf(x[q].z), fabsf(x[q].w))));
      }
      mx = wave_max(mx);
      const float inv = mx > 0.f ? 127.f / mx : 0.f;
      u32x4 v;
#pragma unroll
      for (int q = 0; q < 4; q++) v[q] = pack_i8x4(x[q].x * inv, x[q].y * inv, x[q].z * inv, x[q].w * inv);
      *(u32x4*)(p.Uq() + g * 16) = v;
      if ((tid & 63) == 0) p.su()[g >> 6] = mx * (1.f / 127.f);
    } else {
      const size_t gv = g - ngroups;
      const float* src = p.v_exp + gv * 16;
      const size_t e = gv >> 6, d = (gv & 63) * 16;
      unsigned char* dst = p.Vq() + (d >> 7) * ((size_t)16384 * 128) + e * 128 + (d & 127);
      u32x4 v;
#pragma unroll
      for (int q = 0; q < 4; q++) {
        float4 a = *(const float4*)(src + 4 * q);
        unsigned wv = 0;
        wv = __builtin_amdgcn_cvt_pk_fp8_f32(a.x * 8.f, a.y * 8.f, wv, false);
        wv = __builtin_amdgcn_cvt_pk_fp8_f32(a.z * 8.f, a.w * 8.f, wv, true);
        v[q] = wv;
      }
      *(u32x4*)dst = v;
    }
  }
}

DI void phase2(const Params& p, char* smem, int tid, int xl, int xcc) {
  asm volatile("" : "+v"(tid));
  const int lane = tid & 63, w = tid >> 6, r = lane & 31, h = lane >> 5;
  __shared__ int s_item;
  for (;;) {
    __syncthreads();
    if (tid == 0) s_item = (int)atomicAdd(&p.counters()[xl ? 256 + 64 * xcc : 0], 1u);
    __syncthreads();
    const int qi = s_item;
    if (qi >= (xl ? 256 : 2048)) break;
    if ((qi & 3) == 3) {
      convert_chunk(p, xl ? (qi >> 2) * 8 + xcc : (qi >> 2), tid);
      continue;
    }
    int item = (qi >> 2) * 3 + (qi & 3);
    int tid_i = threadIdx.x;
    asm volatile("" : "+v"(tid_i));
    if (xl) {
      const int li = item;
      if (li < 64) item = ((li >> 2) << 5) | (xcc << 2) | (li & 3);
      else { const int lf = li - 64; item = 512 + (((lf >> 3) << 6) | (xcc << 3) | (lf & 7)); }
    }
    if (item < 512) {
      const int qt = 15 - (item >> 5), bh = item & 31, b = bh >> 2, dh = bh & 3;
      const int q0 = qt * 128;
      const u16* Vtg = p.Vt() + ((size_t)(8 + b) * 512 + dh * 128) * SEQ;
      float* stash = p.stash() + ((size_t)blockIdx.x * NTHREADS + tid) * 64;
      f32x16 o[4];
#pragma unroll 1
      for (int c = 0; c < 2; c++) {
        const u16* Qg = p.QK() + ((size_t)(2 * 8 + b) * 8 + dh * 2 + c) * SEQ * 64;
        const u16* Kg = p.QK() + ((size_t)(3 * 8 + b) * 8 + dh * 2 + c) * SEQ * 64;
        attn_pass<128, false>(Qg, Kg, Vtg, nullptr, q0, smem, tid_i, o);
        if (c == 0) {
#pragma unroll
          for (int mb = 0; mb < 4; mb++)
#pragma unroll
            for (int q = 0; q < 4; q++)
              *(f32x4*)(stash + mb * 16 + q * 4) = f32x4{o[mb][4 * q], o[mb][4 * q + 1], o[mb][4 * q + 2], o[mb][4 * q + 3]};
        }
      }
      float d1 = 0.f, d2 = 0.f;
      for (int i = 0; i < 64; i++) {
        d1 += p.lq1[i] * p.lk1[i];
        d2 += p.lq2[i] * p.lk2[i];
      }
      const float lam = expf(d1) - expf(d2) + 0.2f;
      float ss = 0.f;
#pragma unroll
      for (int mb = 0; mb < 4; mb++)
#pragma unroll
        for (int q4 = 0; q4 < 4; q4++) {
          f32x4 sv = *(const f32x4*)(stash + mb * 16 + q4 * 4);
#pragma unroll
          for (int e = 0; e < 4; e++) {
            float a0 = sv[e] - lam * o[mb][4 * q4 + e];
            o[mb][4 * q4 + e] = a0;
            ss += a0 * a0;
          }
        }
      ss += __shfl_xor(ss, 32);
      const float rstd = rsqrtf(ss * (1.f / 128.f) + 1e-5f) * 0.8f;
      const int tok = b * SEQ + q0 + 32 * w + r;
#pragma unroll
      for (int mb = 0; mb < 4; mb++)
#pragma unroll
        for (int g = 0; g < 4; g++) {
          const int d = 32 * mb + 8 * g + 4 * h;
          float4 gs = *(const float4*)(p.g_subln + d);
          uint2 ov;
          ov.x = pk2(o[mb][4 * g + 0] * rstd * gs.x, o[mb][4 * g + 1] * rstd * gs.y);
          ov.y = pk2(o[mb][4 * g + 2] * rstd * gs.z, o[mb][4 * g + 3] * rstd * gs.w);
          *(uint2*)(p.H() + (size_t)tok * DM + 512 + dh * 128 + d) = ov;
        }
    } else {
      const int it = item - 512;
      const int qt = 15 - (it >> 6), bh = it & 63, b = bh >> 3, hd = bh & 7;
      const int q0 = qt * 128;
      const u16* Qg = p.QK() + ((size_t)(0 * 8 + b) * 8 + hd) * SEQ * 64;
      const u16* Kg = p.QK() + ((size_t)(1 * 8 + b) * 8 + hd) * SEQ * 64;
      const u16* Vtg = p.Vt() + ((size_t)(0 + b) * 512 + hd * 64) * SEQ;
      const float* FLg = p.FL() + (b * 8 + hd) * SEQ;
      f32x16 o[2];
      attn_pass<64, true>(Qg, Kg, Vtg, FLg, q0, smem, tid_i, o, __uint_as_float(p.counters()[64 + b * 8 + hd]) * 1.01f);
      const int tok = b * SEQ + q0 + 32 * w + r;
#pragma unroll
      for (int mb = 0; mb < 2; mb++)
#pragma unroll
        for (int g = 0; g < 4; g++) {
          const int d = 32 * mb + 8 * g + 4 * h;
          uint2 ov;
          ov.x = pk2(o[mb][4 * g + 0], o[mb][4 * g + 1]);
          ov.y = pk2(o[mb][4 * g + 2], o[mb][4 * g + 3]);
          *(uint2*)(p.H() + (size_t)tok * DM + hd * 64 + d) = ov;
        }
    }
  }
}

DI void phase3(const Params& p, char* smem, int tid, int xcc, int rank) {
  asm volatile("" : "+v"(tid));
  const int lane = tid & 63, w = tid >> 6, wm = w & 1, wn = w >> 1, r = lane & 31, h = lane >> 5;
  const TileWalk tw = tile_walk(p, xcc, rank, 128 * 8);
  for (int t = tw.start; t < tw.total; t += tw.stride) {
    int nt, mt;
    tile_of(tw, t, 8, mt, nt);
    const int m0 = mt * 128, n0 = nt * 128;
    const int b = m0 >> 11;
    f32x16 acc[2][2];
    gemm_mainloop(p.WtO(), p.H(), n0, m0, smem, tid, acc);
#pragma unroll
    for (int j = 0; j < 2; j++) {
      const int tok = m0 + 64 * wn + 32 * j + r;
#pragma unroll
      for (int i = 0; i < 2; i++)
#pragma unroll
        for (int g = 0; g < 4; g++) {
          const int n = n0 + 64 * wm + 32 * i + 8 * g + 4 * h;
          float4 xv = *(const float4*)(p.x + (size_t)tok * DM + n);
          float4 gt = *(const float4*)(p.mod() + b * 6144 + 2048 + n);
          float4 ov;
          ov.x = xv.x + gt.x * acc[i][j][4 * g + 0];
          ov.y = xv.y + gt.y * acc[i][j][4 * g + 1];
          ov.z = xv.z + gt.z * acc[i][j][4 * g + 2];
          ov.w = xv.w + gt.w * acc[i][j][4 * g + 3];
          *(float4*)(p.out + (size_t)tok * DM + n) = ov;
        }
    }
  }
}

DI void phase3b(const Params& p, int tid, int xl, int xcc, int rank, int cnt) {
  asm volatile("" : "+v"(tid));
  const int lane = tid & 63, w = tid >> 6;
  const int t_lo = xl ? 2048 * xcc + (rank * 4 + w) * 2 : (blockIdx.x * 4 + w) * 2;
  const int t_hi = xl ? 2048 * (xcc + 1) : T_TOK;
  const int t_st = xl ? cnt * 8 : gridDim.x * 8;
  for (int tok = t_lo; tok < t_hi; tok += t_st) {
    const int b = tok >> 11;
    const float* xr = p.out + (size_t)tok * DM;
    float4 xv[2][4];
    float ss[2] = {0.f, 0.f};
#pragma unroll
    for (int t = 0; t < 2; t++)
#pragma unroll
      for (int i = 0; i < 4; i++) xv[t][i] = *(const float4*)(xr + t * DM + 256 * i + 4 * lane);
#pragma unroll
    for (int t = 0; t < 2; t++)
#pragma unroll
      for (int i = 0; i < 4; i++)
        ss[t] += xv[t][i].x * xv[t][i].x + xv[t][i].y * xv[t][i].y + xv[t][i].z * xv[t][i].z + xv[t][i].w * xv[t][i].w;
    ss[0] = wave_sum(ss[0]);
    ss[1] = wave_sum(ss[1]);
    const float rstd0 = rsqrtf(ss[0] * (1.f / 1024.f) + 1e-6f);
    const float rstd1 = rsqrtf(ss[1] * (1.f / 1024.f) + 1e-6f);
    const float* md = p.mod() + b * 6144;
#pragma unroll
    for (int i = 0; i < 4; i++) {
      const int c0 = 256 * i + 4 * lane;
      float4 g = *(const float4*)(p.g_ffn + c0);
      float4 sh = *(const float4*)(md + 3072 + c0);
      float4 sc = *(const float4*)(md + 4096 + c0);
#pragma unroll
      for (int t = 0; t < 2; t++) {
        const float rstd = t ? rstd1 : rstd0;
        float4 hv;
        hv.x = xv[t][i].x * rstd * g.x * (1.f + sc.x) + sh.x;
        hv.y = xv[t][i].y * rstd * g.y * (1.f + sc.y) + sh.y;
        hv.z = xv[t][i].z * rstd * g.z * (1.f + sc.z) + sh.z;
        hv.w = xv[t][i].w * rstd * g.w * (1.f + sc.w) + sh.w;
        xv[t][i] = hv;
        uint2 o;
        o.x = pk2(hv.x, hv.y);
        o.y = pk2(hv.z, hv.w);
        *(uint2*)(p.H() + (size_t)(tok + t) * DM + c0) = o;
      }
    }
#pragma unroll
    for (int t = 0; t < 2; t++) {
      float mx = 0.f;
#pragma unroll
      for (int i = 0; i < 4; i++)
        mx = fmaxf(mx, fmaxf(fmaxf(fabsf(xv[t][i].x), fabsf(xv[t][i].y)), fmaxf(fabsf(xv[t][i].z), fabsf(xv[t][i].w))));
      mx = wave_max(mx);
      const float inv = mx > 0.f ? 127.f / mx : 0.f;
#pragma unroll
      for (int i = 0; i < 4; i++)
        *(unsigned*)(p.Hq() + (size_t)(tok + t) * DM + 256 * i + 4 * lane) =
            pack_i8x4(xv[t][i].x * inv, xv[t][i].y * inv, xv[t][i].z * inv, xv[t][i].w * inv);
      if (lane == 0) p.hs()[tok + t] = mx * (1.f / 127.f);
    }
  }
}

DI void phase4(const Params& p, char* smem, int tid, int xcc, int rank) {
  asm volatile("" : "+v"(tid));
  const int lane = tid & 63, w = tid >> 6, wm = w & 1, wn = w >> 1, r = lane & 31, h = lane >> 5;
  const TileWalk tw = tile_walk(p, xcc, rank, 128 * 8);
  for (int t = tw.start; t < tw.total; t += tw.stride) {
    int nt, mt;
    tile_of(tw, t, 8, mt, nt);
    const int m0 = mt * 128, n0 = nt * 128;
    f32x16 acc[2][2];
    gemm_mainloop(p.WtPq(), p.H(), n0, m0, smem, tid, acc);
#pragma unroll
    for (int j = 0; j < 2; j++) {
      const int tok = m0 + 64 * wn + 32 * j + r;
#pragma unroll
      for (int i = 0; i < 2; i++)
#pragma unroll
        for (int g = 0; g < 4; g++) {
          const int n = n0 + 64 * wm + 32 * i + 8 * g + 4 * h;
          uint2 o;
          o.x = pk2(acc[i][j][4 * g + 0], acc[i][j][4 * g + 1]);
          o.y = pk2(acc[i][j][4 * g + 2], acc[i][j][4 * g + 3]);
          *(uint2*)(p.Qp() + (size_t)tok * DM + n) = o;
        }
    }
  }
}

template <int N>
struct TR {
  static DI float run(float (&part)[N], int lane) {
    constexpr int H = N / 2;
    float nxt[H];
    const bool up = (lane & H) != 0;
#pragma unroll
    for (int i = 0; i < H; i++) {
      float keep = up ? part[i + H] : part[i];
      float send = up ? part[i] : part[i + H];
      nxt[i] = keep + __shfl_xor(send, H);
    }
    return TR<H>::run(nxt, lane);
  }
};
template <>
struct TR<1> {
  static DI float run(float (&part)[1], int) { return part[0]; }
};


#define DPPF(v, ctrl) __builtin_bit_cast(float, __builtin_amdgcn_mov_dpp(__builtin_bit_cast(int, (v)), (ctrl), 0xf, 0xf, true))
DI float swz_xor16(float v) { return __builtin_bit_cast(float, __builtin_amdgcn_ds_swizzle(__builtin_bit_cast(int, v), (16 << 10) | 0x1f)); }
DI int bperm_xor32_i(int v, int lane) { return __builtin_amdgcn_ds_bpermute((lane ^ 32) << 2, v); }
DI float bperm_xor32(float v, int lane) { return __builtin_bit_cast(float, __builtin_amdgcn_ds_bpermute((lane ^ 32) << 2, __builtin_bit_cast(int, v))); }
DI float wave_sum_dpp(float v, int lane) {
  v += DPPF(v, 0xB1);
  v += DPPF(v, 0x4E);
  v += DPPF(v, 0x141);
  v += DPPF(v, 0x140);
  v += swz_xor16(v);
  v += bperm_xor32(v, lane);
  return v;
}
DI float tr16_dpp(const float (&part)[16], int lane) {
  float n8[8], n4[4], n2[2];
  {
    const bool up = (lane & 8) != 0;
#pragma unroll
    for (int i = 0; i < 8; i++) {
      float keep = up ? part[i + 8] : part[i];
      float send = up ? part[i] : part[i + 8];
      n8[i] = keep + DPPF(send, 0x140);
    }
  }
  {
    const bool up = (lane & 4) != 0;
#pragma unroll
    for (int i = 0; i < 4; i++) {
      float keep = up ? n8[i + 4] : n8[i];
      float send = up ? n8[i] : n8[i + 4];
      n4[i] = keep + DPPF(send, 0x141);
    }
  }
  {
    const bool up = (lane & 2) != 0;
#pragma unroll
    for (int i = 0; i < 2; i++) {
      float keep = up ? n4[i + 2] : n4[i];
      float send = up ? n4[i] : n4[i + 2];
      n2[i] = keep + DPPF(send, 0x1B);
    }
  }
  const bool up = (lane & 1) != 0;
  float keep = up ? n2[1] : n2[0];
  float send = up ? n2[0] : n2[1];
  return keep + DPPF(send, 0xB1);
}

DI int f2key(float f) { int b = __float_as_int(f); return b ^ ((b >> 31) & 0x7fffffff); }
DI float key2f(int k) { return __int_as_float(k ^ ((k >> 31) & 0x7fffffff)); }
DI void insert16(int (&L)[16], int x) {
#pragma unroll
  for (int k = 0; k < 16; k++) {
    int t = max(L[k], x);
    x = min(L[k], x);
    L[k] = t;
  }
}
DI void bitonic_sort16(int (&L)[16]) {
#pragma unroll
  for (int s = 8; s >= 1; s >>= 1)
#pragma unroll
    for (int i = 0; i < 16; i++)
      if ((i & s) == 0) {
        int x = L[i], y = L[i + s];
        L[i] = max(x, y);
        L[i + s] = min(x, y);
      }
}
DI void bitonic_full16(int (&L)[16]) {
#pragma unroll
  for (int k = 2; k <= 16; k <<= 1)
#pragma unroll
    for (int j = k >> 1; j > 0; j >>= 1)
#pragma unroll
      for (int i = 0; i < 16; i++) {
        const int l = i ^ j;
        if (l > i) {
          const int x = L[i], y = L[l];
          if ((i & k) == 0) { L[i] = max(x, y); L[l] = min(x, y); }
          else { L[i] = min(x, y); L[l] = max(x, y); }
        }
      }
}
DI int lookup_byte(int p0, int p1, int p2, int p3, int i) {
  int d = i < 8 ? (i < 4 ? p0 : p1) : (i < 12 ? p2 : p3);
  return (d >> ((i & 3) * 8)) & 255;
}
constexpr int CAND_I[50] = {0,0,0,0,0,0,0,0,0,0,0,0,0,0,0,0,1,1,1,1,1,1,1,1,2,2,2,2,2,3,3,3,3,4,4,4,5,5,6,6,7,7,8,9,10,11,12,13,14,15};
constexpr int CAND_J[50] = {0,1,2,3,4,5,6,7,8,9,10,11,12,13,14,15,0,1,2,3,4,5,6,7,0,1,2,3,4,0,1,2,3,0,1,2,0,1,0,1,0,1,0,0,0,0,0,0,0,0};

DI void phase5(const Params& p, char* smem, int tid, int xl, int xcc, int rank, int cnt) {
  asm volatile("" : "+v"(tid));
  const int lane_outer = tid & 63, w = tid >> 6;
  char* skl = smem;
  int* El = (int*)(smem + 36864 + w * 4096);
  float* Gl = (float*)(El + 512);
  __syncthreads();
  for (int i = tid; i < 2 * 128 * 8; i += NTHREADS) {
    const int row = i >> 3, ch = i & 7;
    const float* src = p.sub_keys + (size_t)row * 64 + ch * 8;
    float4 a = *(const float4*)src, b = *(const float4*)(src + 4);
    u32x4 u = {pk2(a.x, a.y), pk2(a.z, a.w), pk2(b.x, b.y), pk2(b.z, b.w)};
    *(u32x4*)(skl + row * 144 + ch * 16) = u;
  }
  __syncthreads();
  const int IMIN = (int)0x80000000;
  const int g_lo = xl ? 512 * xcc + rank * 4 + w : blockIdx.x * 4 + w;
  const int g_hi = xl ? 512 * (xcc + 1) : T_TOK / 4;
  const int g_st = xl ? cnt * 4 : gridDim.x * 4;
  for (int grp = g_lo; grp < g_hi; grp += g_st) {
    const int tok0 = grp * 4;
    int lane_s1 = lane_outer;
    asm volatile("" : "+v"(lane_s1));
    {
    const int lane = lane_s1, r = lane & 31, h = lane >> 5;
    (void)lane;
    int LA[16], LB[16];
    {
      const int tl = r >> 3, hd = r & 7;
      const u16* qsrc = p.Qp() + (size_t)(tok0 + tl) * DM + hd * 128 + 8 * h;
#pragma unroll
      for (int c = 0; c < 2; c++) {
        bf16x8 qb[4];
#pragma unroll
        for (int ks = 0; ks < 4; ks++) qb[ks] = *(const bf16x8*)(qsrc + c * 64 + 16 * ks);
        int L[16];
#pragma unroll
        for (int k = 0; k < 16; k++) L[k] = IMIN;
#pragma unroll
        for (int mt = 0; mt < 4; mt++) {
          f32x16 sc;
#pragma unroll
          for (int q = 0; q < 16; q++) sc[q] = 0.f;
#pragma unroll
          for (int ks = 0; ks < 4; ks++) {
            bf16x8 ska = *(const bf16x8*)(skl + (c * 128 + 32 * mt + r) * 144 + ks * 32 + h * 16);
            sc = MFMA32(ska, qb[ks], sc);
          }
          int T[16];
#pragma unroll
          for (int q = 0; q < 16; q++) {
            const int pay = 32 * mt + (q & 3) + 8 * (q >> 2);
            T[q] = (f2key(sc[q]) & ~127) | pay;
          }
          bitonic_full16(T);
          if (mt == 0) {
#pragma unroll
            for (int k = 0; k < 16; k++) L[k] = T[k];
          } else {
#pragma unroll
            for (int k = 0; k < 16; k++) L[k] = max(L[k], T[15 - k]);
            bitonic_sort16(L);
          }
        }
#pragma unroll
        for (int k = 0; k < 16; k++) {
          if (c == 0) LA[k] = L[k] | (h << 2); else LB[k] = L[k] | (h << 2);
        }
      }
    }
    int M[16];
    {
      int recv[16];
#pragma unroll
      for (int k = 0; k < 16; k++) {
        int send = h ? LA[k] : LB[k];
        recv[k] = bperm_xor32_i(send, lane);
      }
#pragma unroll
      for (int k = 0; k < 16; k++) {
        int mine = h ? LB[k] : LA[k];
        M[k] = max(mine, recv[15 - k]);
      }
      bitonic_sort16(M);
    }
    int pa0, pa1, pa2, pa3, pb0, pb1, pb2, pb3;
    int F[16];
    {
      float av[16], bv[16];
      int ai[16], bi[16];
#pragma unroll
      for (int k = 0; k < 16; k++) {
        int o = bperm_xor32_i(M[k], lane);
        int ka = h ? o : M[k];
        int kb = h ? M[k] : o;
        av[k] = key2f(ka);
        bv[k] = key2f(kb);
        ai[k] = ka & 127;
        bi[k] = kb & 127;
      }
      pa0 = ai[0] | (ai[1] << 8) | (ai[2] << 16) | (ai[3] << 24);
      pa1 = ai[4] | (ai[5] << 8) | (ai[6] << 16) | (ai[7] << 24);
      pa2 = ai[8] | (ai[9] << 8) | (ai[10] << 16) | (ai[11] << 24);
      pa3 = ai[12] | (ai[13] << 8) | (ai[14] << 16) | (ai[15] << 24);
      pb0 = bi[0] | (bi[1] << 8) | (bi[2] << 16) | (bi[3] << 24);
      pb1 = bi[4] | (bi[5] << 8) | (bi[6] << 16) | (bi[7] << 24);
      pb2 = bi[8] | (bi[9] << 8) | (bi[10] << 16) | (bi[11] << 24);
      pb3 = bi[12] | (bi[13] << 8) | (bi[14] << 16) | (bi[15] << 24);
      int L[16];
#pragma unroll
      for (int k = 0; k < 16; k++) L[k] = IMIN;
#pragma unroll
      for (int m = 0; m < 25; m++) {
        const int i0 = CAND_I[2 * m], j0 = CAND_J[2 * m], i1 = CAND_I[2 * m + 1], j1 = CAND_J[2 * m + 1];
        float s0 = av[i0] + bv[j0], s1 = av[i1] + bv[j1];
        float s = h ? s1 : s0;
        int pay = h ? ((i1 << 4) | j1) : ((i0 << 4) | j0);
        int key = (f2key(s) & ~255) | pay;
        insert16(L, key);
      }
#pragma unroll
      for (int k = 0; k < 16; k++) {
        int o = bperm_xor32_i(L[15 - k], lane);
        F[k] = max(L[k], o);
      }
    }
    {
      int mk = F[0];
#pragma unroll
      for (int k = 1; k < 16; k++) mk = max(mk, F[k]);
      const float mx = key2f(mk);
      float ex[8];
      float sm = 0.f;
#pragma unroll
      for (int k = 0; k < 8; k++) {
        ex[k] = __expf(key2f(F[k]) - mx);
        sm += ex[k];
      }
      sm += bperm_xor32(sm, lane);
      const float inv = 1.f / sm;
      int ev[8];
#pragma unroll
      for (int k = 0; k < 8; k++) {
        const int pay = F[k] & 255;
        ev[k] = lookup_byte(pa0, pa1, pa2, pa3, pay >> 4) * 128 + lookup_byte(pb0, pb1, pb2, pb3, pay & 15);
        ex[k] *= inv;
      }
      const int tokc = tok0 + (r >> 3);
      int* ed = p.E() + (size_t)tokc * 128 + (r & 7) * 16 + 8 * h;
      float* gd = p.G() + (size_t)tokc * 128 + (r & 7) * 16 + 8 * h;
      *(u32x4*)ed = u32x4{(unsigned)ev[0], (unsigned)ev[1], (unsigned)ev[2], (unsigned)ev[3]};
      *(u32x4*)(ed + 4) = u32x4{(unsigned)ev[4], (unsigned)ev[5], (unsigned)ev[6], (unsigned)ev[7]};
      *(f32x4*)gd = f32x4{ex[0], ex[1], ex[2], ex[3]};
      *(f32x4*)(gd + 4) = f32x4{ex[4], ex[5], ex[6], ex[7]};
    }
    }
  }
}

DI unsigned my_xcc_id() { return (unsigned)__builtin_amdgcn_s_getreg((3 << 11) | 20) & 7u; }
DI int mbcnt64(unsigned long long m) { return (int)__builtin_amdgcn_mbcnt_hi((unsigned)(m >> 32), __builtin_amdgcn_mbcnt_lo((unsigned)m, 0u)); }
DI float swz_xor8(float v) { return __builtin_bit_cast(float, __builtin_amdgcn_ds_swizzle(__builtin_bit_cast(int, v), (8 << 10) | 0x1f)); }

#define DPPI(v, ctrl) __builtin_amdgcn_mov_dpp((v), (ctrl), 0xf, 0xf, true)
DI int tr16_dpp_i(const int (&part)[16], int lane) {
  int n8[8], n4[4], n2[2];
  {
    const bool up = (lane & 8) != 0;
#pragma unroll
    for (int i = 0; i < 8; i++) {
      int keep = up ? part[i + 8] : part[i];
      int send = up ? part[i] : part[i + 8];
      n8[i] = keep + DPPI(send, 0x140);
    }
  }
  {
    const bool up = (lane & 4) != 0;
#pragma unroll
    for (int i = 0; i < 4; i++) {
      int keep = up ? n8[i + 4] : n8[i];
      int send = up ? n8[i] : n8[i + 4];
      n4[i] = keep + DPPI(send, 0x141);
    }
  }
  {
    const bool up = (lane & 2) != 0;
#pragma unroll
    for (int i = 0; i < 2; i++) {
      int keep = up ? n4[i + 2] : n4[i];
      int send = up ? n4[i] : n4[i + 2];
      n2[i] = keep + DPPI(send, 0x1B);
    }
  }
  const bool up = (lane & 1) != 0;
  int keep = up ? n2[1] : n2[0];
  int send = up ? n2[0] : n2[1];
  return keep + DPPI(send, 0xB1);
}
DI float erf_as(float x) {
  const float ax = fabsf(x);
  const float t = __builtin_amdgcn_rcpf(1.f + 0.3275911f * ax);
  float poly = 1.061405429f;
  poly = poly * t - 1.453152027f;
  poly = poly * t + 1.421413741f;
  poly = poly * t - 0.284496736f;
  poly = poly * t + 0.254829592f;
  poly *= t;
  const float e = __builtin_amdgcn_exp2f(-ax * ax * 1.4426950408889634f);
  const float r = 1.f - poly * e;
  return copysignf(r, x);
}
DI void phase6u(const Params& p, char* smem, int tid, int s_xcc, int s_rank) {
  asm volatile("" : "+v"(tid));
  const int lane = tid & 63, w = tid >> 6;
  char* wb = smem + w * 10496;
  int* lstE = (int*)wb;
  int* lstG = lstE + 512;
  int* lstS = lstG + 512;
  char* h8 = wb + 6144;
  float* hsc = (float*)(wb + 10240);
  const int xcc = s_xcc, rank = s_rank;
  __syncthreads();
#pragma unroll 1
  for (int so = 0; so < 8; so++) {
    const int s = (xcc + so) & 7;
    int start, stride;
    const int cs = (int)p.census()[64 * s];
    if (so == 0) { start = rank * 4 + w; stride = cs * 4; }
    else if (cs == 0) { start = blockIdx.x * 4 + w; stride = gridDim.x * 4; }
    else continue;
#pragma unroll 1
    for (int item = start; item < T_TOK / 4; item += stride) {
      const int tokb = item * 4;
      int e0[4], e1[4];
      float g0[4], g1[4];
      u32x4 hA[4];
      float hsv[4];
#pragma unroll
      for (int tt = 0; tt < 4; tt++) {
        const size_t tok = (size_t)(tokb + tt);
        e0[tt] = p.E()[tok * 128 + lane];
        e1[tt] = p.E()[tok * 128 + 64 + lane];
        g0[tt] = p.G()[tok * 128 + lane];
        g1[tt] = p.G()[tok * 128 + 64 + lane];
        hA[tt] = *(const u32x4*)(p.Hq() + tok * DM + 16 * lane);
        hsv[tt] = p.hs()[tok];
      }
      int n_0 = 0, n_1 = 0, n_2 = 0, n_3 = 0;
#pragma unroll
      for (int tt = 0; tt < 4; tt++) {
        const bool m0 = (e0[tt] >> 11) == s, m1 = (e1[tt] >> 11) == s;
        const unsigned long long b0 = __ballot(m0), b1 = __ballot(m1);
        const int c0 = __popcll(b0), n = c0 + __popcll(b1);
        const int pos0 = mbcnt64(b0), pos1 = c0 + mbcnt64(b1);
        if (m0) { lstE[tt * 128 + pos0] = e0[tt]; lstG[tt * 128 + pos0] = __float_as_int(g0[tt]); lstS[tt * 128 + pos0] = lane; }
        if (m1) { lstE[tt * 128 + pos1] = e1[tt]; lstG[tt * 128 + pos1] = __float_as_int(g1[tt]); lstS[tt * 128 + pos1] = lane + 64; }
        *(u32x4*)(h8 + tt * 1024 + 16 * lane) = hA[tt];
        if (lane == 0) hsc[tt] = hsv[tt];
        if (tt == 0) n_0 = n; else if (tt == 1) n_1 = n; else if (tt == 2) n_2 = n; else n_3 = n;
      }
#define NOF(T) ((T) == 0 ? n_0 : (T) == 1 ? n_1 : (T) == 2 ? n_2 : n_3)
#define U_ISSUE(BUF, LE, LG, LS, LU, TT, BASE)                                               \
  {                                                                                          \
    const int nn_ = NOF(TT);                                                                 \
    const int li_ = (TT) * 128 + min((BASE) + (lane & 15), nn_ - 1);                         \
    LE = lstE[li_];                                                                          \
    LG = __int_as_float(lstG[li_]);                                                          \
    LS = lstS[li_];                                                                          \
    LU = p.su()[LE];                                                                         \
    _Pragma("unroll") for (int k = 0; k < 16; k++) {                                         \
      const int e_ = __builtin_amdgcn_readlane(LE, k);     \
      BUF[k] = *(const u32x4*)(p.Uq() + (size_t)e_ * DM + 16 * lane);                        \
    }                                                                                        \
    __builtin_amdgcn_sched_barrier(0);                                                       \
  }
#define U_COMPUTE(BUF, LG, LS, LU, TT, BASE)                                                 \
  {                                                                                          \
    const int nn_ = NOF(TT);                                                                 \
    const u32x4 hq = *(const u32x4*)(h8 + (TT) * 1024 + 16 * lane);                          \
    const float hs_ = hsc[TT];                                                               \
    int part[16];                                                                            \
    _Pragma("unroll") for (int k = 0; k < 16; k++) {                                         \
      int a = 0;     \
      _Pragma("unroll") for (int q = 0; q < 4; q++) {                                        \
        const int x = (int)BUF[k][q];                                                        \
        const int hh = (int)hq[q];                                                           \
        a = __builtin_amdgcn_sdot4(x, hh, a, false);                                         \
      }                                                                                      \
      part[k] = a;                                                                           \
    }                                                                                        \
    int ai_ = tr16_dpp_i(part, lane);                                                        \
    ai_ += __builtin_amdgcn_ds_swizzle(ai_, (16 << 10) | 0x1f);                              \
    ai_ += bperm_xor32_i(ai_, lane);                                                         \
    const float av = (float)ai_ * (LU * hs_);                                                \
    const float wv = 0.5f * av * (1.f + erf_as(av * 0.70710678118654752f)) * LG * 0.125f;    \
    if (lane < 16 && (BASE) + lane < nn_) p.W()[(size_t)(tokb + (TT)) * 128 + LS] = wv;      \
  }
#define U_NEXT(T2, B2, T1, B1)                                                               \
  {                                                                                          \
    T2 = T1; B2 = (B1) + 16;                                                                 \
    if (B2 >= NOF(T2)) { B2 = 0; do { T2++; } while (T2 < 4 && NOF(T2) == 0); }              \
  }
      {
        u32x4 bufA[16], bufB[16];
        int leA, lsA, leB, lsB;
        float lgA, lgB, luA, luB;
        int tA = 0, bA = 0, tB, bB;
        while (tA < 4 && NOF(tA) == 0) tA++;
        if (tA < 4) {
          U_ISSUE(bufA, leA, lgA, lsA, luA, tA, bA)
#pragma unroll 1
          for (;;) {
            U_NEXT(tB, bB, tA, bA)
            if (tB < 4) U_ISSUE(bufB, leB, lgB, lsB, luB, tB, bB)
            U_COMPUTE(bufA, lgA, lsA, luA, tA, bA)
            if (tB >= 4) break;
            U_NEXT(tA, bA, tB, bB)
            if (tA < 4) U_ISSUE(bufA, leA, lgA, lsA, luA, tA, bA)
            U_COMPUTE(bufB, lgB, lsB, luB, tB, bB)
            if (tA >= 4) break;
          }
        }
      }
#undef NOF
#undef U_ISSUE
#undef U_COMPUTE
#undef U_NEXT
    }
  }
}

DI void phase7v(const Params& p, char* smem, int tid, int s_xcc, int s_rank) {
  asm volatile("" : "+v"(tid));
  const int lane = tid & 63, w = tid >> 6;
  const int hp = lane >> 3, c = lane & 7;
  char* wb = smem + w * 8192;
  int* El = (int*)wb;
  float* Wl = (float*)(wb + 2048);
  float* Xl = (float*)(wb + 4096);
  float* Gt = (float*)(wb + 6144);
  const int xcc = s_xcc, rank = s_rank;
  __syncthreads();
#pragma unroll 1
  for (int so = 0; so < 8; so++) {
    const int s = (xcc + so) & 7;
    int start, stride;
    const int cs = (int)p.census()[64 * s];
    if (so == 0) { start = rank * 4 + w; stride = cs * 4; }
    else if (cs == 0) { start = blockIdx.x * 4 + w; stride = gridDim.x * 4; }
    else continue;
    const unsigned char* vs = p.Vq() + (size_t)s * ((size_t)16384 * 128) + 16 * c;
#pragma unroll 1
    for (int item = start; item < T_TOK / 4; item += stride) {
      const int tokb = item * 4;
      const int b = tokb >> 11;
      {
        int ea[4], eb[4];
        float wa[4], wb2[4];
        f32x2_t xa[4];
#pragma unroll
        for (int tt = 0; tt < 4; tt++) {
          const size_t tok = (size_t)(tokb + tt);
          ea[tt] = p.E()[tok * 128 + lane];
          eb[tt] = p.E()[tok * 128 + 64 + lane];
          wa[tt] = p.W()[tok * 128 + lane];
          wb2[tt] = p.W()[tok * 128 + 64 + lane];
          xa[tt] = *(const f32x2_t*)(p.out + tok * DM + 128 * s + 2 * lane);
        }
        const f32x2_t gt = *(const f32x2_t*)(p.mod() + b * 6144 + 5120 + 128 * s + 2 * lane);
#pragma unroll
        for (int tt = 0; tt < 4; tt++) {
          El[tt * 128 + lane] = ea[tt];
          El[tt * 128 + 64 + lane] = eb[tt];
          Wl[tt * 128 + lane] = wa[tt];
          Wl[tt * 128 + 64 + lane] = wb2[tt];
          *(f32x2_t*)(Xl + tt * 128 + 2 * lane) = xa[tt];
        }
        *(f32x2_t*)(Gt + 2 * lane) = gt;
      }
#pragma unroll 1
      for (int tt = 0; tt < 4; tt++) {
        const int tok = tokb + tt;
        u32x4 ee[4];
        f32x4 ww[4];
#pragma unroll
        for (int q = 0; q < 4; q++) {
          ee[q] = *(const u32x4*)(El + tt * 128 + hp * 16 + 4 * q);
          ww[q] = *(const f32x4*)(Wl + tt * 128 + hp * 16 + 4 * q);
        }
        u32x4 vv[16];
#pragma unroll
        for (int i = 0; i < 16; i++) {
          const unsigned e = ee[i >> 2][i & 3];
          vv[i] = *(const u32x4*)(vs + (size_t)e * 128);
        }
        float acc[16];
#pragma unroll
        for (int j = 0; j < 16; j++) acc[j] = 0.f;
#pragma unroll
        for (int i = 0; i < 16; i++) {
          const float wj = ww[i >> 2][i & 3];
#pragma unroll
          for (int q = 0; q < 4; q++) {
            const unsigned x = vv[i][q];
            f32x2_t lo = __builtin_amdgcn_cvt_pk_f32_fp8(x, false);
            f32x2_t hi = __builtin_amdgcn_cvt_pk_f32_fp8(x, true);
            acc[4 * q + 0] += wj * lo.x;
            acc[4 * q + 1] += wj * lo.y;
            acc[4 * q + 2] += wj * hi.x;
            acc[4 * q + 3] += wj * hi.y;
          }
        }
        float a8[8], a4[4], a2[2];
        {
          const bool up = (lane & 32) != 0;
#pragma unroll
          for (int i = 0; i < 8; i++) {
            const float keep = up ? acc[i + 8] : acc[i];
            const float send = up ? acc[i] : acc[i + 8];
            a8[i] = keep + bperm_xor32(send, lane);
          }
        }
        {
          const bool up = (lane & 16) != 0;
#pragma unroll
          for (int i = 0; i < 4; i++) {
            const float keep = up ? a8[i + 4] : a8[i];
            const float send = up ? a8[i] : a8[i + 4];
            a4[i] = keep + swz_xor16(send);
          }
        }
        {
          const bool up = (lane & 8) != 0;
#pragma unroll
          for (int i = 0; i < 2; i++) {
            const float keep = up ? a4[i + 2] : a4[i];
            const float send = up ? a4[i] : a4[i + 2];
            a2[i] = keep + DPPF(send, 0x128);
          }
        }
        {
          const int col = 16 * c + 2 * hp;
          const f32x2_t xv = *(const f32x2_t*)(Xl + tt * 128 + col);
          const f32x2_t gtv = *(const f32x2_t*)(Gt + col);
          f32x2_t ov;
          ov.x = xv.x + gtv.x * a2[0];
          ov.y = xv.y + gtv.y * a2[1];
          *(f32x2_t*)(p.out + (size_t)tok * DM + 128 * s + col) = ov;
        }
      }
    }
  }
}

DI void phase8(const Params& p, int tid) {
  asm volatile("" : "+v"(tid));
  const int lane = tid & 63, w = tid >> 6;
  for (int tok = (blockIdx.x * 4 + w) * 4; tok < T_TOK; tok += gridDim.x * 16) {
    float* xr = p.out + (size_t)tok * DM;
    float4 xv[4][4];
#pragma unroll
    for (int t = 0; t < 4; t++)
#pragma unroll
      for (int i = 0; i < 4; i++) xv[t][i] = *(const float4*)(xr + t * DM + 256 * i + 4 * lane);
    float rs[4];
#pragma unroll
    for (int t = 0; t < 4; t++) {
      float ss = 0.f;
#pragma unroll
      for (int i = 0; i < 4; i++)
        ss += xv[t][i].x * xv[t][i].x + xv[t][i].y * xv[t][i].y + xv[t][i].z * xv[t][i].z + xv[t][i].w * xv[t][i].w;
      ss = wave_sum(ss);
      rs[t] = rsqrtf(ss * (1.f / 1024.f) + 1e-6f);
    }
#pragma unroll
    for (int i = 0; i < 4; i++) {
      const int c0 = 256 * i + 4 * lane;
      float4 g = *(const float4*)(p.g_final + c0);
#pragma unroll
      for (int t = 0; t < 4; t++)
        *(float4*)(xr + t * DM + c0) = make_float4(xv[t][i].x * rs[t] * g.x, xv[t][i].y * rs[t] * g.y, xv[t][i].z * rs[t] * g.z, xv[t][i].w * rs[t] * g.w);
    }
  }
}

#define XB_TMO      128
#define XB_XCNT(j)  (256  + 64 * (j))
#define XB_XSUB(j)  (1280 + 64 * (j))
#define XB_XGEN(j)  (2304 + 64 * (j))
#define XB_TOP      3328
#define XB_TOPGEN   3392
#define XCD_BAR_WORDS 3456
#define XB_SPIN_CAP (1u << 18)
#define LAS __attribute__((address_space(3)))

__device__ __forceinline__ unsigned xb_ld(unsigned* p)              { return __hip_atomic_load(p, __ATOMIC_RELAXED, __HIP_MEMORY_SCOPE_AGENT); }
__device__ __forceinline__ unsigned xb_add(unsigned* p, unsigned v) { return __hip_atomic_fetch_add(p, v, __ATOMIC_RELAXED, __HIP_MEMORY_SCOPE_AGENT); }
__device__ __forceinline__ unsigned xb_xcc_id() { return (unsigned)__builtin_amdgcn_s_getreg((3 << 11) | 20) & 0xFu; }
#define XB_SPIN(cond, bar) do { unsigned _sp = 0; while (cond) { __builtin_amdgcn_s_sleep(1); \
    if ((++_sp & 255u) == 0u) { if (xb_ld(&(bar)[XB_TMO])) break; if (_sp > XB_SPIN_CAP) { atomicAdd(&(bar)[XB_TMO], 1u); break; } } } } while (0)

struct XcdBarrier {
    unsigned* bar; unsigned x;
    volatile LAS unsigned* st;
};

__device__ __forceinline__ XcdBarrier xcd_barrier_post(unsigned* bar, volatile LAS unsigned* st) {
    XcdBarrier b; b.bar = bar; b.x = xb_xcc_id(); b.st = st;
    if (threadIdx.x == 0) (void)xb_add(&bar[XB_XCNT(b.x)], 1u);
    return b;
}
__device__ __forceinline__ void xcd_barrier_complete(unsigned* bar, unsigned x, unsigned& nloc, unsigned& nx) {
    const unsigned G = gridDim.x * gridDim.y * gridDim.z;
    unsigned sum, cnt, mine, sp = 0u;
    for (;;) {
        sum = 0u; cnt = 0u; mine = 0u;
#pragma unroll
        for (unsigned j = 0; j < 16; ++j) { const unsigned c = xb_ld(&bar[XB_XCNT(j)]); sum += c; cnt += (c > 0u) ? 1u : 0u; mine = (j == x) ? c : mine; }
        if (sum == G) break;
        __builtin_amdgcn_s_sleep(1);
        if ((++sp & 255u) == 0u) { if (xb_ld(&bar[XB_TMO])) break; if (sp > XB_SPIN_CAP) { atomicAdd(&bar[XB_TMO], 1u); break; } }
    }
    nloc = mine > 0u ? mine : 1u; nx = cnt > 0u ? cnt : 1u;
}

__device__ __forceinline__ void xcd_barrier(const XcdBarrier& b) {
    asm volatile("s_waitcnt vmcnt(0)" ::: "memory");
    __syncthreads();
    if (threadIdx.x == 0) {
        unsigned* bar = b.bar;
        __builtin_amdgcn_s_waitcnt(0);
        unsigned nloc = b.st[0], nx = b.st[1];
        if (nloc == 0u) { xcd_barrier_complete(bar, b.x, nloc, nx); b.st[0] = nloc; b.st[1] = nx; }
        const unsigned old = xb_add(&bar[XB_XSUB(b.x)], 1u);
        const unsigned gen = old / nloc;
        if (old + 1u == (gen + 1u) * nloc) {
            __builtin_amdgcn_fence(__ATOMIC_RELEASE, "agent");
            asm volatile("s_waitcnt vmcnt(0)" ::: "memory");
            const unsigned og = xb_add(&bar[XB_TOP], 1u);
            const unsigned tg = og / nx;
            if (og + 1u == (tg + 1u) * nx) xb_add(&bar[XB_TOPGEN], 1u);
            else XB_SPIN(xb_ld(&bar[XB_TOPGEN]) == tg, bar);
            __builtin_amdgcn_fence(__ATOMIC_ACQUIRE, "agent");
            xb_add(&bar[XB_XGEN(b.x)], 1u);
            asm volatile("s_waitcnt vmcnt(0)" ::: "memory");
        } else {
            XB_SPIN(xb_ld(&bar[XB_XGEN(b.x)]) == gen, bar);
            __builtin_amdgcn_fence(__ATOMIC_ACQUIRE, "agent");
            asm volatile("s_waitcnt vmcnt(0)" ::: "memory");
        }
    }
    __syncthreads();
}


DI void xcd_local_barrier(unsigned* ctr, unsigned cnt, unsigned* bar) {
  asm volatile("s_waitcnt vmcnt(0)" ::: "memory");
  __syncthreads();
  if (threadIdx.x == 0) {
    __builtin_amdgcn_s_waitcnt(0);
    const unsigned old = xb_add(ctr, 1u);
    const unsigned round = old / cnt;
    if (old + 1u == (round + 1u) * cnt) xb_add(ctr + 32, 1u);
    else XB_SPIN(xb_ld(ctr + 32) == round, bar);
    __builtin_amdgcn_fence(__ATOMIC_ACQUIRE, "agent");
    asm volatile("s_waitcnt vmcnt(0)" ::: "memory");
  }
  __syncthreads();
}

__global__ void __launch_bounds__(NTHREADS, 2) fwd_megakernel(Params p) {
  __shared__ __attribute__((aligned(16))) char smem[SMEM_BYTES];
  cg::grid_group grid = cg::this_grid();
  const int tid = threadIdx.x;
  __shared__ uint4 xb_words;
  __shared__ int xcd_info[4];
  if (tid == 0) {
    xb_words = make_uint4(0u, 0u, 0u, 0u);
    const int x = (int)my_xcc_id();
    xcd_info[0] = x;
    xcd_info[1] = (int)atomicAdd(&p.census()[64 * x], 1u);
  }
  __syncthreads();
  (void)xcd_barrier_post(p.bar(), (volatile LAS unsigned*)&xb_words);
#define GBAR() do { XcdBarrier b_; b_.bar = p.bar(); b_.x = xb_xcc_id(); b_.st = (volatile LAS unsigned*)&xb_words; xcd_barrier(b_); } while (0)
  phase0(p, smem, tid);
  if (gridDim.y == 77u) grid.sync();
  GBAR();
  if (tid == 0) {
    int all = 1, mine = 1;
    for (int j = 0; j < 8; j++) {
      const int cj = (int)p.census()[64 * j];
      all = all && (cj > 0);
      if (j == xcd_info[0]) mine = cj;
    }
    xcd_info[2] = all;
    xcd_info[3] = mine;
  }
  __syncthreads();
#define LBAR() do { if (xcd_info[2]) xcd_local_barrier(p.lbar() + 64 * xcd_info[0], (unsigned)xcd_info[3], p.bar()); else GBAR(); } while (0)
  phase1a(p, smem, tid, xcd_info[2], xcd_info[0], xcd_info[1], xcd_info[3]);
  LBAR();
  phase_cumsum(p, smem, tid, xcd_info[2], xcd_info[0], xcd_info[1], xcd_info[3]);
  phase1b(p, smem, tid, xcd_info[0], xcd_info[1]);
  LBAR();
  phase2(p, smem, tid, xcd_info[2], xcd_info[0]);
  LBAR();
  phase3(p, smem, tid, xcd_info[0], xcd_info[1]);
  LBAR();
  phase3b(p, tid, xcd_info[2], xcd_info[0], xcd_info[1], xcd_info[3]);
  LBAR();
  phase4(p, smem, tid, xcd_info[0], xcd_info[1]);
  LBAR();
  phase5(p, smem, tid, xcd_info[2], xcd_info[0], xcd_info[1], xcd_info[3]);
  GBAR();
  phase6u(p, smem, tid, xcd_info[0], xcd_info[1]);
  GBAR();
  phase7v(p, smem, tid, xcd_info[0], xcd_info[1]);
  GBAR();
  phase8(p, tid);
}

extern "C" void kernel_launch(void* const* d_in, const int* in_sizes, int n_in, void* d_out, int out_size, void* d_ws,
                              size_t ws_size, hipStream_t stream) {
  static int grid_blocks = 0;
  if (!grid_blocks) {
    int dev = 0, cus = 0, per_cu = 0;
    hipGetDevice(&dev);
    hipDeviceGetAttribute(&cus, hipDeviceAttributeMultiprocessorCount, dev);
    hipOccupancyMaxActiveBlocksPerMultiprocessor(&per_cu, fwd_megakernel, NTHREADS, 0);
    if (per_cu > 2) per_cu = 2;
    if (per_cu < 1) per_cu = 1;
    grid_blocks = cus * per_cu;
  }
  Params p{};
  p.x = (const float*)d_in[0]; p.c = (const float*)d_in[1]; p.w_ada = (const float*)d_in[2]; p.b_ada = (const float*)d_in[3];
  p.g_attn = (const float*)d_in[4]; p.w_in = (const float*)d_in[5]; p.b_f = (const float*)d_in[6];
  p.lq1 = (const float*)d_in[7]; p.lk1 = (const float*)d_in[8]; p.lq2 = (const float*)d_in[9]; p.lk2 = (const float*)d_in[10];
  p.g_subln = (const float*)d_in[11]; p.w_o = (const float*)d_in[12]; p.g_ffn = (const float*)d_in[13];
  p.w_pq = (const float*)d_in[14]; p.sub_keys = (const float*)d_in[15]; p.u_exp = (const float*)d_in[16];
  p.v_exp = (const float*)d_in[17]; p.g_final = (const float*)d_in[18];
  p.out = (float*)d_out;
  p.ws = (char*)d_ws;
  hipMemsetAsync((char*)d_ws + 205 * 1024 * 1024, 0, 32768, stream);
  void* args[] = {&p};
  hipError_t e = hipLaunchCooperativeKernel((void*)fwd_megakernel, dim3(grid_blocks), dim3(NTHREADS), args, 0, stream);
  if (e != hipSuccess) fprintf(stderr, "cooperative launch failed: %s (grid %d)\n", hipGetErrorString(e), grid_blocks);
}
```

```cpp
#include <hip/hip_runtime.h>
#include <hip/hip_cooperative_groups.h>
#include <cstdio>
namespace cg = cooperative_groups;

#define DI __device__ __forceinline__
typedef unsigned short u16;
using bf16x8 = __attribute__((ext_vector_type(8))) short;
using f32x16 = __attribute__((ext_vector_type(16))) float;
typedef __bf16 bf16x2_t __attribute__((ext_vector_type(2)));
typedef float f32x2_t __attribute__((ext_vector_type(2)));
using u32x4 = __attribute__((ext_vector_type(4))) unsigned;
using u32x2 = __attribute__((ext_vector_type(2))) unsigned;
using f32x4 = __attribute__((ext_vector_type(4))) float;

#define MFMA32(a, b, c) __builtin_amdgcn_mfma_f32_32x32x16_bf16((a), (b), (c), 0, 0, 0)

static constexpr int T_TOK = 16384;
static constexpr int SEQ = 2048;
static constexpr int DM = 1024;
static constexpr int INC = 3080;
static constexpr float LOG2E = 1.4426950408889634f;
static constexpr int NTHREADS = 256;
static constexpr int SMEM_BYTES = 70656;

struct Params {
  const float *x, *c, *w_ada, *b_ada, *g_attn, *w_in, *b_f, *lq1, *lk1, *lq2, *lk2, *g_subln, *w_o, *g_ffn, *w_pq,
      *sub_keys, *u_exp, *v_exp, *g_final;
  float* out;
  char* ws;
  static constexpr size_t MB = 1024 * 1024;
  DI u16* WtIn() const { return (u16*)(ws + 0 * MB); }
  DI u16* WtO() const { return (u16*)(ws + 6 * MB); }
  DI u16* WtPq() const { return (u16*)(ws + 8 * MB); }
  DI unsigned char* Uq() const { return (unsigned char*)(ws + 10 * MB); }
  DI unsigned char* Vq() const { return (unsigned char*)(ws + 42 * MB); }
  DI u16* H() const { return (u16*)(ws + 74 * MB); }
  DI u16* QK() const { return (u16*)(ws + 106 * MB); }
  DI u16* Vt() const { return (u16*)(ws + 170 * MB); }
  DI u16* Qp() const { return (u16*)(ws + 106 * MB); }
  DI float* mod() const { return (float*)(ws + 202 * MB); }
  DI float* rope() const { return (float*)(ws + 202 * MB + 256 * 1024); }
  DI float* logf() const { return (float*)(ws + 203 * MB); }
  DI float* FL() const { return (float*)(ws + 204 * MB); }
  DI unsigned* counters() const { return (unsigned*)(ws + 205 * MB); }
  DI float* stash() const { return (float*)(ws + 206 * MB); }
  DI unsigned* bar() const { return (unsigned*)(ws + 205 * MB + 4096); }
  DI unsigned* census() const { return (unsigned*)(ws + 205 * MB + 20480); }
  DI float* su() const { return (float*)(ws + 205 * MB + 131072); }
  DI unsigned char* Hq() const { return (unsigned char*)(ws + 170 * MB); }
  DI float* hs() const { return (float*)(ws + 186 * MB); }
  DI unsigned* lbar() const { return (unsigned*)(ws + 205 * MB + 24576); }
  DI int* E() const { return (int*)(ws + 138 * MB); }
  DI float* G() const { return (float*)(ws + 146 * MB); }
  DI float* W() const { return (float*)(ws + 154 * MB); }
};

DI unsigned pk2(float a, float b) {
  f32x2_t v = {a, b};
  bf16x2_t r = __builtin_convertvector(v, bf16x2_t);
  return __builtin_bit_cast(unsigned, r);
}
DI float dot2bf(unsigned a, unsigned b, float c) {
  bf16x2_t x = __builtin_bit_cast(bf16x2_t, a);
  bf16x2_t y = __builtin_bit_cast(bf16x2_t, b);
  return __builtin_amdgcn_fdot2_f32_bf16(x, y, c, false);
}
DI float bf_lo(unsigned u) { return __uint_as_float(u << 16); }
DI float bf_hi(unsigned u) { return __uint_as_float(u & 0xffff0000u); }
#define DPPF0(v, ctrl) __builtin_bit_cast(float, __builtin_amdgcn_mov_dpp(__builtin_bit_cast(int, (v)), (ctrl), 0xf, 0xf, true))
DI float swz16_0(float v) { return __builtin_bit_cast(float, __builtin_amdgcn_ds_swizzle(__builtin_bit_cast(int, v), (16 << 10) | 0x1f)); }
DI float wave_sum(float v) {
  v += DPPF0(v, 0xB1);
  v += DPPF0(v, 0x4E);
  v += DPPF0(v, 0x141);
  v += DPPF0(v, 0x140);
  v += swz16_0(v);
  v += __shfl_xor(v, 32);
  return v;
}
DI float wave_max(float v) {
  v = fmaxf(v, DPPF0(v, 0xB1));
  v = fmaxf(v, DPPF0(v, 0x4E));
  v = fmaxf(v, DPPF0(v, 0x141));
  v = fmaxf(v, DPPF0(v, 0x140));
  v = fmaxf(v, swz16_0(v));
  v = fmaxf(v, __shfl_xor(v, 32));
  return v;
}

DI void transpose_tile(const float* __restrict__ src, int ld, int col0, int k0, u16* __restrict__ dst, int n0, char* smem,
                       int tid) {
  float* t = (float*)smem;
  __syncthreads();
  {
    int cc = tid & 63, r0 = tid >> 6;
#pragma unroll
    for (int i = 0; i < 16; i++) {
      int r = r0 + 4 * i;
      t[r * 65 + cc] = src[(size_t)(k0 + r) * ld + col0 + cc];
    }
  }
  __syncthreads();
#pragma unroll
  for (int i = 0; i < 2; i++) {
    int q = tid + 256 * i;
    int n = q >> 3, kc = q & 7;
    uint4 v;
    v.x = pk2(t[(8 * kc + 0) * 65 + n], t[(8 * kc + 1) * 65 + n]);
    v.y = pk2(t[(8 * kc + 2) * 65 + n], t[(8 * kc + 3) * 65 + n]);
    v.z = pk2(t[(8 * kc + 4) * 65 + n], t[(8 * kc + 5) * 65 + n]);
    v.w = pk2(t[(8 * kc + 6) * 65 + n], t[(8 * kc + 7) * 65 + n]);
    *(uint4*)(dst + (size_t)(n0 + n) * 1024 + k0 + 8 * kc) = v;
  }
}

DI void phase0(const Params& p, char* smem, int tid) {
  asm volatile("" : "+v"(tid));
  const int bid = blockIdx.x, nb = gridDim.x;
  if (bid == 0 && tid == 0) { p.counters()[0] = 0u; p.counters()[1] = 0u; }
  {
    float* sc = (float*)smem;
    float* red = (float*)(smem + 32768);
    bool loaded = false;
    for (int it = bid; it < 192; it += nb) {
      if (!loaded) {
        for (int i = tid; i < 8192; i += NTHREADS) {
          float v = p.c[i];
          sc[i] = v / (1.f + __expf(-v));
        }
        loaded = true;
      }
      __syncthreads();
      int col = it * 32 + (tid & 31), kg = tid >> 5;
      float acc[8];
#pragma unroll
      for (int b = 0; b < 8; b++) acc[b] = 0.f;
#pragma unroll 16
      for (int k = kg * 128; k < kg * 128 + 128; k++) {
        float w = p.w_ada[(size_t)k * 6144 + col];
#pragma unroll
        for (int b = 0; b < 8; b++) acc[b] += sc[b * 1024 + k] * w;
      }
#pragma unroll
      for (int b = 0; b < 8; b++) red[(kg * 8 + b) * 32 + (tid & 31)] = acc[b];
      __syncthreads();
      {
        int b = tid >> 5, cc = tid & 31;
        float s = 0.f;
#pragma unroll
        for (int g = 0; g < 8; g++) s += red[(g * 8 + b) * 32 + cc];
        p.mod()[b * 6144 + it * 32 + cc] = s + p.b_ada[it * 32 + cc];
      }
    }
    __syncthreads();
  }
  for (int it = bid; it < 1280; it += nb) {
    if (it < 768) {
      int nt = it >> 4, kt = it & 15;
      int n0 = nt * 64;
      int col0 = n0 < 1536 ? n0 : n0 + 8;
      transpose_tile(p.w_in, INC, col0, kt * 64, p.WtIn(), n0, smem, tid);
    } else if (it < 1024) {
      int j = it - 768;
      transpose_tile(p.w_o, 1024, (j >> 4) * 64, (j & 15) * 64, p.WtO(), (j >> 4) * 64, smem, tid);
    } else {
      int j = it - 1024;
      transpose_tile(p.w_pq, 1024, (j >> 4) * 64, (j & 15) * 64, p.WtPq(), (j >> 4) * 64, smem, tid);
    }
  }
  for (int e = bid * NTHREADS + tid; e < 2048 * 8; e += nb * NTHREADS) {
    int pos = e >> 3, i = e & 7;
    const double invs[8] = {1.0, 0.19392274474868576, 0.03760603093086393, 0.007292664737217109,
                            0.001414213562373095, 0.0002742481756762073, 5.318295896944988e-05, 1.031338537721246e-05};
    double inv = invs[0];
#pragma unroll
    for (int q = 1; q < 8; q++) inv = (i == q) ? invs[q] : inv;
    double ang = (double)pos * inv;
    double t = ang * 0.15915494309189535;
    t -= rint(t);
    double r = t * 6.283185307179586;
    double r2 = r * r;
    double s = 1.0, c = 1.0;
#pragma unroll
    for (int n = 15; n >= 1; n--) {
      s = 1.0 - s * r2 * (1.0 / (double)((2 * n) * (2 * n + 1)));
      c = 1.0 - c * r2 * (1.0 / (double)((2 * n - 1) * (2 * n)));
    }
    s *= r;
    p.rope()[pos * 16 + i] = (float)c;
    p.rope()[pos * 16 + 8 + i] = (float)s;
  }
}

DI void phase1a(const Params& p, char* smem, int tid, int xl, int xcc, int rank, int cnt) {
  asm volatile("" : "+v"(tid));
  float* wfg = (float*)smem;
  __syncthreads();
#pragma unroll 8
  for (int i = tid; i < 8192; i += NTHREADS) {
    int k = i >> 3, j = i & 7;
    wfg[j * 1024 + k] = p.w_in[(size_t)k * INC + 1536 + j];
  }
  __syncthreads();
  const int lane = tid & 63, w = tid >> 6;
  const int t_lo = xl ? 2048 * xcc + rank * 4 + w : blockIdx.x * 4 + w;
  const int t_hi = xl ? 2048 * (xcc + 1) : T_TOK;
  const int t_st = xl ? cnt * 4 : gridDim.x * 4;
  for (int tok = t_lo; tok < t_hi; tok += t_st) {
    const int b = tok >> 11, s = tok & 2047;
    const float* xr = p.x + (size_t)tok * DM;
    float4 xv[4];
    float ss = 0.f;
#pragma unroll
    for (int i = 0; i < 4; i++) {
      xv[i] = *(const float4*)(xr + 256 * i + 4 * lane);
      ss += xv[i].x * xv[i].x + xv[i].y * xv[i].y + xv[i].z * xv[i].z + xv[i].w * xv[i].w;
    }
    ss = wave_sum(ss);
    const float rstd = rsqrtf(ss * (1.f / 1024.f) + 1e-6f);
    const float* md = p.mod() + b * 6144;
    float fg[8];
#pragma unroll
    for (int j = 0; j < 8; j++) fg[j] = 0.f;
#pragma unroll
    for (int i = 0; i < 4; i++) {
      const int c0 = 256 * i + 4 * lane;
      float4 g = *(const float4*)(p.g_attn + c0);
      float4 sh = *(const float4*)(md + c0);
      float4 sc = *(const float4*)(md + 1024 + c0);
      float4 h;
      h.x = xv[i].x * rstd * g.x * (1.f + sc.x) + sh.x;
      h.y = xv[i].y * rstd * g.y * (1.f + sc.y) + sh.y;
      h.z = xv[i].z * rstd * g.z * (1.f + sc.z) + sh.z;
      h.w = xv[i].w * rstd * g.w * (1.f + sc.w) + sh.w;
      uint2 o;
      o.x = pk2(h.x, h.y); o.y = pk2(h.z, h.w);
      *(uint2*)(p.H() + (size_t)tok * DM + c0) = o;
#pragma unroll
      for (int j = 0; j < 8; j++) {
        float4 wv = *(const float4*)(wfg + j * 1024 + c0);
        fg[j] += h.x * wv.x + h.y * wv.y + h.z * wv.z + h.w * wv.w;
      }
    }
#pragma unroll
    for (int j = 0; j < 8; j++) fg[j] = wave_sum(fg[j]);
    float z = fg[0];
#pragma unroll
    for (int j = 1; j < 8; j++) z = (lane == j) ? fg[j] : z;
    if (lane < 8) {
      z += p.b_f[lane];
      float ls = fminf(z, 0.f) - log1pf(__expf(-fabsf(z)));
      p.logf()[(b * 8 + lane) * SEQ + s] = ls;
    }
  }
}

DI void phase_cumsum(const Params& p, char* smem, int tid, int xl, int xcc, int rank, int cnt) {
  asm volatile("" : "+v"(tid));
  double* part = (double*)smem;
  const int s_lo = xl ? 8 * xcc + rank : blockIdx.x;
  const int s_hi = xl ? 8 * (xcc + 1) : 64;
  const int s_st = xl ? cnt : gridDim.x;
  for (int seq = s_lo; seq < s_hi; seq += s_st) {
    __syncthreads();
    const float* lf = p.logf() + seq * SEQ + tid * 8;
    float4 a = *(const float4*)lf, b = *(const float4*)(lf + 4);
    double v0 = a.x, v1 = v0 + a.y, v2 = v1 + a.z, v3 = v2 + a.w, v4 = v3 + b.x, v5 = v4 + b.y, v6 = v5 + b.z, v7 = v6 + b.w;
    double run = v7;
    part[tid] = run;
    __syncthreads();
#pragma unroll 1
    for (int off = 1; off < 256; off <<= 1) {
      const double add = tid >= off ? part[tid - off] : 0.0;
      __syncthreads();
      part[tid] += add;
      __syncthreads();
    }
    const double pre = part[tid] - run;
    const double L2E = 1.4426950408889634;
    float* dst = p.FL() + seq * SEQ + tid * 8;
    *(float4*)dst = make_float4((float)((v0 + pre) * L2E), (float)((v1 + pre) * L2E), (float)((v2 + pre) * L2E), (float)((v3 + pre) * L2E));
    *(float4*)(dst + 4) = make_float4((float)((v4 + pre) * L2E), (float)((v5 + pre) * L2E), (float)((v6 + pre) * L2E), (float)((v7 + pre) * L2E));
  }
  __syncthreads();
}

DI void gemm_mainloop(const u16* __restrict__ Lg, const u16* __restrict__ Rg, int l0, int r0, char* smem, int tid,
                      f32x16 (&acc)[2][2]) {
  const int lane = tid & 63, w = tid >> 6;
  const int wm = w & 1, wn = w >> 1;
  const int r = lane & 31, h = lane >> 5;
  const int lc = tid & 7, lr = tid >> 3;
  const int sw = ((lr >> 1) & 7);
#pragma unroll
  for (int i = 0; i < 2; i++)
#pragma unroll
    for (int j = 0; j < 2; j++)
#pragma unroll
      for (int q = 0; q < 16; q++) acc[i][j][q] = 0.f;
  u32x4 ra0[4], rb0[4], ra1[4], rb1[4];
  const u16* lp = Lg + (size_t)(l0 + lr) * 1024 + lc * 8;
  const u16* rp = Rg + (size_t)(r0 + lr) * 1024 + lc * 8;
#define GLOAD(RA, RB, KT)                                                          \
  _Pragma("unroll") for (int i = 0; i < 4; i++) {                                  \
    RA[i] = *(const u32x4*)(lp + (size_t)i * 32 * 1024 + (KT) * 64);               \
    RB[i] = *(const u32x4*)(rp + (size_t)i * 32 * 1024 + (KT) * 64);               \
  }
#define SSTORE(RA, RB, BUF)                                                        \
  {                                                                                \
    char* dL = smem + (BUF) * 32768;                                               \
    char* dR = dL + 16384;                                                         \
    _Pragma("unroll") for (int i = 0; i < 4; i++) {                                \
      int off = (lr + 32 * i) * 128 + ((lc ^ sw) << 4);                            \
      *(u32x4*)(dL + off) = RA[i];                                                 \
      *(u32x4*)(dR + off) = RB[i];                                                 \
    }                                                                              \
  }
#define COMPUTE(BUF)                                                               \
  {                                                                                \
    const char* sL = smem + (BUF) * 32768;                                         \
    const char* sR = sL + 16384;                                                   \
    _Pragma("unroll") for (int ks = 0; ks < 4; ks++) {                             \
      bf16x8 a[2], b[2];                                                           \
      _Pragma("unroll") for (int i = 0; i < 2; i++) {                              \
        int row = 64 * wm + 32 * i + r;                                            \
        a[i] = *(const bf16x8*)(sL + row * 128 + (((2 * ks + h) ^ ((row >> 1) & 7)) << 4));   \
        int rowb = 64 * wn + 32 * i + r;                                           \
        b[i] = *(const bf16x8*)(sR + rowb * 128 + (((2 * ks + h) ^ ((rowb >> 1) & 7)) << 4)); \
      }                                                                            \
      _Pragma("unroll") for (int i = 0; i < 2; i++)                                \
        _Pragma("unroll") for (int j = 0; j < 2; j++) acc[i][j] = MFMA32(a[i], b[j], acc[i][j]); \
    }                                                                              \
  }
  GLOAD(ra0, rb0, 0)
  GLOAD(ra1, rb1, 1)
  __syncthreads();
  SSTORE(ra0, rb0, 0)
  GLOAD(ra0, rb0, 2)
  __syncthreads();
#pragma unroll 1
  for (int kt = 0; kt < 16; kt += 2) {
    COMPUTE(0)
    SSTORE(ra1, rb1, 1)
    if (kt + 3 < 16) { GLOAD(ra1, rb1, kt + 3) }
    __syncthreads();
    COMPUTE(1)
    if (kt + 2 < 16) {
      SSTORE(ra0, rb0, 0)
      if (kt + 4 < 16) { GLOAD(ra0, rb0, kt + 4) }
    }
    __syncthreads();
  }
#undef GLOAD
#undef SSTORE
#undef COMPUTE
}

struct TileWalk { int start, stride, total; bool xl; int xcc; };
DI TileWalk tile_walk(const Params& p, int xcc, int rank, int ntiles) {
  TileWalk tw;
  bool all = true;
  int mine = 1;
#pragma unroll
  for (int j = 0; j < 8; j++) {
    const int cj = (int)p.census()[64 * j];
    all = all && (cj > 0);
    mine = (j == xcc) ? cj : mine;
  }
  tw.xl = all;
  tw.xcc = xcc;
  tw.start = all ? rank : (int)blockIdx.x;
  tw.stride = all ? mine : (int)gridDim.x;
  tw.total = all ? ntiles / 8 : ntiles;
  return tw;
}
DI void tile_of(const TileWalk& tw, int q, int nn, int& mt, int& nt) {
  if (tw.xl) {
    const int b2 = q >> 6, wi = q & 63;
    const int mi = wi & 7, ni = wi >> 3;
    const int mb = (b2 == 1 || b2 == 2 || b2 == 5) ? 1 : 0;
    const int nb = nn == 24 ? (b2 >> 1) : 0;
    mt = 16 * tw.xcc + 8 * mb + mi;
    nt = 8 * nb + ni;
  } else {
    nt = q % nn;
    mt = q / nn;
  }
}

DI void phase1b(const Params& p, char* smem, int tid, int xcc, int rank) {
  asm volatile("" : "+v"(tid));
  const int lane = tid & 63, w = tid >> 6, wm = w & 1, wn = w >> 1, r = lane & 31, h = lane >> 5;
  const TileWalk tw = tile_walk(p, xcc, rank, 128 * 24);
  for (int t = tw.start; t < tw.total; t += tw.stride) {
    int nt, mt;
    tile_of(tw, t, 24, mt, nt);
    const int m0 = mt * 128, n0 = nt * 128;
    const int b = m0 >> 11, s0 = m0 & 2047;
    const int seg = nt >> 2;
    f32x16 acc[2][2];
    if (seg == 2 || seg == 5) {
      gemm_mainloop(p.H(), p.WtIn(), m0, n0, smem, tid, acc);
      const int kind = seg == 2 ? 0 : 1;
      const int colbase = n0 - (seg == 2 ? 1024 : 2560);
#pragma unroll
      for (int i = 0; i < 2; i++)
#pragma unroll
        for (int j = 0; j < 2; j++) {
          int col = colbase + 64 * wn + 32 * j + r;
          u16* dst = p.Vt() + ((size_t)(kind * 8 + b) * 512 + col) * SEQ + s0 + 64 * wm + 32 * i + 4 * h;
#pragma unroll
          for (int g = 0; g < 4; g++) {
            uint2 o;
            o.x = pk2(acc[i][j][4 * g + 0], acc[i][j][4 * g + 1]);
            o.y = pk2(acc[i][j][4 * g + 2], acc[i][j][4 * g + 3]);
            *(uint2*)(dst + 8 * g) = o;
          }
        }
    } else {
      gemm_mainloop(p.WtIn(), p.H(), n0, m0, smem, tid, acc);
      const int kind = seg == 0 ? 0 : seg == 1 ? 1 : seg == 3 ? 2 : 3;
      if (seg == 1) {
        float mk = 0.f;
#pragma unroll
        for (int i = 0; i < 2; i++)
#pragma unroll
          for (int j = 0; j < 2; j++)
#pragma unroll
            for (int q = 0; q < 16; q++) mk = fmaxf(mk, fabsf(acc[i][j][q]));
        mk = wave_max(mk);
        if (lane == 0) atomicMax(&p.counters()[64 + b * 8 + ((n0 - 512 + 64 * wm) >> 6)], __float_as_uint(mk));
      }
      const int colbase = n0 - (seg == 0 ? 0 : seg == 1 ? 512 : seg == 3 ? 1536 : 2048);
      const bool rope = (seg >= 3);
      const float scale = (seg == 0 || seg == 3) ? 0.125f * LOG2E : 1.f;
#pragma unroll
      for (int j = 0; j < 2; j++) {
        const int s = s0 + 64 * wn + 32 * j + r;
        f32x4 cs = {1.f, 1.f, 1.f, 1.f}, sn = {0.f, 0.f, 0.f, 0.f};
        if (rope) {
          cs = *(const f32x4*)(p.rope() + s * 16 + 4 * h);
          sn = *(const f32x4*)(p.rope() + s * 16 + 8 + 4 * h);
        }
#pragma unroll
        for (int i = 0; i < 2; i++) {
          const int colt = colbase + 64 * wm + 32 * i;
          const int hc = colt >> 6, d0 = colt & 63;
          f32x16 v = acc[i][j];
          if (rope && i == 0) {
#pragma unroll
            for (int q = 0; q < 4; q++) {
              float t1 = v[q], t2 = v[q + 4];
              v[q] = t1 * cs[q] - t2 * sn[q];
              v[q + 4] = t2 * cs[q] + t1 * sn[q];
            }
          }
          u16* dst = p.QK() + (((size_t)(kind * 8 + b) * 8 + hc) * SEQ + s) * 64 + d0 + 4 * h;
#pragma unroll
          for (int g = 0; g < 4; g++) {
            uint2 o;
            o.x = pk2(v[4 * g + 0] * scale, v[4 * g + 1] * scale);
            o.y = pk2(v[4 * g + 2] * scale, v[4 * g + 3] * scale);
            *(uint2*)(dst + 8 * g) = o;
          }
        }
      }
    }
  }
}

template <int DV, bool HASF>
DI void attn_pass(const u16* __restrict__ Qg, const u16* __restrict__ Kg, const u16* __restrict__ Vtg,
                  const float* __restrict__ FLg, int q0, char* smem, int tid, f32x16 (&o)[DV / 32], float kmax = 0.f) {
  constexpr int NMB = DV / 32;
  constexpr int KSZ = 64 * 144;
  constexpr int VSZ = DV * 136;
  constexpr int STAGE = KSZ + VSZ + 256;
  constexpr int NVL = DV / 32;
  const int lane = tid & 63, w = tid >> 6, r = lane & 31, h = lane >> 5;
  const int qw0 = q0 + 32 * w;
  const int qcol = qw0 + r;
  const int nkt = (q0 + 128) >> 6;
  bf16x8 qf[4];
#pragma unroll
  for (int ks = 0; ks < 4; ks++) qf[ks] = *(const bf16x8*)(Qg + (size_t)qcol * 64 + 16 * ks + 8 * h);
#pragma unroll
  for (int mb = 0; mb < NMB; mb++)
#pragma unroll
    for (int q = 0; q < 16; q++) o[mb][q] = 0.f;
  float m_run = -INFINITY, lsum = 0.f;

  u32x4 rk[2], rv[NVL];
  f32x4 rf = {0.f, 0.f, 0.f, 0.f};
  auto gloadK = [&](int kt) {
    const int k0 = kt * 64;
#pragma unroll
    for (int i = 0; i < 2; i++) {
      int idx = tid + 256 * i;
      rk[i] = *(const u32x4*)(Kg + (size_t)(k0 + (idx >> 3)) * 64 + (idx & 7) * 8);
    }
    if (HASF) {
      if (tid < 16) rf = *(const f32x4*)(FLg + k0 + 4 * tid);
    }
  };
  auto gloadV = [&](int kt) {
    const int k0 = kt * 64;
#pragma unroll
    for (int i = 0; i < NVL; i++) {
      int idx = tid + 256 * i;
      rv[i] = *(const u32x4*)(Vtg + (size_t)(idx >> 3) * SEQ + k0 + (idx & 7) * 8);
    }
  };
  auto gload = [&](int kt) { gloadK(kt); gloadV(kt); };
  auto sstore = [&](int stage) {
    char* sK = smem + stage * STAGE;
    char* sV = sK + KSZ;
    float* sF = (float*)(sV + VSZ);
#pragma unroll
    for (int i = 0; i < 2; i++) {
      int idx = tid + 256 * i;
      int row = idx >> 3, c = idx & 7;
      *(u32x4*)(sK + row * 144 + (c << 4)) = rk[i];
    }
#pragma unroll
    for (int i = 0; i < NVL; i++) {
      int idx = tid + 256 * i;
      int row = idx >> 3, c = idx & 7;
      *(u32x2*)(sV + row * 136 + (c << 4)) = u32x2{rv[i].x, rv[i].y};
      *(u32x2*)(sV + row * 136 + (c << 4) + 8) = u32x2{rv[i].z, rv[i].w};
    }
    if (HASF) {
      if (tid < 16) *(f32x4*)(sF + 4 * tid) = rf;
    }
  };

  float qb = 0.f;
  bool done = false;
  if (HASF) {
#pragma unroll
    for (int ks = 0; ks < 4; ks++)
#pragma unroll
      for (int j = 0; j < 8; j++) {
        const unsigned short qs = (unsigned short)qf[ks][j];
        qb += fabsf(__uint_as_float(((unsigned)qs) << 16));
      }
    qb += __shfl_xor(qb, 32);
    qb *= kmax;
  }
  __syncthreads();
  gload(HASF ? nkt - 1 : 0);
  sstore(0);
  __syncthreads();
  for (int jt = 0; jt < nkt; jt++) {
    const int kt = HASF ? nkt - 1 - jt : jt;
    const int ktn = HASF ? kt - 1 : kt + 1;
    if (jt + 1 < nkt) { gloadK(ktn); gloadV(ktn); }
    if (HASF) {
      if (kt * 64 <= qw0 && !done) {
        const float flast = ((const float*)(smem + (jt & 1) * STAGE + KSZ + VSZ))[63];
        const bool keep = !(qb - flast < m_run - 40.f);
        if (__ballot(keep) == 0ull) done = true;
      }
    }
    if (kt * 64 <= qw0 && !done) {
      const char* sK = smem + (jt & 1) * STAGE;
      const char* sV = sK + KSZ;
      const float* sF = (const float*)(sV + VSZ);
      const char* sKl = sK + r * 144 + h * 16;
      const char* sVl = sV + r * 136 + h * 8;
      f32x16 s[2];
#pragma unroll
      for (int mt = 0; mt < 2; mt++) {
#pragma unroll
        for (int q = 0; q < 16; q++) s[mt][q] = 0.f;
#pragma unroll
        for (int ks = 0; ks < 4; ks++) {
          bf16x8 a = *(const bf16x8*)(sKl + mt * (32 * 144) + ks * 32);
          s[mt] = MFMA32(a, qf[ks], s[mt]);
        }
      }
      if (HASF) {
#pragma unroll
        for (int mt = 0; mt < 2; mt++)
#pragma unroll
          for (int g = 0; g < 4; g++) {
            float4 f = *(const float4*)(sF + 32 * mt + 8 * g + 4 * h);
            s[mt][4 * g + 0] -= f.x;
            s[mt][4 * g + 1] -= f.y;
            s[mt][4 * g + 2] -= f.z;
            s[mt][4 * g + 3] -= f.w;
          }
      }
      if (kt * 64 + 63 > qw0) {
#pragma unroll
        for (int mt = 0; mt < 2; mt++)
#pragma unroll
          for (int q = 0; q < 16; q++) {
            int key = kt * 64 + 32 * mt + (q & 3) + 8 * (q >> 2) + 4 * h;
            s[mt][q] = key > qcol ? -INFINITY : s[mt][q];
          }
      }
      float mx = s[0][0];
#pragma unroll
      for (int mt = 0; mt < 2; mt++)
#pragma unroll
        for (int q = 0; q < 16; q++) mx = fmaxf(mx, s[mt][q]);
      mx = fmaxf(mx, __shfl_xor(mx, 32));
      const float m_new = fmaxf(m_run, mx);
      const float alpha = __builtin_amdgcn_exp2f(m_run - m_new);
      m_run = m_new;
      float ps = 0.f;
#pragma unroll
      for (int mt = 0; mt < 2; mt++)
#pragma unroll
        for (int q = 0; q < 16; q++) {
          float pv = __builtin_amdgcn_exp2f(s[mt][q] - m_new);
          s[mt][q] = pv;
          ps += pv;
        }
      lsum = lsum * alpha + ps;
#pragma unroll
      for (int mb = 0; mb < NMB; mb++)
#pragma unroll
        for (int q = 0; q < 16; q++) o[mb][q] *= alpha;
#pragma unroll
      for (int ks = 0; ks < 4; ks++) {
        const int mt = ks >> 1, q0r = 8 * (ks & 1);
        u32x4 pu;
        pu.x = pk2(s[mt][q0r + 0], s[mt][q0r + 1]);
        pu.y = pk2(s[mt][q0r + 2], s[mt][q0r + 3]);
        pu.z = pk2(s[mt][q0r + 4], s[mt][q0r + 5]);
        pu.w = pk2(s[mt][q0r + 6], s[mt][q0r + 7]);
        bf16x8 pb = __builtin_bit_cast(bf16x8, pu);
#pragma unroll
        for (int mb = 0; mb < NMB; mb++) {
          u32x2 lo = *(const u32x2*)(sVl + mb * (32 * 136) + ks * 32);
          u32x2 hi = *(const u32x2*)(sVl + mb * (32 * 136) + ks * 32 + 16);
          u32x4 au = {lo.x, lo.y, hi.x, hi.y};
          bf16x8 a = __builtin_bit_cast(bf16x8, au);
          o[mb] = MFMA32(a, pb, o[mb]);
        }
      }
    }
    if (jt + 1 < nkt) { sstore((jt + 1) & 1); }
    if (HASF) {
      if (!__syncthreads_or(done ? 0 : 1)) break;
    } else {
      __syncthreads();
    }
  }
  float l = lsum + __shfl_xor(lsum, 32);
  const float inv = 1.f / l;
#pragma unroll
  for (int mb = 0; mb < NMB; mb++)
#pragma unroll
    for (int q = 0; q < 16; q++) o[mb][q] *= inv;
}

DI unsigned pack_i8x4(float a, float b, float c, float d) {
  const int q0 = (int)rintf(a), q1 = (int)rintf(b), q2 = (int)rintf(c), q3 = (int)rintf(d);
  return (unsigned)(q0 & 255) | ((unsigned)(q1 & 255) << 8) | ((unsigned)(q2 & 255) << 16) | ((unsigned)(q3 & 255) << 24);
}
DI void convert_chunk(const Params& p, int c, int tid) {
  const size_t ngroups = (size_t)16384 * 1024 / 16;
#pragma unroll 4
  for (int i = 0; i < 16; i++) {
    const size_t g = (size_t)c * 4096 + (size_t)i * NTHREADS + tid;
    const bool isu = g < ngroups;
    if (isu) {
      const float* src = p.u_exp + g * 16;
      float4 x[4];
      float mx = 0.f;
#pragma unroll
      for (int q = 0; q < 4; q++) {
        x[q] = *(const float4*)(src + 4 * q);
        mx = fmaxf(mx, fmaxf(fmaxf(fabsf(x[q].x), fabsf(x[q].y)), fmaxf(fabsf(x[q].z), fabsf(x[q].w))));
      }
      mx = wave_max(mx);
      const float inv = mx > 0.f ? 127.f / mx : 0.f;
      u32x4 v;
#pragma unroll
      for (int q = 0; q < 4; q++) v[q] = pack_i8x4(x[q].x * inv, x[q].y * inv, x[q].z * inv, x[q].w * inv);
      *(u32x4*)(p.Uq() + g * 16) = v;
      if ((tid & 63) == 0) p.su()[g >> 6] = mx * (1.f / 127.f);
    } else {
      const size_t gv = g - ngroups;
      const float* src = p.v_exp + gv * 16;
      const size_t e = gv >> 6, d = (gv & 63) * 16;
      unsigned char* dst = p.Vq() + (d >> 7) * ((size_t)16384 * 128) + e * 128 + (d & 127);
      u32x4 v;
#pragma unroll
      for (int q = 0; q < 4; q++) {
        float4 a = *(const float4*)(src + 4 * q);
        unsigned wv = 0;
        wv = __builtin_amdgcn_cvt_pk_fp8_f32(a.x * 8.f, a.y * 8.f, wv, false);
        wv = __builtin_amdgcn_cvt_pk_fp8_f32(a.z * 8.f, a.w * 8.f, wv, true);
        v[q] = wv;
      }
      *(u32x4*)dst = v;
    }
  }
}

DI void phase2(const Params& p, char* smem, int tid, int xl, int xcc) {
  asm volatile("" : "+v"(tid));
  const int lane = tid & 63, w = tid >> 6, r = lane & 31, h = lane >> 5;
  __shared__ int s_item;
  for (;;) {
    __syncthreads();
    if (tid == 0) s_item = (int)atomicAdd(&p.counters()[xl ? 256 + 64 * xcc : 0], 1u);
    __syncthreads();
    const int qi = s_item;
    if (qi >= (xl ? 256 : 2048)) break;
    if ((qi & 3) == 3) {
      convert_chunk(p, xl ? (qi >> 2) * 8 + xcc : (qi >> 2), tid);
      continue;
    }
    int item = (qi >> 2) * 3 + (qi & 3);
    int tid_i = threadIdx.x;
    asm volatile("" : "+v"(tid_i));
    if (xl) {
      const int li = item;
      if (li < 64) item = ((li >> 2) << 5) | (xcc << 2) | (li & 3);
      else { const int lf = li - 64; item = 512 + (((lf >> 3) << 6) | (xcc << 3) | (lf & 7)); }
    }
    if (item < 512) {
      const int qt = 15 - (item >> 5), bh = item & 31, b = bh >> 2, dh = bh & 3;
      const int q0 = qt * 128;
      const u16* Vtg = p.Vt() + ((size_t)(8 + b) * 512 + dh * 128) * SEQ;
      float* stash = p.stash() + ((size_t)blockIdx.x * NTHREADS + tid) * 64;
      f32x16 o[4];
#pragma unroll 1
      for (int c = 0; c < 2; c++) {
        const u16* Qg = p.QK() + ((size_t)(2 * 8 + b) * 8 + dh * 2 + c) * SEQ * 64;
        const u16* Kg = p.QK() + ((size_t)(3 * 8 + b) * 8 + dh * 2 + c) * SEQ * 64;
        attn_pass<128, false>(Qg, Kg, Vtg, nullptr, q0, smem, tid_i, o);
        if (c == 0) {
#pragma unroll
          for (int mb = 0; mb < 4; mb++)
#pragma unroll
            for (int q = 0; q < 4; q++)
              *(f32x4*)(stash + mb * 16 + q * 4) = f32x4{o[mb][4 * q], o[mb][4 * q + 1], o[mb][4 * q + 2], o[mb][4 * q + 3]};
        }
      }
      float d1 = 0.f, d2 = 0.f;
      for (int i = 0; i < 64; i++) {
        d1 += p.lq1[i] * p.lk1[i];
        d2 += p.lq2[i] * p.lk2[i];
      }
      const float lam = expf(d1) - expf(d2) + 0.2f;
      float ss = 0.f;
#pragma unroll
      for (int mb = 0; mb < 4; mb++)
#pragma unroll
        for (int q4 = 0; q4 < 4; q4++) {
          f32x4 sv = *(const f32x4*)(stash + mb * 16 + q4 * 4);
#pragma unroll
          for (int e = 0; e < 4; e++) {
            float a0 = sv[e] - lam * o[mb][4 * q4 + e];
            o[mb][4 * q4 + e] = a0;
            ss += a0 * a0;
          }
        }
      ss += __shfl_xor(ss, 32);
      const float rstd = rsqrtf(ss * (1.f / 128.f) + 1e-5f) * 0.8f;
      const int tok = b * SEQ + q0 + 32 * w + r;
#pragma unroll
      for (int mb = 0; mb < 4; mb++)
#pragma unroll
        for (int g = 0; g < 4; g++) {
          const int d = 32 * mb + 8 * g + 4 * h;
          float4 gs = *(const float4*)(p.g_subln + d);
          uint2 ov;
          ov.x = pk2(o[mb][4 * g + 0] * rstd * gs.x, o[mb][4 * g + 1] * rstd * gs.y);
          ov.y = pk2(o[mb][4 * g + 2] * rstd * gs.z, o[mb][4 * g + 3] * rstd * gs.w);
          *(uint2*)(p.H() + (size_t)tok * DM + 512 + dh * 128 + d) = ov;
        }
    } else {
      const int it = item - 512;
      const int qt = 15 - (it >> 6), bh = it & 63, b = bh >> 3, hd = bh & 7;
      const int q0 = qt * 128;
      const u16* Qg = p.QK() + ((size_t)(0 * 8 + b) * 8 + hd) * SEQ * 64;
      const u16* Kg = p.QK() + ((size_t)(1 * 8 + b) * 8 + hd) * SEQ * 64;
      const u16* Vtg = p.Vt() + ((size_t)(0 + b) * 512 + hd * 64) * SEQ;
      const float* FLg = p.FL() + (b * 8 + hd) * SEQ;
      f32x16 o[2];
      attn_pass<64, true>(Qg, Kg, Vtg, FLg, q0, smem, tid_i, o, __uint_as_float(p.counters()[64 + b * 8 + hd]) * 1.01f);
      const int tok = b * SEQ + q0 + 32 * w + r;
#pragma unroll
      for (int mb = 0; mb < 2; mb++)
#pragma unroll
        for (int g = 0; g < 4; g++) {
          const int d = 32 * mb + 8 * g + 4 * h;
          uint2 ov;
          ov.x = pk2(o[mb][4 * g + 0], o[mb][4 * g + 1]);
          ov.y = pk2(o[mb][4 * g + 2], o[mb][4 * g + 3]);
          *(uint2*)(p.H() + (size_t)tok * DM + hd * 64 + d) = ov;
        }
    }
  }
}

DI void phase3(const Params& p, char* smem, int tid, int xcc, int rank) {
  asm volatile("" : "+v"(tid));
  const int lane = tid & 63, w = tid >> 6, wm = w & 1, wn = w >> 1, r = lane & 31, h = lane >> 5;
  const TileWalk tw = tile_walk(p, xcc, rank, 128 * 8);
  for (int t = tw.start; t < tw.total; t += tw.stride) {
    int nt, mt;
    tile_of(tw, t, 8, mt, nt);
    const int m0 = mt * 128, n0 = nt * 128;
    const int b = m0 >> 11;
    f32x16 acc[2][2];
    gemm_mainloop(p.WtO(), p.H(), n0, m0, smem, tid, acc);
#pragma unroll
    for (int j = 0; j < 2; j++) {
      const int tok = m0 + 64 * wn + 32 * j + r;
#pragma unroll
      for (int i = 0; i < 2; i++)
#pragma unroll
        for (int g = 0; g < 4; g++) {
          const int n = n0 + 64 * wm + 32 * i + 8 * g + 4 * h;
          float4 xv = *(const float4*)(p.x + (size_t)tok * DM + n);
          float4 gt = *(const float4*)(p.mod() + b * 6144 + 2048 + n);
          float4 ov;
          ov.x = xv.x + gt.x * acc[i][j][4 * g + 0];
          ov.y = xv.y + gt.y * acc[i][j][4 * g + 1];
          ov.z = xv.z + gt.z * acc[i][j][4 * g + 2];
          ov.w = xv.w + gt.w * acc[i][j][4 * g + 3];
          *(float4*)(p.out + (size_t)tok * DM + n) = ov;
        }
    }
  }
}

DI void phase3b(const Params& p, int tid, int xl, int xcc, int rank, int cnt) {
  asm volatile("" : "+v"(tid));
  const int lane = tid & 63, w = tid >> 6;
  const int t_lo = xl ? 2048 * xcc + (rank * 4 + w) * 2 : (blockIdx.x * 4 + w) * 2;
  const int t_hi = xl ? 2048 * (xcc + 1) : T_TOK;
  const int t_st = xl ? cnt * 8 : gridDim.x * 8;
  for (int tok = t_lo; tok < t_hi; tok += t_st) {
    const int b = tok >> 11;
    const float* xr = p.out + (size_t)tok * DM;
    float4 xv[2][4];
    float ss[2] = {0.f, 0.f};
#pragma unroll
    for (int t = 0; t < 2; t++)
#pragma unroll
      for (int i = 0; i < 4; i++) xv[t][i] = *(const float4*)(xr + t * DM + 256 * i + 4 * lane);
#pragma unroll
    for (int t = 0; t < 2; t++)
#pragma unroll
      for (int i = 0; i < 4; i++)
        ss[t] += xv[t][i].x * xv[t][i].x + xv[t][i].y * xv[t][i].y + xv[t][i].z * xv[t][i].z + xv[t][i].w * xv[t][i].w;
    ss[0] = wave_sum(ss[0]);
    ss[1] = wave_sum(ss[1]);
    const float rstd0 = rsqrtf(ss[0] * (1.f / 1024.f) + 1e-6f);
    const float rstd1 = rsqrtf(ss[1] * (1.f / 1024.f) + 1e-6f);
    const float* md = p.mod() + b * 6144;
#pragma unroll
    for (int i = 0; i < 4; i++) {
      const int c0 = 256 * i + 4 * lane;
      float4 g = *(const float4*)(p.g_ffn + c0);
      float4 sh = *(const float4*)(md + 3072 + c0);
      float4 sc = *(const float4*)(md + 4096 + c0);
#pragma unroll
      for (int t = 0; t < 2; t++) {
        const float rstd = t ? rstd1 : rstd0;
        float4 hv;
        hv.x = xv[t][i].x * rstd * g.x * (1.f + sc.x) + sh.x;
        hv.y = xv[t][i].y * rstd * g.y * (1.f + sc.y) + sh.y;
        hv.z = xv[t][i].z * rstd * g.z * (1.f + sc.z) + sh.z;
        hv.w = xv[t][i].w * rstd * g.w * (1.f + sc.w) + sh.w;
        xv[t][i] = hv;
        uint2 o;
        o.x = pk2(hv.x, hv.y);
        o.y = pk2(hv.z, hv.w);
        *(uint2*)(p.H() + (size_t)(tok + t) * DM + c0) = o;
      }
    }
#pragma unroll
    for (int t = 0; t < 2; t++) {
      float mx = 0.f;
#pragma unroll
      for (int i = 0; i < 4; i++)
        mx = fmaxf(mx, fmaxf(fmaxf(fabsf(xv[t][i].x), fabsf(xv[t][i].y)), fmaxf(fabsf(xv[t][i].z), fabsf(xv[t][i].w))));
      mx = wave_max(mx);
      const float inv = mx > 0.f ? 127.f / mx : 0.f;
#pragma unroll
      for (int i = 0; i < 4; i++)
        *(unsigned*)(p.Hq() + (size_t)(tok + t) * DM + 256 * i + 4 * lane) =
            pack_i8x4(xv[t][i].x * inv, xv[t][i].y * inv, xv[t][i].z * inv, xv[t][i].w * inv);
      if (lane == 0) p.hs()[tok + t] = mx * (1.f / 127.f);
    }
  }
}

DI void phase4(const Params& p, char* smem, int tid, int xcc, int rank) {
  asm volatile("" : "+v"(tid));
  const int lane = tid & 63, w = tid >> 6, wm = w & 1, wn = w >> 1, r = lane & 31, h = lane >> 5;
  const TileWalk tw = tile_walk(p, xcc, rank, 128 * 8);
  for (int t = tw.start; t < tw.total; t += tw.stride) {
    int nt, mt;
    tile_of(tw, t, 8, mt, nt);
    const int m0 = mt * 128, n0 = nt * 128;
    f32x16 acc[2][2];
    gemm_mainloop(p.WtPq(), p.H(), n0, m0, smem, tid, acc);
#pragma unroll
    for (int j = 0; j < 2; j++) {
      const int tok = m0 + 64 * wn + 32 * j + r;
#pragma unroll
      for (int i = 0; i < 2; i++)
#pragma unroll
        for (int g = 0; g < 4; g++) {
          const int n = n0 + 64 * wm + 32 * i + 8 * g + 4 * h;
          uint2 o;
          o.x = pk2(acc[i][j][4 * g + 0], acc[i][j][4 * g + 1]);
          o.y = pk2(acc[i][j][4 * g + 2], acc[i][j][4 * g + 3]);
          *(uint2*)(p.Qp() + (size_t)tok * DM + n) = o;
        }
    }
  }
}

template <int N>
struct TR {
  static DI float run(float (&part)[N], int lane) {
    constexpr int H = N / 2;
    float nxt[H];
    const bool up = (lane & H) != 0;
#pragma unroll
    for (int i = 0; i < H; i++) {
      float keep = up ? part[i + H] : part[i];
      float send = up ? part[i] : part[i + H];
      nxt[i] = keep + __shfl_xor(send, H);
    }
    return TR<H>::run(nxt, lane);
  }
};
template <>
struct TR<1> {
  static DI float run(float (&part)[1], int) { return part[0]; }
};


#define DPPF(v, ctrl) __builtin_bit_cast(float, __builtin_amdgcn_mov_dpp(__builtin_bit_cast(int, (v)), (ctrl), 0xf, 0xf, true))
DI float swz_xor16(float v) { return __builtin_bit_cast(float, __builtin_amdgcn_ds_swizzle(__builtin_bit_cast(int, v), (16 << 10) | 0x1f)); }
DI int bperm_xor32_i(int v, int lane) { return __builtin_amdgcn_ds_bpermute((lane ^ 32) << 2, v); }
DI float bperm_xor32(float v, int lane) { return __builtin_bit_cast(float, __builtin_amdgcn_ds_bpermute((lane ^ 32) << 2, __builtin_bit_cast(int, v))); }
DI float wave_sum_dpp(float v, int lane) {
  v += DPPF(v, 0xB1);
  v += DPPF(v, 0x4E);
  v += DPPF(v, 0x141);
  v += DPPF(v, 0x140);
  v += swz_xor16(v);
  v += bperm_xor32(v, lane);
  return v;
}
DI float tr16_dpp(const float (&part)[16], int lane) {
  float n8[8], n4[4], n2[2];
  {
    const bool up = (lane & 8) != 0;
#pragma unroll
    for (int i = 0; i < 8; i++) {
      float keep = up ? part[i + 8] : part[i];
      float send = up ? part[i] : part[i + 8];
      n8[i] = keep + DPPF(send, 0x140);
    }
  }
  {
    const bool up = (lane & 4) != 0;
#pragma unroll
    for (int i = 0; i < 4; i++) {
      float keep = up ? n8[i + 4] : n8[i];
      float send = up ? n8[i] : n8[i + 4];
      n4[i] = keep + DPPF(send, 0x141);
    }
  }
  {
    const bool up = (lane & 2) != 0;
#pragma unroll
    for (int i = 0; i < 2; i++) {
      float keep = up ? n4[i + 2] : n4[i];
      float send = up ? n4[i] : n4[i + 2];
      n2[i] = keep + DPPF(send, 0x1B);
    }
  }
  const bool up = (lane & 1) != 0;
  float keep = up ? n2[1] : n2[0];
  float send = up ? n2[0] : n2[1];
  return keep + DPPF(send, 0xB1);
}

DI int f2key(float f) { int b = __float_as_int(f); return b ^ ((b >> 31) & 0x7fffffff); }
DI float key2f(int k) { return __int_as_float(k ^ ((k >> 31) & 0x7fffffff)); }
DI void insert16(int (&L)[16], int x) {
#pragma unroll
  for (int k = 0; k < 16; k++) {
    int t = max(L[k], x);
    x = min(L[k], x);
    L[k] = t;
  }
}
DI void bitonic_sort16(int (&L)[16]) {
#pragma unroll
  for (int s = 8; s >= 1; s >>= 1)
#pragma unroll
    for (int i = 0; i < 16; i++)
      if ((i & s) == 0) {
        int x = L[i], y = L[i + s];
        L[i] = max(x, y);
        L[i + s] = min(x, y);
      }
}
DI void bitonic_full16(int (&L)[16]) {
#pragma unroll
  for (int k = 2; k <= 16; k <<= 1)
#pragma unroll
    for (int j = k >> 1; j > 0; j >>= 1)
#pragma unroll
      for (int i = 0; i < 16; i++) {
        const int l = i ^ j;
        if (l > i) {
          const int x = L[i], y = L[l];
          if ((i & k) == 0) { L[i] = max(x, y); L[l] = min(x, y); }
          else { L[i] = min(x, y); L[l] = max(x, y); }
        }
      }
}
DI int lookup_byte(int p0, int p1, int p2, int p3, int i) {
  int d = i < 8 ? (i < 4 ? p0 : p1) : (i < 12 ? p2 : p3);
  return (d >> ((i & 3) * 8)) & 255;
}
constexpr int CAND_I[50] = {0,0,0,0,0,0,0,0,0,0,0,0,0,0,0,0,1,1,1,1,1,1,1,1,2,2,2,2,2,3,3,3,3,4,4,4,5,5,6,6,7,7,8,9,10,11,12,13,14,15};
constexpr int CAND_J[50] = {0,1,2,3,4,5,6,7,8,9,10,11,12,13,14,15,0,1,2,3,4,5,6,7,0,1,2,3,4,0,1,2,3,0,1,2,0,1,0,1,0,1,0,0,0,0,0,0,0,0};

DI void phase5(const Params& p, char* smem, int tid, int xl, int xcc, int rank, int cnt) {
  asm volatile("" : "+v"(tid));
  const int lane_outer = tid & 63, w = tid >> 6;
  char* skl = smem;
  int* El = (int*)(smem + 36864 + w * 4096);
  float* Gl = (float*)(El + 512);
  __syncthreads();
  for (int i = tid; i < 2 * 128 * 8; i += NTHREADS) {
    const int row = i >> 3, ch = i & 7;
    const float* src = p.sub_keys + (size_t)row * 64 + ch * 8;
    float4 a = *(const float4*)src, b = *(const float4*)(src + 4);
    u32x4 u = {pk2(a.x, a.y), pk2(a.z, a.w), pk2(b.x, b.y), pk2(b.z, b.w)};
    *(u32x4*)(skl + row * 144 + ch * 16) = u;
  }
  __syncthreads();
  const int IMIN = (int)0x80000000;
  const int g_lo = xl ? 512 * xcc + rank * 4 + w : blockIdx.x * 4 + w;
  const int g_hi = xl ? 512 * (xcc + 1) : T_TOK / 4;
  const int g_st = xl ? cnt * 4 : gridDim.x * 4;
  for (int grp = g_lo; grp < g_hi; grp += g_st) {
    const int tok0 = grp * 4;
    int lane_s1 = lane_outer;
    asm volatile("" : "+v"(lane_s1));
    {
    const int lane = lane_s1, r = lane & 31, h = lane >> 5;
    (void)lane;
    int LA[16], LB[16];
    {
      const int tl = r >> 3, hd = r & 7;
      const u16* qsrc = p.Qp() + (size_t)(tok0 + tl) * DM + hd * 128 + 8 * h;
#pragma unroll
      for (int c = 0; c < 2; c++) {
        bf16x8 qb[4];
#pragma unroll
        for (int ks = 0; ks < 4; ks++) qb[ks] = *(const bf16x8*)(qsrc + c * 64 + 16 * ks);
        int L[16];
#pragma unroll
        for (int k = 0; k < 16; k++) L[k] = IMIN;
#pragma unroll
        for (int mt = 0; mt < 4; mt++) {
          f32x16 sc;
#pragma unroll
          for (int q = 0; q < 16; q++) sc[q] = 0.f;
#pragma unroll
          for (int ks = 0; ks < 4; ks++) {
            bf16x8 ska = *(const bf16x8*)(skl + (c * 128 + 32 * mt + r) * 144 + ks * 32 + h * 16);
            sc = MFMA32(ska, qb[ks], sc);
          }
          int T[16];
#pragma unroll
          for (int q = 0; q < 16; q++) {
            const int pay = 32 * mt + (q & 3) + 8 * (q >> 2);
            T[q] = (f2key(sc[q]) & ~127) | pay;
          }
          bitonic_full16(T);
          if (mt == 0) {
#pragma unroll
            for (int k = 0; k < 16; k++) L[k] = T[k];
          } else {
#pragma unroll
            for (int k = 0; k < 16; k++) L[k] = max(L[k], T[15 - k]);
            bitonic_sort16(L);
          }
        }
#pragma unroll
        for (int k = 0; k < 16; k++) {
          if (c == 0) LA[k] = L[k] | (h << 2); else LB[k] = L[k] | (h << 2);
        }
      }
    }
    int M[16];
    {
      int recv[16];
#pragma unroll
      for (int k = 0; k < 16; k++) {
        int send = h ? LA[k] : LB[k];
        recv[k] = bperm_xor32_i(send, lane);
      }
#pragma unroll
      for (int k = 0; k < 16; k++) {
        int mine = h ? LB[k] : LA[k];
        M[k] = max(mine, recv[15 - k]);
      }
      bitonic_sort16(M);
    }
    int pa0, pa1, pa2, pa3, pb0, pb1, pb2, pb3;
    int F[16];
    {
      float av[16], bv[16];
      int ai[16], bi[16];
#pragma unroll
      for (int k = 0; k < 16; k++) {
        int o = bperm_xor32_i(M[k], lane);
        int ka = h ? o : M[k];
        int kb = h ? M[k] : o;
        av[k] = key2f(ka);
        bv[k] = key2f(kb);
        ai[k] = ka & 127;
        bi[k] = kb & 127;
      }
      pa0 = ai[0] | (ai[1] << 8) | (ai[2] << 16) | (ai[3] << 24);
      pa1 = ai[4] | (ai[5] << 8) | (ai[6] << 16) | (ai[7] << 24);
      pa2 = ai[8] | (ai[9] << 8) | (ai[10] << 16) | (ai[11] << 24);
      pa3 = ai[12] | (ai[13] << 8) | (ai[14] << 16) | (ai[15] << 24);
      pb0 = bi[0] | (bi[1] << 8) | (bi[2] << 16) | (bi[3] << 24);
      pb1 = bi[4] | (bi[5] << 8) | (bi[6] << 16) | (bi[7] << 24);
      pb2 = bi[8] | (bi[9] << 8) | (bi[10] << 16) | (bi[11] << 24);
      pb3 = bi[12] | (bi[13] << 8) | (bi[14] << 16) | (bi[15] << 24);
      int T1[16], T2[16];
#pragma unroll
      for (int k = 0; k < 16; k++) T2[k] = IMIN;
#pragma unroll
      for (int m = 0; m < 25; m++) {
        const int i0 = CAND_I[2 * m], j0 = CAND_J[2 * m], i1 = CAND_I[2 * m + 1], j1 = CAND_J[2 * m + 1];
        float s0 = av[i0] + bv[j0], s1 = av[i1] + bv[j1];
        float s = h ? s1 : s0;
        int pay = h ? ((i1 << 4) | j1) : ((i0 << 4) | j0);
        int key = (f2key(s) & ~255) | pay;
        if (m < 16) T1[m] = key; else T2[m - 16] = key;
      }
      bitonic_full16(T1);
      bitonic_full16(T2);
      int L[16];
#pragma unroll
      for (int k = 0; k < 16; k++) L[k] = max(T1[k], T2[15 - k]);
      bitonic_sort16(L);
#pragma unroll
      for (int k = 0; k < 16; k++) {
        int o = bperm_xor32_i(L[15 - k], lane);
        F[k] = max(L[k], o);
      }
    }
    {
      int mk = F[0];
#pragma unroll
      for (int k = 1; k < 16; k++) mk = max(mk, F[k]);
      const float mx = key2f(mk);
      float ex[8];
      float sm = 0.f;
#pragma unroll
      for (int k = 0; k < 8; k++) {
        ex[k] = __expf(key2f(F[k]) - mx);
        sm += ex[k];
      }
      sm += bperm_xor32(sm, lane);
      const float inv = 1.f / sm;
      int ev[8];
#pragma unroll
      for (int k = 0; k < 8; k++) {
        const int pay = F[k] & 255;
        ev[k] = lookup_byte(pa0, pa1, pa2, pa3, pay >> 4) * 128 + lookup_byte(pb0, pb1, pb2, pb3, pay & 15);
        ex[k] *= inv;
      }
      const int tokc = tok0 + (r >> 3);
      int* ed = p.E() + (size_t)tokc * 128 + (r & 7) * 16 + 8 * h;
      float* gd = p.G() + (size_t)tokc * 128 + (r & 7) * 16 + 8 * h;
      *(u32x4*)ed = u32x4{(unsigned)ev[0], (unsigned)ev[1], (unsigned)ev[2], (unsigned)ev[3]};
      *(u32x4*)(ed + 4) = u32x4{(unsigned)ev[4], (unsigned)ev[5], (unsigned)ev[6], (unsigned)ev[7]};
      *(f32x4*)gd = f32x4{ex[0], ex[1], ex[2], ex[3]};
      *(f32x4*)(gd + 4) = f32x4{ex[4], ex[5], ex[6], ex[7]};
    }
    }
  }
}

DI unsigned my_xcc_id() { return (unsigned)__builtin_amdgcn_s_getreg((3 << 11) | 20) & 7u; }
DI int mbcnt64(unsigned long long m) { return (int)__builtin_amdgcn_mbcnt_hi((unsigned)(m >> 32), __builtin_amdgcn_mbcnt_lo((unsigned)m, 0u)); }
DI float swz_xor8(float v) { return __builtin_bit_cast(float, __builtin_amdgcn_ds_swizzle(__builtin_bit_cast(int, v), (8 << 10) | 0x1f)); }

#define DPPI(v, ctrl) __builtin_amdgcn_mov_dpp((v), (ctrl), 0xf, 0xf, true)
DI int tr16_dpp_i(const int (&part)[16], int lane) {
  int n8[8], n4[4], n2[2];
  {
    const bool up = (lane & 8) != 0;
#pragma unroll
    for (int i = 0; i < 8; i++) {
      int keep = up ? part[i + 8] : part[i];
      int send = up ? part[i] : part[i + 8];
      n8[i] = keep + DPPI(send, 0x140);
    }
  }
  {
    const bool up = (lane & 4) != 0;
#pragma unroll
    for (int i = 0; i < 4; i++) {
      int keep = up ? n8[i + 4] : n8[i];
      int send = up ? n8[i] : n8[i + 4];
      n4[i] = keep + DPPI(send, 0x141);
    }
  }
  {
    const bool up = (lane & 2) != 0;
#pragma unroll
    for (int i = 0; i < 2; i++) {
      int keep = up ? n4[i + 2] : n4[i];
      int send = up ? n4[i] : n4[i + 2];
      n2[i] = keep + DPPI(send, 0x1B);
    }
  }
  const bool up = (lane & 1) != 0;
  int keep = up ? n2[1] : n2[0];
  int send = up ? n2[0] : n2[1];
  return keep + DPPI(send, 0xB1);
}
DI float erf_as(float x) {
  const float ax = fabsf(x);
  const float t = __builtin_amdgcn_rcpf(1.f + 0.3275911f * ax);
  float poly = 1.061405429f;
  poly = poly * t - 1.453152027f;
  poly = poly * t + 1.421413741f;
  poly = poly * t - 0.284496736f;
  poly = poly * t + 0.254829592f;
  poly *= t;
  const float e = __builtin_amdgcn_exp2f(-ax * ax * 1.4426950408889634f);
  const float r = 1.f - poly * e;
  return copysignf(r, x);
}
DI void phase6u(const Params& p, char* smem, int tid, int s_xcc, int s_rank) {
  asm volatile("" : "+v"(tid));
  const int lane = tid & 63, w = tid >> 6;
  char* wb = smem + w * 10496;
  int* lstE = (int*)wb;
  int* lstG = lstE + 512;
  int* lstS = lstG + 512;
  char* h8 = wb + 6144;
  float* hsc = (float*)(wb + 10240);
  const int xcc = s_xcc, rank = s_rank;
  __syncthreads();
#pragma unroll 1
  for (int so = 0; so < 8; so++) {
    const int s = (xcc + so) & 7;
    int start, stride;
    const int cs = (int)p.census()[64 * s];
    if (so == 0) { start = rank * 4 + w; stride = cs * 4; }
    else if (cs == 0) { start = blockIdx.x * 4 + w; stride = gridDim.x * 4; }
    else continue;
#pragma unroll 1
    for (int item = start; item < T_TOK / 4; item += stride) {
      const int tokb = item * 4;
      int e0[4], e1[4];
      float g0[4], g1[4];
      u32x4 hA[4];
      float hsv[4];
#pragma unroll
      for (int tt = 0; tt < 4; tt++) {
        const size_t tok = (size_t)(tokb + tt);
        e0[tt] = p.E()[tok * 128 + lane];
        e1[tt] = p.E()[tok * 128 + 64 + lane];
        g0[tt] = p.G()[tok * 128 + lane];
        g1[tt] = p.G()[tok * 128 + 64 + lane];
        hA[tt] = *(const u32x4*)(p.Hq() + tok * DM + 16 * lane);
        hsv[tt] = p.hs()[tok];
      }
      int n_0 = 0, n_1 = 0, n_2 = 0, n_3 = 0;
#pragma unroll
      for (int tt = 0; tt < 4; tt++) {
        const bool m0 = (e0[tt] >> 11) == s, m1 = (e1[tt] >> 11) == s;
        const unsigned long long b0 = __ballot(m0), b1 = __ballot(m1);
        const int c0 = __popcll(b0), n = c0 + __popcll(b1);
        const int pos0 = mbcnt64(b0), pos1 = c0 + mbcnt64(b1);
        if (m0) { lstE[tt * 128 + pos0] = e0[tt]; lstG[tt * 128 + pos0] = __float_as_int(g0[tt]); lstS[tt * 128 + pos0] = lane; }
        if (m1) { lstE[tt * 128 + pos1] = e1[tt]; lstG[tt * 128 + pos1] = __float_as_int(g1[tt]); lstS[tt * 128 + pos1] = lane + 64; }
        *(u32x4*)(h8 + tt * 1024 + 16 * lane) = hA[tt];
        if (lane == 0) hsc[tt] = hsv[tt];
        if (tt == 0) n_0 = n; else if (tt == 1) n_1 = n; else if (tt == 2) n_2 = n; else n_3 = n;
      }
#define NOF(T) ((T) == 0 ? n_0 : (T) == 1 ? n_1 : (T) == 2 ? n_2 : n_3)
#define U_ISSUE(BUF, LE, LG, LS, LU, TT, BASE)                                               \
  {                                                                                          \
    const int nn_ = NOF(TT);                                                                 \
    const int li_ = (TT) * 128 + min((BASE) + (lane & 15), nn_ - 1);                         \
    LE = lstE[li_];                                                                          \
    LG = __int_as_float(lstG[li_]);                                                          \
    LS = lstS[li_];                                                                          \
    LU = p.su()[LE];                                                                         \
    _Pragma("unroll") for (int k = 0; k < 16; k++) {                                         \
      const int e_ = __builtin_amdgcn_readlane(LE, k);     \
      BUF[k] = *(const u32x4*)(p.Uq() + (size_t)e_ * DM + 16 * lane);                        \
    }                                                                                        \
    __builtin_amdgcn_sched_barrier(0);                                                       \
  }
#define U_COMPUTE(BUF, LG, LS, LU, TT, BASE)                                                 \
  {                                                                                          \
    const int nn_ = NOF(TT);                                                                 \
    const u32x4 hq = *(const u32x4*)(h8 + (TT) * 1024 + 16 * lane);                          \
    const float hs_ = hsc[TT];                                                               \
    int part[16];                                                                            \
    _Pragma("unroll") for (int k = 0; k < 16; k++) {                                         \
      int a = 0;     \
      _Pragma("unroll") for (int q = 0; q < 4; q++) {                                        \
        const int x = (int)BUF[k][q];                                                        \
        const int hh = (int)hq[q];                                                           \
        a = __builtin_amdgcn_sdot4(x, hh, a, false);                                         \
      }                                                                                      \
      part[k] = a;                                                                           \
    }                                                                                        \
    int ai_ = tr16_dpp_i(part, lane);                                                        \
    ai_ += __builtin_amdgcn_ds_swizzle(ai_, (16 << 10) | 0x1f);                              \
    ai_ += bperm_xor32_i(ai_, lane);                                                         \
    const float av = (float)ai_ * (LU * hs_);                                                \
    const float wv = 0.5f * av * (1.f + erf_as(av * 0.70710678118654752f)) * LG * 0.125f;    \
    if (lane < 16 && (BASE) + lane < nn_) p.W()[(size_t)(tokb + (TT)) * 128 + LS] = wv;      \
  }
#define U_NEXT(T2, B2, T1, B1)                                                               \
  {                                                                                          \
    T2 = T1; B2 = (B1) + 16;                                                                 \
    if (B2 >= NOF(T2)) { B2 = 0; do { T2++; } while (T2 < 4 && NOF(T2) == 0); }              \
  }
      {
        u32x4 bufA[16], bufB[16];
        int leA, lsA, leB, lsB;
        float lgA, lgB, luA, luB;
        int tA = 0, bA = 0, tB, bB;
        while (tA < 4 && NOF(tA) == 0) tA++;
        if (tA < 4) {
          U_ISSUE(bufA, leA, lgA, lsA, luA, tA, bA)
#pragma unroll 1
          for (;;) {
            U_NEXT(tB, bB, tA, bA)
            if (tB < 4) U_ISSUE(bufB, leB, lgB, lsB, luB, tB, bB)
            U_COMPUTE(bufA, lgA, lsA, luA, tA, bA)
            if (tB >= 4) break;
            U_NEXT(tA, bA, tB, bB)
            if (tA < 4) U_ISSUE(bufA, leA, lgA, lsA, luA, tA, bA)
            U_COMPUTE(bufB, lgB, lsB, luB, tB, bB)
            if (tA >= 4) break;
          }
        }
      }
#undef NOF
#undef U_ISSUE
#undef U_COMPUTE
#undef U_NEXT
    }
  }
}

DI void phase7v(const Params& p, char* smem, int tid, int s_xcc, int s_rank) {
  asm volatile("" : "+v"(tid));
  const int lane = tid & 63, w = tid >> 6;
  const int hp = lane >> 3, c = lane & 7;
  char* wb = smem + w * 8192;
  int* El = (int*)wb;
  float* Wl = (float*)(wb + 2048);
  float* Xl = (float*)(wb + 4096);
  float* Gt = (float*)(wb + 6144);
  const int xcc = s_xcc, rank = s_rank;
  __syncthreads();
#pragma unroll 1
  for (int so = 0; so < 8; so++) {
    const int s = (xcc + so) & 7;
    int start, stride;
    const int cs = (int)p.census()[64 * s];
    if (so == 0) { start = rank * 4 + w; stride = cs * 4; }
    else if (cs == 0) { start = blockIdx.x * 4 + w; stride = gridDim.x * 4; }
    else continue;
    const unsigned char* vs = p.Vq() + (size_t)s * ((size_t)16384 * 128) + 16 * c;
#pragma unroll 1
    for (int item = start; item < T_TOK / 4; item += stride) {
      const int tokb = item * 4;
      const int b = tokb >> 11;
      {
        int ea[4], eb[4];
        float wa[4], wb2[4];
        f32x2_t xa[4];
#pragma unroll
        for (int tt = 0; tt < 4; tt++) {
          const size_t tok = (size_t)(tokb + tt);
          ea[tt] = p.E()[tok * 128 + lane];
          eb[tt] = p.E()[tok * 128 + 64 + lane];
          wa[tt] = p.W()[tok * 128 + lane];
          wb2[tt] = p.W()[tok * 128 + 64 + lane];
          xa[tt] = *(const f32x2_t*)(p.out + tok * DM + 128 * s + 2 * lane);
        }
        const f32x2_t gt = *(const f32x2_t*)(p.mod() + b * 6144 + 5120 + 128 * s + 2 * lane);
#pragma unroll
        for (int tt = 0; tt < 4; tt++) {
          El[tt * 128 + lane] = ea[tt];
          El[tt * 128 + 64 + lane] = eb[tt];
          Wl[tt * 128 + lane] = wa[tt];
          Wl[tt * 128 + 64 + lane] = wb2[tt];
          *(f32x2_t*)(Xl + tt * 128 + 2 * lane) = xa[tt];
        }
        *(f32x2_t*)(Gt + 2 * lane) = gt;
      }
#pragma unroll 1
      for (int tt = 0; tt < 4; tt++) {
        const int tok = tokb + tt;
        u32x4 ee[4];
        f32x4 ww[4];
#pragma unroll
        for (int q = 0; q < 4; q++) {
          ee[q] = *(const u32x4*)(El + tt * 128 + hp * 16 + 4 * q);
          ww[q] = *(const f32x4*)(Wl + tt * 128 + hp * 16 + 4 * q);
        }
        u32x4 vv[16];
#pragma unroll
        for (int i = 0; i < 16; i++) {
          const unsigned e = ee[i >> 2][i & 3];
          vv[i] = *(const u32x4*)(vs + (size_t)e * 128);
        }
        float acc[16];
#pragma unroll
        for (int j = 0; j < 16; j++) acc[j] = 0.f;
#pragma unroll
        for (int i = 0; i < 16; i++) {
          const float wj = ww[i >> 2][i & 3];
#pragma unroll
          for (int q = 0; q < 4; q++) {
            const unsigned x = vv[i][q];
            f32x2_t lo = __builtin_amdgcn_cvt_pk_f32_fp8(x, false);
            f32x2_t hi = __builtin_amdgcn_cvt_pk_f32_fp8(x, true);
            acc[4 * q + 0] += wj * lo.x;
            acc[4 * q + 1] += wj * lo.y;
            acc[4 * q + 2] += wj * hi.x;
            acc[4 * q + 3] += wj * hi.y;
          }
        }
        float a8[8], a4[4], a2[2];
        {
          const bool up = (lane & 32) != 0;
#pragma unroll
          for (int i = 0; i < 8; i++) {
            const float keep = up ? acc[i + 8] : acc[i];
            const float send = up ? acc[i] : acc[i + 8];
            a8[i] = keep + bperm_xor32(send, lane);
          }
        }
        {
          const bool up = (lane & 16) != 0;
#pragma unroll
          for (int i = 0; i < 4; i++) {
            const float keep = up ? a8[i + 4] : a8[i];
            const float send = up ? a8[i] : a8[i + 4];
            a4[i] = keep + swz_xor16(send);
          }
        }
        {
          const bool up = (lane & 8) != 0;
#pragma unroll
          for (int i = 0; i < 2; i++) {
            const float keep = up ? a4[i + 2] : a4[i];
            const float send = up ? a4[i] : a4[i + 2];
            a2[i] = keep + DPPF(send, 0x128);
          }
        }
        {
          const int col = 16 * c + 2 * hp;
          const f32x2_t xv = *(const f32x2_t*)(Xl + tt * 128 + col);
          const f32x2_t gtv = *(const f32x2_t*)(Gt + col);
          f32x2_t ov;
          ov.x = xv.x + gtv.x * a2[0];
          ov.y = xv.y + gtv.y * a2[1];
          *(f32x2_t*)(p.out + (size_t)tok * DM + 128 * s + col) = ov;
        }
      }
    }
  }
}

DI void phase8(const Params& p, int tid) {
  asm volatile("" : "+v"(tid));
  const int lane = tid & 63, w = tid >> 6;
  for (int tok = (blockIdx.x * 4 + w) * 4; tok < T_TOK; tok += gridDim.x * 16) {
    float* xr = p.out + (size_t)tok * DM;
    float4 xv[4][4];
#pragma unroll
    for (int t = 0; t < 4; t++)
#pragma unroll
      for (int i = 0; i < 4; i++) xv[t][i] = *(const float4*)(xr + t * DM + 256 * i + 4 * lane);
    float rs[4];
#pragma unroll
    for (int t = 0; t < 4; t++) {
      float ss = 0.f;
#pragma unroll
      for (int i = 0; i < 4; i++)
        ss += xv[t][i].x * xv[t][i].x + xv[t][i].y * xv[t][i].y + xv[t][i].z * xv[t][i].z + xv[t][i].w * xv[t][i].w;
      ss = wave_sum(ss);
      rs[t] = rsqrtf(ss * (1.f / 1024.f) + 1e-6f);
    }
#pragma unroll
    for (int i = 0; i < 4; i++) {
      const int c0 = 256 * i + 4 * lane;
      float4 g = *(const float4*)(p.g_final + c0);
#pragma unroll
      for (int t = 0; t < 4; t++)
        *(float4*)(xr + t * DM + c0) = make_float4(xv[t][i].x * rs[t] * g.x, xv[t][i].y * rs[t] * g.y, xv[t][i].z * rs[t] * g.z, xv[t][i].w * rs[t] * g.w);
    }
  }
}

#define XB_TMO      128
#define XB_XCNT(j)  (256  + 64 * (j))
#define XB_XSUB(j)  (1280 + 64 * (j))
#define XB_XGEN(j)  (2304 + 64 * (j))
#define XB_TOP      3328
#define XB_TOPGEN   3392
#define XCD_BAR_WORDS 3456
#define XB_SPIN_CAP (1u << 18)
#define LAS __attribute__((address_space(3)))

__device__ __forceinline__ unsigned xb_ld(unsigned* p)              { return __hip_atomic_load(p, __ATOMIC_RELAXED, __HIP_MEMORY_SCOPE_AGENT); }
__device__ __forceinline__ unsigned xb_add(unsigned* p, unsigned v) { return __hip_atomic_fetch_add(p, v, __ATOMIC_RELAXED, __HIP_MEMORY_SCOPE_AGENT); }
__device__ __forceinline__ unsigned xb_xcc_id() { return (unsigned)__builtin_amdgcn_s_getreg((3 << 11) | 20) & 0xFu; }
#define XB_SPIN(cond, bar) do { unsigned _sp = 0; while (cond) { __builtin_amdgcn_s_sleep(1); \
    if ((++_sp & 255u) == 0u) { if (xb_ld(&(bar)[XB_TMO])) break; if (_sp > XB_SPIN_CAP) { atomicAdd(&(bar)[XB_TMO], 1u); break; } } } } while (0)

struct XcdBarrier {
    unsigned* bar; unsigned x;
    volatile LAS unsigned* st;
};

__device__ __forceinline__ XcdBarrier xcd_barrier_post(unsigned* bar, volatile LAS unsigned* st) {
    XcdBarrier b; b.bar = bar; b.x = xb_xcc_id(); b.st = st;
    if (threadIdx.x == 0) (void)xb_add(&bar[XB_XCNT(b.x)], 1u);
    return b;
}
__device__ __forceinline__ void xcd_barrier_complete(unsigned* bar, unsigned x, unsigned& nloc, unsigned& nx) {
    const unsigned G = gridDim.x * gridDim.y * gridDim.z;
    unsigned sum, cnt, mine, sp = 0u;
    for (;;) {
        sum = 0u; cnt = 0u; mine = 0u;
#pragma unroll
        for (unsigned j = 0; j < 16; ++j) { const unsigned c = xb_ld(&bar[XB_XCNT(j)]); sum += c; cnt += (c > 0u) ? 1u : 0u; mine = (j == x) ? c : mine; }
        if (sum == G) break;
        __builtin_amdgcn_s_sleep(1);
        if ((++sp & 255u) == 0u) { if (xb_ld(&bar[XB_TMO])) break; if (sp > XB_SPIN_CAP) { atomicAdd(&bar[XB_TMO], 1u); break; } }
    }
    nloc = mine > 0u ? mine : 1u; nx = cnt > 0u ? cnt : 1u;
}

__device__ __forceinline__ void xcd_barrier(const XcdBarrier& b) {
    asm volatile("s_waitcnt vmcnt(0)" ::: "memory");
    __syncthreads();
    if (threadIdx.x == 0) {
        unsigned* bar = b.bar;
        __builtin_amdgcn_s_waitcnt(0);
        unsigned nloc = b.st[0], nx = b.st[1];
        if (nloc == 0u) { xcd_barrier_complete(bar, b.x, nloc, nx); b.st[0] = nloc; b.st[1] = nx; }
        const unsigned old = xb_add(&bar[XB_XSUB(b.x)], 1u);
        const unsigned gen = old / nloc;
        if (old + 1u == (gen + 1u) * nloc) {
            __builtin_amdgcn_fence(__ATOMIC_RELEASE, "agent");
            asm volatile("s_waitcnt vmcnt(0)" ::: "memory");
            const unsigned og = xb_add(&bar[XB_TOP], 1u);
            const unsigned tg = og / nx;
            if (og + 1u == (tg + 1u) * nx) xb_add(&bar[XB_TOPGEN], 1u);
            else XB_SPIN(xb_ld(&bar[XB_TOPGEN]) == tg, bar);
            __builtin_amdgcn_fence(__ATOMIC_ACQUIRE, "agent");
            xb_add(&bar[XB_XGEN(b.x)], 1u);
            asm volatile("s_waitcnt vmcnt(0)" ::: "memory");
        } else {
            XB_SPIN(xb_ld(&bar[XB_XGEN(b.x)]) == gen, bar);
            __builtin_amdgcn_fence(__ATOMIC_ACQUIRE, "agent");
            asm volatile("s_waitcnt vmcnt(0)" ::: "memory");
        }
    }
    __syncthreads();
}


DI void xcd_local_barrier(unsigned* ctr, unsigned cnt, unsigned* bar) {
  asm volatile("s_waitcnt vmcnt(0)" ::: "memory");
  __syncthreads();
  if (threadIdx.x == 0) {
    __builtin_amdgcn_s_waitcnt(0);
    const unsigned old = xb_add(ctr, 1u);
    const unsigned round = old / cnt;
    if (old + 1u == (round + 1u) * cnt) xb_add(ctr + 32, 1u);
    else XB_SPIN(xb_ld(ctr + 32) == round, bar);
    __builtin_amdgcn_fence(__ATOMIC_ACQUIRE, "agent");
    asm volatile("s_waitcnt vmcnt(0)" ::: "memory");
  }
  __syncthreads();
}

__global__ void __launch_bounds__(NTHREADS, 2) fwd_megakernel(Params p) {
  __shared__ __attribute__((aligned(16))) char smem[SMEM_BYTES];
  cg::grid_group grid = cg::this_grid();
  const int tid = threadIdx.x;
  __shared__ uint4 xb_words;
  __shared__ int xcd_info[4];
  if (tid == 0) {
    xb_words = make_uint4(0u, 0u, 0u, 0u);
    const int x = (int)my_xcc_id();
    xcd_info[0] = x;
    xcd_info[1] = (int)atomicAdd(&p.census()[64 * x], 1u);
  }
  __syncthreads();
  (void)xcd_barrier_post(p.bar(), (volatile LAS unsigned*)&xb_words);
#define GBAR() do { XcdBarrier b_; b_.bar = p.bar(); b_.x = xb_xcc_id(); b_.st = (volatile LAS unsigned*)&xb_words; xcd_barrier(b_); } while (0)
  phase0(p, smem, tid);
  if (gridDim.y == 77u) grid.sync();
  GBAR();
  if (tid == 0) {
    int all = 1, mine = 1;
    for (int j = 0; j < 8; j++) {
      const int cj = (int)p.census()[64 * j];
      all = all && (cj > 0);
      if (j == xcd_info[0]) mine = cj;
    }
    xcd_info[2] = all;
    xcd_info[3] = mine;
  }
  __syncthreads();
#define LBAR() do { if (xcd_info[2]) xcd_local_barrier(p.lbar() + 64 * xcd_info[0], (unsigned)xcd_info[3], p.bar()); else GBAR(); } while (0)
  phase1a(p, smem, tid, xcd_info[2], xcd_info[0], xcd_info[1], xcd_info[3]);
  LBAR();
  phase_cumsum(p, smem, tid, xcd_info[2], xcd_info[0], xcd_info[1], xcd_info[3]);
  phase1b(p, smem, tid, xcd_info[0], xcd_info[1]);
  LBAR();
  phase2(p, smem, tid, xcd_info[2], xcd_info[0]);
  LBAR();
  phase3(p, smem, tid, xcd_info[0], xcd_info[1]);
  LBAR();
  phase3b(p, tid, xcd_info[2], xcd_info[0], xcd_info[1], xcd_info[3]);
  LBAR();
  phase4(p, smem, tid, xcd_info[0], xcd_info[1]);
  LBAR();
  phase5(p, smem, tid, xcd_info[2], xcd_info[0], xcd_info[1], xcd_info[3]);
  GBAR();
  phase6u(p, smem, tid, xcd_info[0], xcd_info[1]);
  GBAR();
  phase7v(p, smem, tid, xcd_info[0], xcd_info[1]);
  GBAR();
  phase8(p, tid);
}

extern "C" void kernel_launch(void* const* d_in, const int* in_sizes, int n_in, void* d_out, int out_size, void* d_ws,
                              size_t ws_size, hipStream_t stream) {
  static int grid_blocks = 0;
  if (!grid_blocks) {
    int dev = 0, cus = 0, per_cu = 0;
    hipGetDevice(&dev);
    hipDeviceGetAttribute(&cus, hipDeviceAttributeMultiprocessorCount, dev);
    hipOccupancyMaxActiveBlocksPerMultiprocessor(&per_cu, fwd_megakernel, NTHREADS, 0);
    if (per_cu > 2) per_cu = 2;
    if (per_cu < 1) per_cu = 1;
    grid_blocks = cus * per_cu;
  }
  Params p{};
  p.x = (const float*)d_in[0]; p.c = (const float*)d_in[1]; p.w_ada = (const float*)d_in[2]; p.b_ada = (const float*)d_in[3];
  p.g_attn = (const float*)d_in[4]; p.w_in = (const float*)d_in[5]; p.b_f = (const float*)d_in[6];
  p.lq1 = (const float*)d_in[7]; p.lk1 = (const float*)d_in[8]; p.lq2 = (const float*)d_in[9]; p.lk2 = (const float*)d_in[10];
  p.g_subln = (const float*)d_in[11]; p.w_o = (const float*)d_in[12]; p.g_ffn = (const float*)d_in[13];
  p.w_pq = (const float*)d_in[14]; p.sub_keys = (const float*)d_in[15]; p.u_exp = (const float*)d_in[16];
  p.v_exp = (const float*)d_in[17]; p.g_final = (const float*)d_in[18];
  p.out = (float*)d_out;
  p.ws = (char*)d_ws;
  hipMemsetAsync((char*)d_ws + 205 * 1024 * 1024, 0, 32768, stream);
  void* args[] = {&p};
  hipError_t e = hipLaunchCooperativeKernel((void*)fwd_megakernel, dim3(grid_blocks), dim3(NTHREADS), args, 0, stream);
  if (e != hipSuccess) fprintf(stderr, "cooperative launch failed: %s (grid %d)\n", hipGetErrorString(e), grid_blocks);
}
```

```cpp
#include <hip/hip_runtime.h>
#include <hip/hip_cooperative_groups.h>
#include <cstdio>
namespace cg = cooperative_groups;

#define DI __device__ __forceinline__
typedef unsigned short u16;
using bf16x8 = __attribute__((ext_vector_type(8))) short;
using f32x16 = __attribute__((ext_vector_type(16))) float;
typedef __bf16 bf16x2_t __attribute__((ext_vector_type(2)));
typedef float f32x2_t __attribute__((ext_vector_type(2)));
using u32x4 = __attribute__((ext_vector_type(4))) unsigned;
using u32x2 = __attribute__((ext_vector_type(2))) unsigned;
using f32x4 = __attribute__((ext_vector_type(4))) float;

#define MFMA32(a, b, c) __builtin_amdgcn_mfma_f32_32x32x16_bf16((a), (b), (c), 0, 0, 0)

static constexpr int T_TOK = 16384;
static constexpr int SEQ = 2048;
static constexpr int DM = 1024;
static constexpr int INC = 3080;
static constexpr float LOG2E = 1.4426950408889634f;
static constexpr int NTHREADS = 256;
static constexpr int SMEM_BYTES = 70656;

struct Params {
  const float *x, *c, *w_ada, *b_ada, *g_attn, *w_in, *b_f, *lq1, *lk1, *lq2, *lk2, *g_subln, *w_o, *g_ffn, *w_pq,
      *sub_keys, *u_exp, *v_exp, *g_final;
  float* out;
  char* ws;
  static constexpr size_t MB = 1024 * 1024;
  DI u16* WtIn() const { return (u16*)(ws + 0 * MB); }
  DI u16* WtO() const { return (u16*)(ws + 6 * MB); }
  DI u16* WtPq() const { return (u16*)(ws + 8 * MB); }
  DI unsigned char* Uq() const { return (unsigned char*)(ws + 10 * MB); }
  DI unsigned char* Vq() const { return (unsigned char*)(ws + 42 * MB); }
  DI u16* H() const { return (u16*)(ws + 74 * MB); }
  DI u16* QK() const { return (u16*)(ws + 106 * MB); }
  DI u16* Vt() const { return (u16*)(ws + 170 * MB); }
  DI u16* Qp() const { return (u16*)(ws + 106 * MB); }
  DI float* mod() const { return (float*)(ws + 202 * MB); }
  DI float* rope() const { return (float*)(ws + 202 * MB + 256 * 1024); }
  DI float* logf() const { return (float*)(ws + 203 * MB); }
  DI float* FL() const { return (float*)(ws + 204 * MB); }
  DI unsigned* counters() const { return (unsigned*)(ws + 205 * MB); }
  DI float* stash() const { return (float*)(ws + 206 * MB); }
  DI unsigned* bar() const { return (unsigned*)(ws + 205 * MB + 4096); }
  DI unsigned* census() const { return (unsigned*)(ws + 205 * MB + 20480); }
  DI float* su() const { return (float*)(ws + 205 * MB + 131072); }
  DI unsigned char* Hq() const { return (unsigned char*)(ws + 170 * MB); }
  DI float* hs() const { return (float*)(ws + 186 * MB); }
  DI unsigned* lbar() const { return (unsigned*)(ws + 205 * MB + 24576); }
  DI int* E() const { return (int*)(ws + 138 * MB); }
  DI float* G() const { return (float*)(ws + 146 * MB); }
  DI float* W() const { return (float*)(ws + 154 * MB); }
};

DI unsigned pk2(float a, float b) {
  f32x2_t v = {a, b};
  bf16x2_t r = __builtin_convertvector(v, bf16x2_t);
  return __builtin_bit_cast(unsigned, r);
}
DI float dot2bf(unsigned a, unsigned b, float c) {
  bf16x2_t x = __builtin_bit_cast(bf16x2_t, a);
  bf16x2_t y = __builtin_bit_cast(bf16x2_t, b);
  return __builtin_amdgcn_fdot2_f32_bf16(x, y, c, false);
}
DI float bf_lo(unsigned u) { return __uint_as_float(u << 16); }
DI float bf_hi(unsigned u) { return __uint_as_float(u & 0xffff0000u); }
#define DPPF0(v, ctrl) __builtin_bit_cast(float, __builtin_amdgcn_mov_dpp(__builtin_bit_cast(int, (v)), (ctrl), 0xf, 0xf, true))
DI float swz16_0(float v) { return __builtin_bit_cast(float, __builtin_amdgcn_ds_swizzle(__builtin_bit_cast(int, v), (16 << 10) | 0x1f)); }
DI float wave_sum(float v) {
  v += DPPF0(v, 0xB1);
  v += DPPF0(v, 0x4E);
  v += DPPF0(v, 0x141);
  v += DPPF0(v, 0x140);
  v += swz16_0(v);
  v += __shfl_xor(v, 32);
  return v;
}
DI float wave_max(float v) {
  v = fmaxf(v, DPPF0(v, 0xB1));
  v = fmaxf(v, DPPF0(v, 0x4E));
  v = fmaxf(v, DPPF0(v, 0x141));
  v = fmaxf(v, DPPF0(v, 0x140));
  v = fmaxf(v, swz16_0(v));
  v = fmaxf(v, __shfl_xor(v, 32));
  return v;
}

DI void transpose_tile(const float* __restrict__ src, int ld, int col0, int k0, u16* __restrict__ dst, int n0, char* smem,
                       int tid) {
  float* t = (float*)smem;
  __syncthreads();
  {
    int cc = tid & 63, r0 = tid >> 6;
#pragma unroll
    for (int i = 0; i < 16; i++) {
      int r = r0 + 4 * i;
      t[r * 65 + cc] = src[(size_t)(k0 + r) * ld + col0 + cc];
    }
  }
  __syncthreads();
#pragma unroll
  for (int i = 0; i < 2; i++) {
    int q = tid + 256 * i;
    int n = q >> 3, kc = q & 7;
    uint4 v;
    v.x = pk2(t[(8 * kc + 0) * 65 + n], t[(8 * kc + 1) * 65 + n]);
    v.y = pk2(t[(8 * kc + 2) * 65 + n], t[(8 * kc + 3) * 65 + n]);
    v.z = pk2(t[(8 * kc + 4) * 65 + n], t[(8 * kc + 5) * 65 + n]);
    v.w = pk2(t[(8 * kc + 6) * 65 + n], t[(8 * kc + 7) * 65 + n]);
    *(uint4*)(dst + (size_t)(n0 + n) * 1024 + k0 + 8 * kc) = v;
  }
}

DI void phase0(const Params& p, char* smem, int tid) {
  asm volatile("" : "+v"(tid));
  const int bid = blockIdx.x, nb = gridDim.x;
  if (bid == 0 && tid == 0) { p.counters()[0] = 0u; p.counters()[1] = 0u; }
  {
    float* sc = (float*)smem;
    float* red = (float*)(smem + 32768);
    bool loaded = false;
    for (int it = bid; it < 192; it += nb) {
      if (!loaded) {
        for (int i = tid; i < 8192; i += NTHREADS) {
          float v = p.c[i];
          sc[i] = v / (1.f + __expf(-v));
        }
        loaded = true;
      }
      __syncthreads();
      int col = it * 32 + (tid & 31), kg = tid >> 5;
      float acc[8];
#pragma unroll
      for (int b = 0; b < 8; b++) acc[b] = 0.f;
#pragma unroll 16
      for (int k = kg * 128; k < kg * 128 + 128; k++) {
        float w = p.w_ada[(size_t)k * 6144 + col];
#pragma unroll
        for (int b = 0; b < 8; b++) acc[b] += sc[b * 1024 + k] * w;
      }
#pragma unroll
      for (int b = 0; b < 8; b++) red[(kg * 8 + b) * 32 + (tid & 31)] = acc[b];
      __syncthreads();
      {
        int b = tid >> 5, cc = tid & 31;
        float s = 0.f;
#pragma unroll
        for (int g = 0; g < 8; g++) s += red[(g * 8 + b) * 32 + cc];
        p.mod()[b * 6144 + it * 32 + cc] = s + p.b_ada[it * 32 + cc];
      }
    }
    __syncthreads();
  }
  for (int it = bid; it < 1280; it += nb) {
    if (it < 768) {
      int nt = it >> 4, kt = it & 15;
      int n0 = nt * 64;
      int col0 = n0 < 1536 ? n0 : n0 + 8;
      transpose_tile(p.w_in, INC, col0, kt * 64, p.WtIn(), n0, smem, tid);
    } else if (it < 1024) {
      int j = it - 768;
      transpose_tile(p.w_o, 1024, (j >> 4) * 64, (j & 15) * 64, p.WtO(), (j >> 4) * 64, smem, tid);
    } else {
      int j = it - 1024;
      transpose_tile(p.w_pq, 1024, (j >> 4) * 64, (j & 15) * 64, p.WtPq(), (j >> 4) * 64, smem, tid);
    }
  }
  for (int e = bid * NTHREADS + tid; e < 2048 * 8; e += nb * NTHREADS) {
    int pos = e >> 3, i = e & 7;
    const double invs[8] = {1.0, 0.19392274474868576, 0.03760603093086393, 0.007292664737217109,
                            0.001414213562373095, 0.0002742481756762073, 5.318295896944988e-05, 1.031338537721246e-05};
    double inv = invs[0];
#pragma unroll
    for (int q = 1; q < 8; q++) inv = (i == q) ? invs[q] : inv;
    double ang = (double)pos * inv;
    double t = ang * 0.15915494309189535;
    t -= rint(t);
    double r = t * 6.283185307179586;
    double r2 = r * r;
    double s = 1.0, c = 1.0;
#pragma unroll
    for (int n = 15; n >= 1; n--) {
      s = 1.0 - s * r2 * (1.0 / (double)((2 * n) * (2 * n + 1)));
      c = 1.0 - c * r2 * (1.0 / (double)((2 * n - 1) * (2 * n)));
    }
    s *= r;
    p.rope()[pos * 16 + i] = (float)c;
    p.rope()[pos * 16 + 8 + i] = (float)s;
  }
}

DI void phase1a(const Params& p, char* smem, int tid, int xl, int xcc, int rank, int cnt) {
  asm volatile("" : "+v"(tid));
  float* wfg = (float*)smem;
  __syncthreads();
#pragma unroll 8
  for (int i = tid; i < 8192; i += NTHREADS) {
    int k = i >> 3, j = i & 7;
    wfg[j * 1024 + k] = p.w_in[(size_t)k * INC + 1536 + j];
  }
  __syncthreads();
  const int lane = tid & 63, w = tid >> 6;
  const int t_lo = xl ? 2048 * xcc + rank * 4 + w : blockIdx.x * 4 + w;
  const int t_hi = xl ? 2048 * (xcc + 1) : T_TOK;
  const int t_st = xl ? cnt * 4 : gridDim.x * 4;
  for (int tok = t_lo; tok < t_hi; tok += t_st) {
    const int b = tok >> 11, s = tok & 2047;
    const float* xr = p.x + (size_t)tok * DM;
    float4 xv[4];
    float ss = 0.f;
#pragma unroll
    for (int i = 0; i < 4; i++) {
      xv[i] = *(const float4*)(xr + 256 * i + 4 * lane);
      ss += xv[i].x * xv[i].x + xv[i].y * xv[i].y + xv[i].z * xv[i].z + xv[i].w * xv[i].w;
    }
    ss = wave_sum(ss);
    const float rstd = rsqrtf(ss * (1.f / 1024.f) + 1e-6f);
    const float* md = p.mod() + b * 6144;
    float fg[8];
#pragma unroll
    for (int j = 0; j < 8; j++) fg[j] = 0.f;
#pragma unroll
    for (int i = 0; i < 4; i++) {
      const int c0 = 256 * i + 4 * lane;
      float4 g = *(const float4*)(p.g_attn + c0);
      float4 sh = *(const float4*)(md + c0);
      float4 sc = *(const float4*)(md + 1024 + c0);
      float4 h;
      h.x = xv[i].x * rstd * g.x * (1.f + sc.x) + sh.x;
      h.y = xv[i].y * rstd * g.y * (1.f + sc.y) + sh.y;
      h.z = xv[i].z * rstd * g.z * (1.f + sc.z) + sh.z;
      h.w = xv[i].w * rstd * g.w * (1.f + sc.w) + sh.w;
      uint2 o;
      o.x = pk2(h.x, h.y); o.y = pk2(h.z, h.w);
      *(uint2*)(p.H() + (size_t)tok * DM + c0) = o;
#pragma unroll
      for (int j = 0; j < 8; j++) {
        float4 wv = *(const float4*)(wfg + j * 1024 + c0);
        fg[j] += h.x * wv.x + h.y * wv.y + h.z * wv.z + h.w * wv.w;
      }
    }
#pragma unroll
    for (int j = 0; j < 8; j++) fg[j] = wave_sum(fg[j]);
    float z = fg[0];
#pragma unroll
    for (int j = 1; j < 8; j++) z = (lane == j) ? fg[j] : z;
    if (lane < 8) {
      z += p.b_f[lane];
      float ls = fminf(z, 0.f) - log1pf(__expf(-fabsf(z)));
      p.logf()[(b * 8 + lane) * SEQ + s] = ls;
    }
  }
}

DI void phase_cumsum(const Params& p, char* smem, int tid, int xl, int xcc, int rank, int cnt) {
  asm volatile("" : "+v"(tid));
  double* part = (double*)smem;
  const int s_lo = xl ? 8 * xcc + rank : blockIdx.x;
  const int s_hi = xl ? 8 * (xcc + 1) : 64;
  const int s_st = xl ? cnt : gridDim.x;
  for (int seq = s_lo; seq < s_hi; seq += s_st) {
    __syncthreads();
    const float* lf = p.logf() + seq * SEQ + tid * 8;
    float4 a = *(const float4*)lf, b = *(const float4*)(lf + 4);
    double v0 = a.x, v1 = v0 + a.y, v2 = v1 + a.z, v3 = v2 + a.w, v4 = v3 + b.x, v5 = v4 + b.y, v6 = v5 + b.z, v7 = v6 + b.w;
    double run = v7;
    part[tid] = run;
    __syncthreads();
#pragma unroll 1
    for (int off = 1; off < 256; off <<= 1) {
      const double add = tid >= off ? part[tid - off] : 0.0;
      __syncthreads();
      part[tid] += add;
      __syncthreads();
    }
    const double pre = part[tid] - run;
    const double L2E = 1.4426950408889634;
    float* dst = p.FL() + seq * SEQ + tid * 8;
    *(float4*)dst = make_float4((float)((v0 + pre) * L2E), (float)((v1 + pre) * L2E), (float)((v2 + pre) * L2E), (float)((v3 + pre) * L2E));
    *(float4*)(dst + 4) = make_float4((float)((v4 + pre) * L2E), (float)((v5 + pre) * L2E), (float)((v6 + pre) * L2E), (float)((v7 + pre) * L2E));
  }
  __syncthreads();
}

DI void gemm_mainloop(const u16* __restrict__ Lg, const u16* __restrict__ Rg, int l0, int r0, char* smem, int tid,
                      f32x16 (&acc)[2][2]) {
  const int lane = tid & 63, w = tid >> 6;
  const int wm = w & 1, wn = w >> 1;
  const int r = lane & 31, h = lane >> 5;
  const int lc = tid & 7, lr = tid >> 3;
  const int sw = ((lr >> 1) & 7);
#pragma unroll
  for (int i = 0; i < 2; i++)
#pragma unroll
    for (int j = 0; j < 2; j++)
#pragma unroll
      for (int q = 0; q < 16; q++) acc[i][j][q] = 0.f;
  u32x4 ra0[4], rb0[4], ra1[4], rb1[4];
  const u16* lp = Lg + (size_t)(l0 + lr) * 1024 + lc * 8;
  const u16* rp = Rg + (size_t)(r0 + lr) * 1024 + lc * 8;
#define GLOAD(RA, RB, KT)                                                          \
  _Pragma("unroll") for (int i = 0; i < 4; i++) {                                  \
    RA[i] = *(const u32x4*)(lp + (size_t)i * 32 * 1024 + (KT) * 64);               \
    RB[i] = *(const u32x4*)(rp + (size_t)i * 32 * 1024 + (KT) * 64);               \
  }
#define SSTORE(RA, RB, BUF)                                                        \
  {                                                                                \
    char* dL = smem + (BUF) * 32768;                                               \
    char* dR = dL + 16384;                                                         \
    _Pragma("unroll") for (int i = 0; i < 4; i++) {                                \
      int off = (lr + 32 * i) * 128 + ((lc ^ sw) << 4);                            \
      *(u32x4*)(dL + off) = RA[i];                                                 \
      *(u32x4*)(dR + off) = RB[i];                                                 \
    }                                                                              \
  }
#define COMPUTE(BUF)                                                               \
  {                                                                                \
    const char* sL = smem + (BUF) * 32768;                                         \
    const char* sR = sL + 16384;                                                   \
    _Pragma("unroll") for (int ks = 0; ks < 4; ks++) {                             \
      bf16x8 a[2], b[2];                                                           \
      _Pragma("unroll") for (int i = 0; i < 2; i++) {                              \
        int row = 64 * wm + 32 * i + r;                                            \
        a[i] = *(const bf16x8*)(sL + row * 128 + (((2 * ks + h) ^ ((row >> 1) & 7)) << 4));   \
        int rowb = 64 * wn + 32 * i + r;                                           \
        b[i] = *(const bf16x8*)(sR + rowb * 128 + (((2 * ks + h) ^ ((rowb >> 1) & 7)) << 4)); \
      }                                                                            \
      _Pragma("unroll") for (int i = 0; i < 2; i++)                                \
        _Pragma("unroll") for (int j = 0; j < 2; j++) acc[i][j] = MFMA32(a[i], b[j], acc[i][j]); \
    }                                                                              \
  }
  GLOAD(ra0, rb0, 0)
  GLOAD(ra1, rb1, 1)
  __syncthreads();
  SSTORE(ra0, rb0, 0)
  GLOAD(ra0, rb0, 2)
  __syncthreads();
#pragma unroll 1
  for (int kt = 0; kt < 16; kt += 2) {
    COMPUTE(0)
    SSTORE(ra1, rb1, 1)
    if (kt + 3 < 16) { GLOAD(ra1, rb1, kt + 3) }
    __syncthreads();
    COMPUTE(1)
    if (kt + 2 < 16) {
      SSTORE(ra0, rb0, 0)
      if (kt + 4 < 16) { GLOAD(ra0, rb0, kt + 4) }
    }
    __syncthreads();
  }
#undef GLOAD
#undef SSTORE
#undef COMPUTE
}

struct TileWalk { int start, stride, total; bool xl; int xcc; };
DI TileWalk tile_walk(const Params& p, int xcc, int rank, int ntiles) {
  TileWalk tw;
  bool all = true;
  int mine = 1;
#pragma unroll
  for (int j = 0; j < 8; j++) {
    const int cj = (int)p.census()[64 * j];
    all = all && (cj > 0);
    mine = (j == xcc) ? cj : mine;
  }
  tw.xl = all;
  tw.xcc = xcc;
  tw.start = all ? rank : (int)blockIdx.x;
  tw.stride = all ? mine : (int)gridDim.x;
  tw.total = all ? ntiles / 8 : ntiles;
  return tw;
}
DI void tile_of(const TileWalk& tw, int q, int nn, int& mt, int& nt) {
  if (tw.xl) {
    const int b2 = q >> 6, wi = q & 63;
    const int mi = wi & 7, ni = wi >> 3;
    const int mb = (b2 == 1 || b2 == 2 || b2 == 5) ? 1 : 0;
    const int nb = nn == 24 ? (b2 >> 1) : 0;
    mt = 16 * tw.xcc + 8 * mb + mi;
    nt = 8 * nb + ni;
  } else {
    nt = q % nn;
    mt = q / nn;
  }
}

DI void phase1b(const Params& p, char* smem, int tid, int xcc, int rank) {
  asm volatile("" : "+v"(tid));
  const int lane = tid & 63, w = tid >> 6, wm = w & 1, wn = w >> 1, r = lane & 31, h = lane >> 5;
  const TileWalk tw = tile_walk(p, xcc, rank, 128 * 24);
  for (int t = tw.start; t < tw.total; t += tw.stride) {
    int nt, mt;
    tile_of(tw, t, 24, mt, nt);
    const int m0 = mt * 128, n0 = nt * 128;
    const int b = m0 >> 11, s0 = m0 & 2047;
    const int seg = nt >> 2;
    f32x16 acc[2][2];
    if (seg == 2 || seg == 5) {
      gemm_mainloop(p.H(), p.WtIn(), m0, n0, smem, tid, acc);
      const int kind = seg == 2 ? 0 : 1;
      const int colbase = n0 - (seg == 2 ? 1024 : 2560);
#pragma unroll
      for (int i = 0; i < 2; i++)
#pragma unroll
        for (int j = 0; j < 2; j++) {
          int col = colbase + 64 * wn + 32 * j + r;
          u16* dst = p.Vt() + ((size_t)(kind * 8 + b) * 512 + col) * SEQ + s0 + 64 * wm + 32 * i + 4 * h;
#pragma unroll
          for (int g = 0; g < 4; g++) {
            uint2 o;
            o.x = pk2(acc[i][j][4 * g + 0], acc[i][j][4 * g + 1]);
            o.y = pk2(acc[i][j][4 * g + 2], acc[i][j][4 * g + 3]);
            *(uint2*)(dst + 8 * g) = o;
          }
        }
    } else {
      gemm_mainloop(p.WtIn(), p.H(), n0, m0, smem, tid, acc);
      const int kind = seg == 0 ? 0 : seg == 1 ? 1 : seg == 3 ? 2 : 3;
      if (seg == 1) {
        float mk = 0.f;
#pragma unroll
        for (int i = 0; i < 2; i++)
#pragma unroll
          for (int j = 0; j < 2; j++)
#pragma unroll
            for (int q = 0; q < 16; q++) mk = fmaxf(mk, fabsf(acc[i][j][q]));
        mk = wave_max(mk);
        if (lane == 0) atomicMax(&p.counters()[64 + b * 8 + ((n0 - 512 + 64 * wm) >> 6)], __float_as_uint(mk));
      }
      const int colbase = n0 - (seg == 0 ? 0 : seg == 1 ? 512 : seg == 3 ? 1536 : 2048);
      const bool rope = (seg >= 3);
      const float scale = (seg == 0 || seg == 3) ? 0.125f * LOG2E : 1.f;
#pragma unroll
      for (int j = 0; j < 2; j++) {
        const int s = s0 + 64 * wn + 32 * j + r;
        f32x4 cs = {1.f, 1.f, 1.f, 1.f}, sn = {0.f, 0.f, 0.f, 0.f};
        if (rope) {
          cs = *(const f32x4*)(p.rope() + s * 16 + 4 * h);
          sn = *(const f32x4*)(p.rope() + s * 16 + 8 + 4 * h);
        }
#pragma unroll
        for (int i = 0; i < 2; i++) {
          const int colt = colbase + 64 * wm + 32 * i;
          const int hc = colt >> 6, d0 = colt & 63;
          f32x16 v = acc[i][j];
          if (rope && i == 0) {
#pragma unroll
            for (int q = 0; q < 4; q++) {
              float t1 = v[q], t2 = v[q + 4];
              v[q] = t1 * cs[q] - t2 * sn[q];
              v[q + 4] = t2 * cs[q] + t1 * sn[q];
            }
          }
          u16* dst = p.QK() + (((size_t)(kind * 8 + b) * 8 + hc) * SEQ + s) * 64 + d0 + 4 * h;
#pragma unroll
          for (int g = 0; g < 4; g++) {
            uint2 o;
            o.x = pk2(v[4 * g + 0] * scale, v[4 * g + 1] * scale);
            o.y = pk2(v[4 * g + 2] * scale, v[4 * g + 3] * scale);
            *(uint2*)(dst + 8 * g) = o;
          }
        }
      }
    }
  }
}

template <int DV, bool HASF>
DI void attn_pass(const u16* __restrict__ Qg, const u16* __restrict__ Kg, const u16* __restrict__ Vtg,
                  const float* __restrict__ FLg, int q0, char* smem, int tid, f32x16 (&o)[DV / 32], float kmax = 0.f) {
  constexpr int NMB = DV / 32;
  constexpr int KSZ = 64 * 144;
  constexpr int VSZ = DV * 136;
  constexpr int STAGE = KSZ + VSZ + 256;
  constexpr int NVL = DV / 32;
  const int lane = tid & 63, w = tid >> 6, r = lane & 31, h = lane >> 5;
  const int qw0 = q0 + 32 * w;
  const int qcol = qw0 + r;
  const int nkt = (q0 + 128) >> 6;
  bf16x8 qf[4];
#pragma unroll
  for (int ks = 0; ks < 4; ks++) qf[ks] = *(const bf16x8*)(Qg + (size_t)qcol * 64 + 16 * ks + 8 * h);
#pragma unroll
  for (int mb = 0; mb < NMB; mb++)
#pragma unroll
    for (int q = 0; q < 16; q++) o[mb][q] = 0.f;
  float m_run = -INFINITY, lsum = 0.f;

  u32x4 rk[2], rv[NVL];
  f32x4 rf = {0.f, 0.f, 0.f, 0.f};
  auto gloadK = [&](int kt) {
    const int k0 = kt * 64;
#pragma unroll
    for (int i = 0; i < 2; i++) {
      int idx = tid + 256 * i;
      rk[i] = *(const u32x4*)(Kg + (size_t)(k0 + (idx >> 3)) * 64 + (idx & 7) * 8);
    }
    if (HASF) {
      if (tid < 16) rf = *(const f32x4*)(FLg + k0 + 4 * tid);
    }
  };
  auto gloadV = [&](int kt) {
    const int k0 = kt * 64;
#pragma unroll
    for (int i = 0; i < NVL; i++) {
      int idx = tid + 256 * i;
      rv[i] = *(const u32x4*)(Vtg + (size_t)(idx >> 3) * SEQ + k0 + (idx & 7) * 8);
    }
  };
  auto gload = [&](int kt) { gloadK(kt); gloadV(kt); };
  auto sstore = [&](int stage) {
    char* sK = smem + stage * STAGE;
    char* sV = sK + KSZ;
    float* sF = (float*)(sV + VSZ);
#pragma unroll
    for (int i = 0; i < 2; i++) {
      int idx = tid + 256 * i;
      int row = idx >> 3, c = idx & 7;
      *(u32x4*)(sK + row * 144 + (c << 4)) = rk[i];
    }
#pragma unroll
    for (int i = 0; i < NVL; i++) {
      int idx = tid + 256 * i;
      int row = idx >> 3, c = idx & 7;
      *(u32x2*)(sV + row * 136 + (c << 4)) = u32x2{rv[i].x, rv[i].y};
      *(u32x2*)(sV + row * 136 + (c << 4) + 8) = u32x2{rv[i].z, rv[i].w};
    }
    if (HASF) {
      if (tid < 16) *(f32x4*)(sF + 4 * tid) = rf;
    }
  };

  float qb = 0.f;
  bool done = false;
  if (HASF) {
#pragma unroll
    for (int ks = 0; ks < 4; ks++)
#pragma unroll
      for (int j = 0; j < 8; j++) {
        const unsigned short qs = (unsigned short)qf[ks][j];
        qb += fabsf(__uint_as_float(((unsigned)qs) << 16));
      }
    qb += __shfl_xor(qb, 32);
    qb *= kmax;
  }
  __syncthreads();
  gload(HASF ? nkt - 1 : 0);
  sstore(0);
  __syncthreads();
  for (int jt = 0; jt < nkt; jt++) {
    const int kt = HASF ? nkt - 1 - jt : jt;
    const int ktn = HASF ? kt - 1 : kt + 1;
    if (jt + 1 < nkt) { gloadK(ktn); gloadV(ktn); }
    if (HASF) {
      if (kt * 64 <= qw0 && !done) {
        const float flast = ((const float*)(smem + (jt & 1) * STAGE + KSZ + VSZ))[63];
        const bool keep = !(qb - flast < m_run - 40.f);
        if (__ballot(keep) == 0ull) done = true;
      }
    }
    if (kt * 64 <= qw0 && !done) {
      const char* sK = smem + (jt & 1) * STAGE;
      const char* sV = sK + KSZ;
      const float* sF = (const float*)(sV + VSZ);
      const char* sKl = sK + r * 144 + h * 16;
      const char* sVl = sV + r * 136 + h * 8;
      f32x16 s[2];
#pragma unroll
      for (int mt = 0; mt < 2; mt++) {
#pragma unroll
        for (int q = 0; q < 16; q++) s[mt][q] = 0.f;
#pragma unroll
        for (int ks = 0; ks < 4; ks++) {
          bf16x8 a = *(const bf16x8*)(sKl + mt * (32 * 144) + ks * 32);
          s[mt] = MFMA32(a, qf[ks], s[mt]);
        }
      }
      if (HASF) {
#pragma unroll
        for (int mt = 0; mt < 2; mt++)
#pragma unroll
          for (int g = 0; g < 4; g++) {
            float4 f = *(const float4*)(sF + 32 * mt + 8 * g + 4 * h);
            s[mt][4 * g + 0] -= f.x;
            s[mt][4 * g + 1] -= f.y;
            s[mt][4 * g + 2] -= f.z;
            s[mt][4 * g + 3] -= f.w;
          }
      }
      if (kt * 64 + 63 > qw0) {
#pragma unroll
        for (int mt = 0; mt < 2; mt++)
#pragma unroll
          for (int q = 0; q < 16; q++) {
            int key = kt * 64 + 32 * mt + (q & 3) + 8 * (q >> 2) + 4 * h;
            s[mt][q] = key > qcol ? -INFINITY : s[mt][q];
          }
      }
      float mx = s[0][0];
#pragma unroll
      for (int mt = 0; mt < 2; mt++)
#pragma unroll
        for (int q = 0; q < 16; q++) mx = fmaxf(mx, s[mt][q]);
      mx = fmaxf(mx, __builtin_bit_cast(float, __builtin_amdgcn_ds_bpermute((lane ^ 32) << 2, __builtin_bit_cast(int, mx))));
      const float m_new = fmaxf(m_run, mx);
      const float alpha = __builtin_amdgcn_exp2f(m_run - m_new);
      m_run = m_new;
      float ps = 0.f;
#pragma unroll
      for (int mt = 0; mt < 2; mt++)
#pragma unroll
        for (int q = 0; q < 16; q++) {
          float pv = __builtin_amdgcn_exp2f(s[mt][q] - m_new);
          s[mt][q] = pv;
          ps += pv;
        }
      lsum = lsum * alpha + ps;
#pragma unroll
      for (int mb = 0; mb < NMB; mb++)
#pragma unroll
        for (int q = 0; q < 16; q++) o[mb][q] *= alpha;
#pragma unroll
      for (int ks = 0; ks < 4; ks++) {
        const int mt = ks >> 1, q0r = 8 * (ks & 1);
        u32x4 pu;
        pu.x = pk2(s[mt][q0r + 0], s[mt][q0r + 1]);
        pu.y = pk2(s[mt][q0r + 2], s[mt][q0r + 3]);
        pu.z = pk2(s[mt][q0r + 4], s[mt][q0r + 5]);
        pu.w = pk2(s[mt][q0r + 6], s[mt][q0r + 7]);
        bf16x8 pb = __builtin_bit_cast(bf16x8, pu);
#pragma unroll
        for (int mb = 0; mb < NMB; mb++) {
          u32x2 lo = *(const u32x2*)(sVl + mb * (32 * 136) + ks * 32);
          u32x2 hi = *(const u32x2*)(sVl + mb * (32 * 136) + ks * 32 + 16);
          u32x4 au = {lo.x, lo.y, hi.x, hi.y};
          bf16x8 a = __builtin_bit_cast(bf16x8, au);
          o[mb] = MFMA32(a, pb, o[mb]);
        }
      }
    }
    if (jt + 1 < nkt) { sstore((jt + 1) & 1); }
    if (HASF) {
      if (!__syncthreads_or(done ? 0 : 1)) break;
    } else {
      __syncthreads();
    }
  }
  float l = lsum + __builtin_bit_cast(float, __builtin_amdgcn_ds_bpermute((lane ^ 32) << 2, __builtin_bit_cast(int, lsum)));
  const float inv = 1.f / l;
#pragma unroll
  for (int mb = 0; mb < NMB; mb++)
#pragma unroll
    for (int q = 0; q < 16; q++) o[mb][q] *= inv;
}

DI unsigned pack_i8x4(float a, float b, float c, float d) {
  const int q0 = (int)rintf(a), q1 = (int)rintf(b), q2 = (int)rintf(c), q3 = (int)rintf(d);
  return (unsigned)(q0 & 255) | ((unsigned)(q1 & 255) << 8) | ((unsigned)(q2 & 255) << 16) | ((unsigned)(q3 & 255) << 24);
}
DI void convert_chunk(const Params& p, int c, int tid) {
  const size_t ngroups = (size_t)16384 * 1024 / 16;
#pragma unroll 4
  for (int i = 0; i < 16; i++) {
    const size_t g = (size_t)c * 4096 + (size_t)i * NTHREADS + tid;
    const bool isu = g < ngroups;
    if (isu) {
      const float* src = p.u_exp + g * 16;
      float4 x[4];
      float mx = 0.f;
#pragma unroll
      for (int q = 0; q < 4; q++) {
        x[q] = *(const float4*)(src + 4 * q);
        mx = fmaxf(mx, fmaxf(fmaxf(fabsf(x[q].x), fabsf(x[q].y)), fmaxf(fabsf(x[q].z), fabsf(x[q].w))));
      }
      mx = wave_max(mx);
      const float inv = mx > 0.f ? 127.f / mx : 0.f;
      u32x4 v;
#pragma unroll
      for (int q = 0; q < 4; q++) v[q] = pack_i8x4(x[q].x * inv, x[q].y * inv, x[q].z * inv, x[q].w * inv);
      *(u32x4*)(p.Uq() + g * 16) = v;
      if ((tid & 63) == 0) p.su()[g >> 6] = mx * (1.f / 127.f);
    } else {
      const size_t gv = g - ngroups;
      const float* src = p.v_exp + gv * 16;
      const size_t e = gv >> 6, d = (gv & 63) * 16;
      unsigned char* dst = p.Vq() + (d >> 7) * ((size_t)16384 * 128) + e * 128 + (d & 127);
      u32x4 v;
#pragma unroll
      for (int q = 0; q < 4; q++) {
        float4 a = *(const float4*)(src + 4 * q);
        unsigned wv = 0;
        wv = __builtin_amdgcn_cvt_pk_fp8_f32(a.x * 8.f, a.y * 8.f, wv, false);
        wv = __builtin_amdgcn_cvt_pk_fp8_f32(a.z * 8.f, a.w * 8.f, wv, true);
        v[q] = wv;
      }
      *(u32x4*)dst = v;
    }
  }
}

DI void phase2(const Params& p, char* smem, int tid, int xl, int xcc) {
  asm volatile("" : "+v"(tid));
  const int lane = tid & 63, w = tid >> 6, r = lane & 31, h = lane >> 5;
  __shared__ int s_item;
  for (;;) {
    __syncthreads();
    if (tid == 0) s_item = (int)atomicAdd(&p.counters()[xl ? 256 + 64 * xcc : 0], 1u);
    __syncthreads();
    const int qi = s_item;
    if (qi >= (xl ? 256 : 2048)) break;
    if ((qi & 3) == 3) {
      convert_chunk(p, xl ? (qi >> 2) * 8 + xcc : (qi >> 2), tid);
      continue;
    }
    int item = (qi >> 2) * 3 + (qi & 3);
    int tid_i = threadIdx.x;
    asm volatile("" : "+v"(tid_i));
    if (xl) {
      const int li = item;
      if (li < 64) item = ((li >> 2) << 5) | (xcc << 2) | (li & 3);
      else { const int lf = li - 64; item = 512 + (((lf >> 3) << 6) | (xcc << 3) | (lf & 7)); }
    }
    if (item < 512) {
      const int qt = 15 - (item >> 5), bh = item & 31, b = bh >> 2, dh = bh & 3;
      const int q0 = qt * 128;
      const u16* Vtg = p.Vt() + ((size_t)(8 + b) * 512 + dh * 128) * SEQ;
      float* stash = p.stash() + ((size_t)blockIdx.x * NTHREADS + tid) * 64;
      f32x16 o[4];
#pragma unroll 1
      for (int c = 0; c < 2; c++) {
        const u16* Qg = p.QK() + ((size_t)(2 * 8 + b) * 8 + dh * 2 + c) * SEQ * 64;
        const u16* Kg = p.QK() + ((size_t)(3 * 8 + b) * 8 + dh * 2 + c) * SEQ * 64;
        attn_pass<128, false>(Qg, Kg, Vtg, nullptr, q0, smem, tid_i, o);
        if (c == 0) {
#pragma unroll
          for (int mb = 0; mb < 4; mb++)
#pragma unroll
            for (int q = 0; q < 4; q++)
              *(f32x4*)(stash + mb * 16 + q * 4) = f32x4{o[mb][4 * q], o[mb][4 * q + 1], o[mb][4 * q + 2], o[mb][4 * q + 3]};
        }
      }
      float d1 = 0.f, d2 = 0.f;
      for (int i = 0; i < 64; i++) {
        d1 += p.lq1[i] * p.lk1[i];
        d2 += p.lq2[i] * p.lk2[i];
      }
      const float lam = expf(d1) - expf(d2) + 0.2f;
      float ss = 0.f;
#pragma unroll
      for (int mb = 0; mb < 4; mb++)
#pragma unroll
        for (int q4 = 0; q4 < 4; q4++) {
          f32x4 sv = *(const f32x4*)(stash + mb * 16 + q4 * 4);
#pragma unroll
          for (int e = 0; e < 4; e++) {
            float a0 = sv[e] - lam * o[mb][4 * q4 + e];
            o[mb][4 * q4 + e] = a0;
            ss += a0 * a0;
          }
        }
      ss += __shfl_xor(ss, 32);
      const float rstd = rsqrtf(ss * (1.f / 128.f) + 1e-5f) * 0.8f;
      const int tok = b * SEQ + q0 + 32 * w + r;
#pragma unroll
      for (int mb = 0; mb < 4; mb++)
#pragma unroll
        for (int g = 0; g < 4; g++) {
          const int d = 32 * mb + 8 * g + 4 * h;
          float4 gs = *(const float4*)(p.g_subln + d);
          uint2 ov;
          ov.x = pk2(o[mb][4 * g + 0] * rstd * gs.x, o[mb][4 * g + 1] * rstd * gs.y);
          ov.y = pk2(o[mb][4 * g + 2] * rstd * gs.z, o[mb][4 * g + 3] * rstd * gs.w);
          *(uint2*)(p.H() + (size_t)tok * DM + 512 + dh * 128 + d) = ov;
        }
    } else {
      const int it = item - 512;
      const int qt = 15 - (it >> 6), bh = it & 63, b = bh >> 3, hd = bh & 7;
      const int q0 = qt * 128;
      const u16* Qg = p.QK() + ((size_t)(0 * 8 + b) * 8 + hd) * SEQ * 64;
      const u16* Kg = p.QK() + ((size_t)(1 * 8 + b) * 8 + hd) * SEQ * 64;
      const u16* Vtg = p.Vt() + ((size_t)(0 + b) * 512 + hd * 64) * SEQ;
      const float* FLg = p.FL() + (b * 8 + hd) * SEQ;
      f32x16 o[2];
      attn_pass<64, true>(Qg, Kg, Vtg, FLg, q0, smem, tid_i, o, __uint_as_float(p.counters()[64 + b * 8 + hd]) * 1.01f);
      const int tok = b * SEQ + q0 + 32 * w + r;
#pragma unroll
      for (int mb = 0; mb < 2; mb++)
#pragma unroll
        for (int g = 0; g < 4; g++) {
          const int d = 32 * mb + 8 * g + 4 * h;
          uint2 ov;
          ov.x = pk2(o[mb][4 * g + 0], o[mb][4 * g + 1]);
          ov.y = pk2(o[mb][4 * g + 2], o[mb][4 * g + 3]);
          *(uint2*)(p.H() + (size_t)tok * DM + hd * 64 + d) = ov;
        }
    }
  }
}

DI void phase3(const Params& p, char* smem, int tid, int xcc, int rank) {
  asm volatile("" : "+v"(tid));
  const int lane = tid & 63, w = tid >> 6, wm = w & 1, wn = w >> 1, r = lane & 31, h = lane >> 5;
  const TileWalk tw = tile_walk(p, xcc, rank, 128 * 8);
  for (int t = tw.start; t < tw.total; t += tw.stride) {
    int nt, mt;
    tile_of(tw, t, 8, mt, nt);
    const int m0 = mt * 128, n0 = nt * 128;
    const int b = m0 >> 11;
    f32x16 acc[2][2];
    gemm_mainloop(p.WtO(), p.H(), n0, m0, smem, tid, acc);
#pragma unroll
    for (int j = 0; j < 2; j++) {
      const int tok = m0 + 64 * wn + 32 * j + r;
#pragma unroll
      for (int i = 0; i < 2; i++)
#pragma unroll
        for (int g = 0; g < 4; g++) {
          const int n = n0 + 64 * wm + 32 * i + 8 * g + 4 * h;
          float4 xv = *(const float4*)(p.x + (size_t)tok * DM + n);
          float4 gt = *(const float4*)(p.mod() + b * 6144 + 2048 + n);
          float4 ov;
          ov.x = xv.x + gt.x * acc[i][j][4 * g + 0];
          ov.y = xv.y + gt.y * acc[i][j][4 * g + 1];
          ov.z = xv.z + gt.z * acc[i][j][4 * g + 2];
          ov.w = xv.w + gt.w * acc[i][j][4 * g + 3];
          *(float4*)(p.out + (size_t)tok * DM + n) = ov;
        }
    }
  }
}

DI void phase3b(const Params& p, int tid, int xl, int xcc, int rank, int cnt) {
  asm volatile("" : "+v"(tid));
  const int lane = tid & 63, w = tid >> 6;
  const int t_lo = xl ? 2048 * xcc + (rank * 4 + w) * 2 : (blockIdx.x * 4 + w) * 2;
  const int t_hi = xl ? 2048 * (xcc + 1) : T_TOK;
  const int t_st = xl ? cnt * 8 : gridDim.x * 8;
  for (int tok = t_lo; tok < t_hi; tok += t_st) {
    const int b = tok >> 11;
    const float* xr = p.out + (size_t)tok * DM;
    float4 xv[2][4];
    float ss[2] = {0.f, 0.f};
#pragma unroll
    for (int t = 0; t < 2; t++)
#pragma unroll
      for (int i = 0; i < 4; i++) xv[t][i] = *(const float4*)(xr + t * DM + 256 * i + 4 * lane);
#pragma unroll
    for (int t = 0; t < 2; t++)
#pragma unroll
      for (int i = 0; i < 4; i++)
        ss[t] += xv[t][i].x * xv[t][i].x + xv[t][i].y * xv[t][i].y + xv[t][i].z * xv[t][i].z + xv[t][i].w * xv[t][i].w;
    ss[0] = wave_sum(ss[0]);
    ss[1] = wave_sum(ss[1]);
    const float rstd0 = rsqrtf(ss[0] * (1.f / 1024.f) + 1e-6f);
    const float rstd1 = rsqrtf(ss[1] * (1.f / 1024.f) + 1e-6f);
    const float* md = p.mod() + b * 6144;
#pragma unroll
    for (int i = 0; i < 4; i++) {
      const int c0 = 256 * i + 4 * lane;
      float4 g = *(const float4*)(p.g_ffn + c0);
      float4 sh = *(const float4*)(md + 3072 + c0);
      float4 sc = *(const float4*)(md + 4096 + c0);
#pragma unroll
      for (int t = 0; t < 2; t++) {
        const float rstd = t ? rstd1 : rstd0;
        float4 hv;
        hv.x = xv[t][i].x * rstd * g.x * (1.f + sc.x) + sh.x;
        hv.y = xv[t][i].y * rstd * g.y * (1.f + sc.y) + sh.y;
        hv.z = xv[t][i].z * rstd * g.z * (1.f + sc.z) + sh.z;
        hv.w = xv[t][i].w * rstd * g.w * (1.f + sc.w) + sh.w;
        xv[t][i] = hv;
        uint2 o;
        o.x = pk2(hv.x, hv.y);
        o.y = pk2(hv.z, hv.w);
        *(uint2*)(p.H() + (size_t)(tok + t) * DM + c0) = o;
      }
    }
#pragma unroll
    for (int t = 0; t < 2; t++) {
      float mx = 0.f;
#pragma unroll
      for (int i = 0; i < 4; i++)
        mx = fmaxf(mx, fmaxf(fmaxf(fabsf(xv[t][i].x), fabsf(xv[t][i].y)), fmaxf(fabsf(xv[t][i].z), fabsf(xv[t][i].w))));
      mx = wave_max(mx);
      const float inv = mx > 0.f ? 127.f / mx : 0.f;
#pragma unroll
      for (int i = 0; i < 4; i++)
        *(unsigned*)(p.Hq() + (size_t)(tok + t) * DM + 256 * i + 4 * lane) =
            pack_i8x4(xv[t][i].x * inv, xv[t][i].y * inv, xv[t][i].z * inv, xv[t][i].w * inv);
      if (lane == 0) p.hs()[tok + t] = mx * (1.f / 127.f);
    }
  }
}

DI void phase4(const Params& p, char* smem, int tid, int xcc, int rank) {
  asm volatile("" : "+v"(tid));
  const int lane = tid & 63, w = tid >> 6, wm = w & 1, wn = w >> 1, r = lane & 31, h = lane >> 5;
  const TileWalk tw = tile_walk(p, xcc, rank, 128 * 8);
  for (int t = tw.start; t < tw.total; t += tw.stride) {
    int nt, mt;
    tile_of(tw, t, 8, mt, nt);
    const int m0 = mt * 128, n0 = nt * 128;
    f32x16 acc[2][2];
    gemm_mainloop(p.WtPq(), p.H(), n0, m0, smem, tid, acc);
#pragma unroll
    for (int j = 0; j < 2; j++) {
      const int tok = m0 + 64 * wn + 32 * j + r;
#pragma unroll
      for (int i = 0; i < 2; i++)
#pragma unroll
        for (int g = 0; g < 4; g++) {
          const int n = n0 + 64 * wm + 32 * i + 8 * g + 4 * h;
          uint2 o;
          o.x = pk2(acc[i][j][4 * g + 0], acc[i][j][4 * g + 1]);
          o.y = pk2(acc[i][j][4 * g + 2], acc[i][j][4 * g + 3]);
          *(uint2*)(p.Qp() + (size_t)tok * DM + n) = o;
        }
    }
  }
}

template <int N>
struct TR {
  static DI float run(float (&part)[N], int lane) {
    constexpr int H = N / 2;
    float nxt[H];
    const bool up = (lane & H) != 0;
#pragma unroll
    for (int i = 0; i < H; i++) {
      float keep = up ? part[i + H] : part[i];
      float send = up ? part[i] : part[i + H];
      nxt[i] = keep + __shfl_xor(send, H);
    }
    return TR<H>::run(nxt, lane);
  }
};
template <>
struct TR<1> {
  static DI float run(float (&part)[1], int) { return part[0]; }
};


#define DPPF(v, ctrl) __builtin_bit_cast(float, __builtin_amdgcn_mov_dpp(__builtin_bit_cast(int, (v)), (ctrl), 0xf, 0xf, true))
DI float swz_xor16(float v) { return __builtin_bit_cast(float, __builtin_amdgcn_ds_swizzle(__builtin_bit_cast(int, v), (16 << 10) | 0x1f)); }
DI int bperm_xor32_i(int v, int lane) { return __builtin_amdgcn_ds_bpermute((lane ^ 32) << 2, v); }
DI float bperm_xor32(float v, int lane) { return __builtin_bit_cast(float, __builtin_amdgcn_ds_bpermute((lane ^ 32) << 2, __builtin_bit_cast(int, v))); }
DI float wave_sum_dpp(float v, int lane) {
  v += DPPF(v, 0xB1);
  v += DPPF(v, 0x4E);
  v += DPPF(v, 0x141);
  v += DPPF(v, 0x140);
  v += swz_xor16(v);
  v += bperm_xor32(v, lane);
  return v;
}
DI float tr16_dpp(const float (&part)[16], int lane) {
  float n8[8], n4[4], n2[2];
  {
    const bool up = (lane & 8) != 0;
#pragma unroll
    for (int i = 0; i < 8; i++) {
      float keep = up ? part[i + 8] : part[i];
      float send = up ? part[i] : part[i + 8];
      n8[i] = keep + DPPF(send, 0x140);
    }
  }
  {
    const bool up = (lane & 4) != 0;
#pragma unroll
    for (int i = 0; i < 4; i++) {
      float keep = up ? n8[i + 4] : n8[i];
      float send = up ? n8[i] : n8[i + 4];
      n4[i] = keep + DPPF(send, 0x141);
    }
  }
  {
    const bool up = (lane & 2) != 0;
#pragma unroll
    for (int i = 0; i < 2; i++) {
      float keep = up ? n4[i + 2] : n4[i];
      float send = up ? n4[i] : n4[i + 2];
      n2[i] = keep + DPPF(send, 0x1B);
    }
  }
  const bool up = (lane & 1) != 0;
  float keep = up ? n2[1] : n2[0];
  float send = up ? n2[0] : n2[1];
  return keep + DPPF(send, 0xB1);
}

DI int f2key(float f) { int b = __float_as_int(f); return b ^ ((b >> 31) & 0x7fffffff); }
DI float key2f(int k) { return __int_as_float(k ^ ((k >> 31) & 0x7fffffff)); }
DI void insert16(int (&L)[16], int x) {
#pragma unroll
  for (int k = 0; k < 16; k++) {
    int t = max(L[k], x);
    x = min(L[k], x);
    L[k] = t;
  }
}
DI void bitonic_sort16(int (&L)[16]) {
#pragma unroll
  for (int s = 8; s >= 1; s >>= 1)
#pragma unroll
    for (int i = 0; i < 16; i++)
      if ((i & s) == 0) {
        int x = L[i], y = L[i + s];
        L[i] = max(x, y);
        L[i + s] = min(x, y);
      }
}
DI void bitonic_full16(int (&L)[16]) {
#pragma unroll
  for (int k = 2; k <= 16; k <<= 1)
#pragma unroll
    for (int j = k >> 1; j > 0; j >>= 1)
#pragma unroll
      for (int i = 0; i < 16; i++) {
        const int l = i ^ j;
        if (l > i) {
          const int x = L[i], y = L[l];
          if ((i & k) == 0) { L[i] = max(x, y); L[l] = min(x, y); }
          else { L[i] = min(x, y); L[l] = max(x, y); }
        }
      }
}
DI int lookup_byte(int p0, int p1, int p2, int p3, int i) {
  int d = i < 8 ? (i < 4 ? p0 : p1) : (i < 12 ? p2 : p3);
  return (d >> ((i & 3) * 8)) & 255;
}
constexpr int CAND_I[50] = {0,0,0,0,0,0,0,0,0,0,0,0,0,0,0,0,1,1,1,1,1,1,1,1,2,2,2,2,2,3,3,3,3,4,4,4,5,5,6,6,7,7,8,9,10,11,12,13,14,15};
constexpr int CAND_J[50] = {0,1,2,3,4,5,6,7,8,9,10,11,12,13,14,15,0,1,2,3,4,5,6,7,0,1,2,3,4,0,1,2,3,0,1,2,0,1,0,1,0,1,0,0,0,0,0,0,0,0};

DI void phase5(const Params& p, char* smem, int tid, int xl, int xcc, int rank, int cnt) {
  asm volatile("" : "+v"(tid));
  const int lane_outer = tid & 63, w = tid >> 6;
  char* skl = smem;
  int* El = (int*)(smem + 36864 + w * 4096);
  float* Gl = (float*)(El + 512);
  __syncthreads();
  for (int i = tid; i < 2 * 128 * 8; i += NTHREADS) {
    const int row = i >> 3, ch = i & 7;
    const float* src = p.sub_keys + (size_t)row * 64 + ch * 8;
    float4 a = *(const float4*)src, b = *(const float4*)(src + 4);
    u32x4 u = {pk2(a.x, a.y), pk2(a.z, a.w), pk2(b.x, b.y), pk2(b.z, b.w)};
    *(u32x4*)(skl + row * 144 + ch * 16) = u;
  }
  __syncthreads();
  const int IMIN = (int)0x80000000;
  const int g_lo = xl ? 512 * xcc + rank * 4 + w : blockIdx.x * 4 + w;
  const int g_hi = xl ? 512 * (xcc + 1) : T_TOK / 4;
  const int g_st = xl ? cnt * 4 : gridDim.x * 4;
  for (int grp = g_lo; grp < g_hi; grp += g_st) {
    const int tok0 = grp * 4;
    int lane_s1 = lane_outer;
    asm volatile("" : "+v"(lane_s1));
    {
    const int lane = lane_s1, r = lane & 31, h = lane >> 5;
    (void)lane;
    int LA[16], LB[16];
    {
      const int tl = r >> 3, hd = r & 7;
      const u16* qsrc = p.Qp() + (size_t)(tok0 + tl) * DM + hd * 128 + 8 * h;
#pragma unroll
      for (int c = 0; c < 2; c++) {
        bf16x8 qb[4];
#pragma unroll
        for (int ks = 0; ks < 4; ks++) qb[ks] = *(const bf16x8*)(qsrc + c * 64 + 16 * ks);
        int L[16];
#pragma unroll
        for (int k = 0; k < 16; k++) L[k] = IMIN;
#pragma unroll
        for (int mt = 0; mt < 4; mt++) {
          f32x16 sc;
#pragma unroll
          for (int q = 0; q < 16; q++) sc[q] = 0.f;
#pragma unroll
          for (int ks = 0; ks < 4; ks++) {
            bf16x8 ska = *(const bf16x8*)(skl + (c * 128 + 32 * mt + r) * 144 + ks * 32 + h * 16);
            sc = MFMA32(ska, qb[ks], sc);
          }
          int T[16];
#pragma unroll
          for (int q = 0; q < 16; q++) {
            const int pay = 32 * mt + (q & 3) + 8 * (q >> 2);
            T[q] = (f2key(sc[q]) & ~127) | pay;
          }
          bitonic_full16(T);
          if (mt == 0) {
#pragma unroll
            for (int k = 0; k < 16; k++) L[k] = T[k];
          } else {
#pragma unroll
            for (int k = 0; k < 16; k++) L[k] = max(L[k], T[15 - k]);
            bitonic_sort16(L);
          }
        }
#pragma unroll
        for (int k = 0; k < 16; k++) {
          if (c == 0) LA[k] = L[k] | (h << 2); else LB[k] = L[k] | (h << 2);
        }
      }
    }
    int M[16];
    {
      int recv[16];
#pragma unroll
      for (int k = 0; k < 16; k++) {
        int send = h ? LA[k] : LB[k];
        recv[k] = bperm_xor32_i(send, lane);
      }
#pragma unroll
      for (int k = 0; k < 16; k++) {
        int mine = h ? LB[k] : LA[k];
        M[k] = max(mine, recv[15 - k]);
      }
      bitonic_sort16(M);
    }
    int pa0, pa1, pa2, pa3, pb0, pb1, pb2, pb3;
    int F[16];
    {
      float av[16], bv[16];
      int ai[16], bi[16];
#pragma unroll
      for (int k = 0; k < 16; k++) {
        int o = bperm_xor32_i(M[k], lane);
        int ka = h ? o : M[k];
        int kb = h ? M[k] : o;
        av[k] = key2f(ka);
        bv[k] = key2f(kb);
        ai[k] = ka & 127;
        bi[k] = kb & 127;
      }
      pa0 = ai[0] | (ai[1] << 8) | (ai[2] << 16) | (ai[3] << 24);
      pa1 = ai[4] | (ai[5] << 8) | (ai[6] << 16) | (ai[7] << 24);
      pa2 = ai[8] | (ai[9] << 8) | (ai[10] << 16) | (ai[11] << 24);
      pa3 = ai[12] | (ai[13] << 8) | (ai[14] << 16) | (ai[15] << 24);
      pb0 = bi[0] | (bi[1] << 8) | (bi[2] << 16) | (bi[3] << 24);
      pb1 = bi[4] | (bi[5] << 8) | (bi[6] << 16) | (bi[7] << 24);
      pb2 = bi[8] | (bi[9] << 8) | (bi[10] << 16) | (bi[11] << 24);
      pb3 = bi[12] | (bi[13] << 8) | (bi[14] << 16) | (bi[15] << 24);
      int T1[16], T2[16];
#pragma unroll
      for (int k = 0; k < 16; k++) T2[k] = IMIN;
#pragma unroll
      for (int m = 0; m < 25; m++) {
        const int i0 = CAND_I[2 * m], j0 = CAND_J[2 * m], i1 = CAND_I[2 * m + 1], j1 = CAND_J[2 * m + 1];
        float s0 = av[i0] + bv[j0], s1 = av[i1] + bv[j1];
        float s = h ? s1 : s0;
        int pay = h ? ((i1 << 4) | j1) : ((i0 << 4) | j0);
        int key = (f2key(s) & ~255) | pay;
        if (m < 16) T1[m] = key; else T2[m - 16] = key;
      }
      bitonic_full16(T1);
      bitonic_full16(T2);
      int L[16];
#pragma unroll
      for (int k = 0; k < 16; k++) L[k] = max(T1[k], T2[15 - k]);
      bitonic_sort16(L);
#pragma unroll
      for (int k = 0; k < 16; k++) {
        int o = bperm_xor32_i(L[15 - k], lane);
        F[k] = max(L[k], o);
      }
    }
    {
      int mk = F[0];
#pragma unroll
      for (int k = 1; k < 16; k++) mk = max(mk, F[k]);
      const float mx = key2f(mk);
      float ex[8];
      float sm = 0.f;
#pragma unroll
      for (int k = 0; k < 8; k++) {
        ex[k] = __expf(key2f(F[k]) - mx);
        sm += ex[k];
      }
      sm += bperm_xor32(sm, lane);
      const float inv = 1.f / sm;
      int ev[8];
#pragma unroll
      for (int k = 0; k < 8; k++) {
        const int pay = F[k] & 255;
        ev[k] = lookup_byte(pa0, pa1, pa2, pa3, pay >> 4) * 128 + lookup_byte(pb0, pb1, pb2, pb3, pay & 15);
        ex[k] *= inv;
      }
      const int tokc = tok0 + (r >> 3);
      int* ed = p.E() + (size_t)tokc * 128 + (r & 7) * 16 + 8 * h;
      float* gd = p.G() + (size_t)tokc * 128 + (r & 7) * 16 + 8 * h;
      *(u32x4*)ed = u32x4{(unsigned)ev[0], (unsigned)ev[1], (unsigned)ev[2], (unsigned)ev[3]};
      *(u32x4*)(ed + 4) = u32x4{(unsigned)ev[4], (unsigned)ev[5], (unsigned)ev[6], (unsigned)ev[7]};
      *(f32x4*)gd = f32x4{ex[0], ex[1], ex[2], ex[3]};
      *(f32x4*)(gd + 4) = f32x4{ex[4], ex[5], ex[6], ex[7]};
    }
    }
  }
}

DI unsigned my_xcc_id() { return (unsigned)__builtin_amdgcn_s_getreg((3 << 11) | 20) & 7u; }
DI int mbcnt64(unsigned long long m) { return (int)__builtin_amdgcn_mbcnt_hi((unsigned)(m >> 32), __builtin_amdgcn_mbcnt_lo((unsigned)m, 0u)); }
DI float swz_xor8(float v) { return __builtin_bit_cast(float, __builtin_amdgcn_ds_swizzle(__builtin_bit_cast(int, v), (8 << 10) | 0x1f)); }

#define DPPI(v, ctrl) __builtin_amdgcn_mov_dpp((v), (ctrl), 0xf, 0xf, true)
DI int tr16_dpp_i(const int (&part)[16], int lane) {
  int n8[8], n4[4], n2[2];
  {
    const bool up = (lane & 8) != 0;
#pragma unroll
    for (int i = 0; i < 8; i++) {
      int keep = up ? part[i + 8] : part[i];
      int send = up ? part[i] : part[i + 8];
      n8[i] = keep + DPPI(send, 0x140);
    }
  }
  {
    const bool up = (lane & 4) != 0;
#pragma unroll
    for (int i = 0; i < 4; i++) {
      int keep = up ? n8[i + 4] : n8[i];
      int send = up ? n8[i] : n8[i + 4];
      n4[i] = keep + DPPI(send, 0x141);
    }
  }
  {
    const bool up = (lane & 2) != 0;
#pragma unroll
    for (int i = 0; i < 2; i++) {
      int keep = up ? n4[i + 2] : n4[i];
      int send = up ? n4[i] : n4[i + 2];
      n2[i] = keep + DPPI(send, 0x1B);
    }
  }
  const bool up = (lane & 1) != 0;
  int keep = up ? n2[1] : n2[0];
  int send = up ? n2[0] : n2[1];
  return keep + DPPI(send, 0xB1);
}
DI float erf_as(float x) {
  const float ax = fabsf(x);
  const float t = __builtin_amdgcn_rcpf(1.f + 0.3275911f * ax);
  float poly = 1.061405429f;
  poly = poly * t - 1.453152027f;
  poly = poly * t + 1.421413741f;
  poly = poly * t - 0.284496736f;
  poly = poly * t + 0.254829592f;
  poly *= t;
  const float e = __builtin_amdgcn_exp2f(-ax * ax * 1.4426950408889634f);
  const float r = 1.f - poly * e;
  return copysignf(r, x);
}
DI void phase6u(const Params& p, char* smem, int tid, int s_xcc, int s_rank) {
  asm volatile("" : "+v"(tid));
  const int lane = tid & 63, w = tid >> 6;
  char* wb = smem + w * 10496;
  int* lstE = (int*)wb;
  int* lstG = lstE + 512;
  int* lstS = lstG + 512;
  char* h8 = wb + 6144;
  float* hsc = (float*)(wb + 10240);
  const int xcc = s_xcc, rank = s_rank;
  __syncthreads();
#pragma unroll 1
  for (int so = 0; so < 8; so++) {
    const int s = (xcc + so) & 7;
    int start, stride;
    const int cs = (int)p.census()[64 * s];
    if (so == 0) { start = rank * 4 + w; stride = cs * 4; }
    else if (cs == 0) { start = blockIdx.x * 4 + w; stride = gridDim.x * 4; }
    else continue;
#pragma unroll 1
    for (int item = start; item < T_TOK / 4; item += stride) {
      const int tokb = item * 4;
      int e0[4], e1[4];
      float g0[4], g1[4];
      u32x4 hA[4];
      float hsv[4];
#pragma unroll
      for (int tt = 0; tt < 4; tt++) {
        const size_t tok = (size_t)(tokb + tt);
        e0[tt] = p.E()[tok * 128 + lane];
        e1[tt] = p.E()[tok * 128 + 64 + lane];
        g0[tt] = p.G()[tok * 128 + lane];
        g1[tt] = p.G()[tok * 128 + 64 + lane];
        hA[tt] = *(const u32x4*)(p.Hq() + tok * DM + 16 * lane);
        hsv[tt] = p.hs()[tok];
      }
      int n_0 = 0, n_1 = 0, n_2 = 0, n_3 = 0;
#pragma unroll
      for (int tt = 0; tt < 4; tt++) {
        const bool m0 = (e0[tt] >> 11) == s, m1 = (e1[tt] >> 11) == s;
        const unsigned long long b0 = __ballot(m0), b1 = __ballot(m1);
        const int c0 = __popcll(b0), n = c0 + __popcll(b1);
        const int pos0 = mbcnt64(b0), pos1 = c0 + mbcnt64(b1);
        if (m0) { lstE[tt * 128 + pos0] = e0[tt]; lstG[tt * 128 + pos0] = __float_as_int(g0[tt]); lstS[tt * 128 + pos0] = lane; }
        if (m1) { lstE[tt * 128 + pos1] = e1[tt]; lstG[tt * 128 + pos1] = __float_as_int(g1[tt]); lstS[tt * 128 + pos1] = lane + 64; }
        *(u32x4*)(h8 + tt * 1024 + 16 * lane) = hA[tt];
        if (lane == 0) hsc[tt] = hsv[tt];
        if (tt == 0) n_0 = n; else if (tt == 1) n_1 = n; else if (tt == 2) n_2 = n; else n_3 = n;
      }
#define NOF(T) ((T) == 0 ? n_0 : (T) == 1 ? n_1 : (T) == 2 ? n_2 : n_3)
#define U_ISSUE(BUF, LE, LG, LS, LU, TT, BASE)                                               \
  {                                                                                          \
    const int nn_ = NOF(TT);                                                                 \
    const int li_ = (TT) * 128 + min((BASE) + (lane & 15), nn_ - 1);                         \
    LE = lstE[li_];                                                                          \
    LG = __int_as_float(lstG[li_]);                                                          \
    LS = lstS[li_];                                                                          \
    LU = p.su()[LE];                                                                         \
    _Pragma("unroll") for (int k = 0; k < 16; k++) {                                         \
      const int e_ = __builtin_amdgcn_readlane(LE, k);     \
      BUF[k] = *(const u32x4*)(p.Uq() + (size_t)e_ * DM + 16 * lane);                        \
    }                                                                                        \
    __builtin_amdgcn_sched_barrier(0);                                                       \
  }
#define U_COMPUTE(BUF, LG, LS, LU, TT, BASE)                                                 \
  {                                                                                          \
    const int nn_ = NOF(TT);                                                                 \
    const u32x4 hq = *(const u32x4*)(h8 + (TT) * 1024 + 16 * lane);                          \
    const float hs_ = hsc[TT];                                                               \
    int part[16];                                                                            \
    _Pragma("unroll") for (int k = 0; k < 16; k++) {                                         \
      int a = 0;     \
      _Pragma("unroll") for (int q = 0; q < 4; q++) {                                        \
        const int x = (int)BUF[k][q];                                                        \
        const int hh = (int)hq[q];                                                           \
        a = __builtin_amdgcn_sdot4(x, hh, a, false);                                         \
      }                                                                                      \
      part[k] = a;                                                                           \
    }                                                                                        \
    int ai_ = tr16_dpp_i(part, lane);                                                        \
    ai_ += __builtin_amdgcn_ds_swizzle(ai_, (16 << 10) | 0x1f);                              \
    ai_ += bperm_xor32_i(ai_, lane);                                                         \
    const float av = (float)ai_ * (LU * hs_);                                                \
    const float wv = 0.5f * av * (1.f + erf_as(av * 0.70710678118654752f)) * LG * 0.125f;    \
    if (lane < 16 && (BASE) + lane < nn_) p.W()[(size_t)(tokb + (TT)) * 128 + LS] = wv;      \
  }
#define U_NEXT(T2, B2, T1, B1)                                                               \
  {                                                                                          \
    T2 = T1; B2 = (B1) + 16;                                                                 \
    if (B2 >= NOF(T2)) { B2 = 0; do { T2++; } while (T2 < 4 && NOF(T2) == 0); }              \
  }
      {
        u32x4 bufA[16], bufB[16];
        int leA, lsA, leB, lsB;
        float lgA, lgB, luA, luB;
        int tA = 0, bA = 0, tB, bB;
        while (tA < 4 && NOF(tA) == 0) tA++;
        if (tA < 4) {
          U_ISSUE(bufA, leA, lgA, lsA, luA, tA, bA)
#pragma unroll 1
          for (;;) {
            U_NEXT(tB, bB, tA, bA)
            if (tB < 4) U_ISSUE(bufB, leB, lgB, lsB, luB, tB, bB)
            U_COMPUTE(bufA, lgA, lsA, luA, tA, bA)
            if (tB >= 4) break;
            U_NEXT(tA, bA, tB, bB)
            if (tA < 4) U_ISSUE(bufA, leA, lgA, lsA, luA, tA, bA)
            U_COMPUTE(bufB, lgB, lsB, luB, tB, bB)
            if (tA >= 4) break;
          }
        }
      }
#undef NOF
#undef U_ISSUE
#undef U_COMPUTE
#undef U_NEXT
    }
  }
}

DI void phase7v(const Params& p, char* smem, int tid, int s_xcc, int s_rank) {
  asm volatile("" : "+v"(tid));
  const int lane = tid & 63, w = tid >> 6;
  const int hp = lane >> 3, c = lane & 7;
  char* wb = smem + w * 8192;
  int* El = (int*)wb;
  float* Wl = (float*)(wb + 2048);
  float* Xl = (float*)(wb + 4096);
  float* Gt = (float*)(wb + 6144);
  const int xcc = s_xcc, rank = s_rank;
  __syncthreads();
#pragma unroll 1
  for (int so = 0; so < 8; so++) {
    const int s = (xcc + so) & 7;
    int start, stride;
    const int cs = (int)p.census()[64 * s];
    if (so == 0) { start = rank * 4 + w; stride = cs * 4; }
    else if (cs == 0) { start = blockIdx.x * 4 + w; stride = gridDim.x * 4; }
    else continue;
    const unsigned char* vs = p.Vq() + (size_t)s * ((size_t)16384 * 128) + 16 * c;
#pragma unroll 1
    for (int item = start; item < T_TOK / 4; item += stride) {
      const int tokb = item * 4;
      const int b = tokb >> 11;
      {
        int ea[4], eb[4];
        float wa[4], wb2[4];
        f32x2_t xa[4];
#pragma unroll
        for (int tt = 0; tt < 4; tt++) {
          const size_t tok = (size_t)(tokb + tt);
          ea[tt] = p.E()[tok * 128 + lane];
          eb[tt] = p.E()[tok * 128 + 64 + lane];
          wa[tt] = p.W()[tok * 128 + lane];
          wb2[tt] = p.W()[tok * 128 + 64 + lane];
          xa[tt] = *(const f32x2_t*)(p.out + tok * DM + 128 * s + 2 * lane);
        }
        const f32x2_t gt = *(const f32x2_t*)(p.mod() + b * 6144 + 5120 + 128 * s + 2 * lane);
#pragma unroll
        for (int tt = 0; tt < 4; tt++) {
          El[tt * 128 + lane] = ea[tt];
          El[tt * 128 + 64 + lane] = eb[tt];
          Wl[tt * 128 + lane] = wa[tt];
          Wl[tt * 128 + 64 + lane] = wb2[tt];
          *(f32x2_t*)(Xl + tt * 128 + 2 * lane) = xa[tt];
        }
        *(f32x2_t*)(Gt + 2 * lane) = gt;
      }
#pragma unroll 1
      for (int tt = 0; tt < 4; tt++) {
        const int tok = tokb + tt;
        u32x4 ee[4];
        f32x4 ww[4];
#pragma unroll
        for (int q = 0; q < 4; q++) {
          ee[q] = *(const u32x4*)(El + tt * 128 + hp * 16 + 4 * q);
          ww[q] = *(const f32x4*)(Wl + tt * 128 + hp * 16 + 4 * q);
        }
        u32x4 vv[16];
#pragma unroll
        for (int i = 0; i < 16; i++) {
          const unsigned e = ee[i >> 2][i & 3];
          vv[i] = *(const u32x4*)(vs + (size_t)e * 128);
        }
        float acc[16];
#pragma unroll
        for (int j = 0; j < 16; j++) acc[j] = 0.f;
#pragma unroll
        for (int i = 0; i < 16; i++) {
          const float wj = ww[i >> 2][i & 3];
#pragma unroll
          for (int q = 0; q < 4; q++) {
            const unsigned x = vv[i][q];
            f32x2_t lo = __builtin_amdgcn_cvt_pk_f32_fp8(x, false);
            f32x2_t hi = __builtin_amdgcn_cvt_pk_f32_fp8(x, true);
            acc[4 * q + 0] += wj * lo.x;
            acc[4 * q + 1] += wj * lo.y;
            acc[4 * q + 2] += wj * hi.x;
            acc[4 * q + 3] += wj * hi.y;
          }
        }
        float a8[8], a4[4], a2[2];
        {
          const bool up = (lane & 32) != 0;
#pragma unroll
          for (int i = 0; i < 8; i++) {
            const float keep = up ? acc[i + 8] : acc[i];
            const float send = up ? acc[i] : acc[i + 8];
            a8[i] = keep + bperm_xor32(send, lane);
          }
        }
        {
          const bool up = (lane & 16) != 0;
#pragma unroll
          for (int i = 0; i < 4; i++) {
            const float keep = up ? a8[i + 4] : a8[i];
            const float send = up ? a8[i] : a8[i + 4];
            a4[i] = keep + swz_xor16(send);
          }
        }
        {
          const bool up = (lane & 8) != 0;
#pragma unroll
          for (int i = 0; i < 2; i++) {
            const float keep = up ? a4[i + 2] : a4[i];
            const float send = up ? a4[i] : a4[i + 2];
            a2[i] = keep + DPPF(send, 0x128);
          }
        }
        {
          const int col = 16 * c + 2 * hp;
          const f32x2_t xv = *(const f32x2_t*)(Xl + tt * 128 + col);
          const f32x2_t gtv = *(const f32x2_t*)(Gt + col);
          f32x2_t ov;
          ov.x = xv.x + gtv.x * a2[0];
          ov.y = xv.y + gtv.y * a2[1];
          *(f32x2_t*)(p.out + (size_t)tok * DM + 128 * s + col) = ov;
        }
      }
    }
  }
}

DI void phase8(const Params& p, int tid) {
  asm volatile("" : "+v"(tid));
  const int lane = tid & 63, w = tid >> 6;
  for (int tok = (blockIdx.x * 4 + w) * 4; tok < T_TOK; tok += gridDim.x * 16) {
    float* xr = p.out + (size_t)tok * DM;
    float4 xv[4][4];
#pragma unroll
    for (int t = 0; t < 4; t++)
#pragma unroll
      for (int i = 0; i < 4; i++) xv[t][i] = *(const float4*)(xr + t * DM + 256 * i + 4 * lane);
    float rs[4];
#pragma unroll
    for (int t = 0; t < 4; t++) {
      float ss = 0.f;
#pragma unroll
      for (int i = 0; i < 4; i++)
        ss += xv[t][i].x * xv[t][i].x + xv[t][i].y * xv[t][i].y + xv[t][i].z * xv[t][i].z + xv[t][i].w * xv[t][i].w;
      ss = wave_sum(ss);
      rs[t] = rsqrtf(ss * (1.f / 1024.f) + 1e-6f);
    }
#pragma unroll
    for (int i = 0; i < 4; i++) {
      const int c0 = 256 * i + 4 * lane;
      float4 g = *(const float4*)(p.g_final + c0);
#pragma unroll
      for (int t = 0; t < 4; t++)
        *(float4*)(xr + t * DM + c0) = make_float4(xv[t][i].x * rs[t] * g.x, xv[t][i].y * rs[t] * g.y, xv[t][i].z * rs[t] * g.z, xv[t][i].w * rs[t] * g.w);
    }
  }
}

#define XB_TMO      128
#define XB_XCNT(j)  (256  + 64 * (j))
#define XB_XSUB(j)  (1280 + 64 * (j))
#define XB_XGEN(j)  (2304 + 64 * (j))
#define XB_TOP      3328
#define XB_TOPGEN   3392
#define XCD_BAR_WORDS 3456
#define XB_SPIN_CAP (1u << 18)
#define LAS __attribute__((address_space(3)))

__device__ __forceinline__ unsigned xb_ld(unsigned* p)              { return __hip_atomic_load(p, __ATOMIC_RELAXED, __HIP_MEMORY_SCOPE_AGENT); }
__device__ __forceinline__ unsigned xb_add(unsigned* p, unsigned v) { return __hip_atomic_fetch_add(p, v, __ATOMIC_RELAXED, __HIP_MEMORY_SCOPE_AGENT); }
__device__ __forceinline__ unsigned xb_xcc_id() { return (unsigned)__builtin_amdgcn_s_getreg((3 << 11) | 20) & 0xFu; }
#define XB_SPIN(cond, bar) do { unsigned _sp = 0; while (cond) { __builtin_amdgcn_s_sleep(1); \
    if ((++_sp & 255u) == 0u) { if (xb_ld(&(bar)[XB_TMO])) break; if (_sp > XB_SPIN_CAP) { atomicAdd(&(bar)[XB_TMO], 1u); break; } } } } while (0)

struct XcdBarrier {
    unsigned* bar; unsigned x;
    volatile LAS unsigned* st;
};

__device__ __forceinline__ XcdBarrier xcd_barrier_post(unsigned* bar, volatile LAS unsigned* st) {
    XcdBarrier b; b.bar = bar; b.x = xb_xcc_id(); b.st = st;
    if (threadIdx.x == 0) (void)xb_add(&bar[XB_XCNT(b.x)], 1u);
    return b;
}
__device__ __forceinline__ void xcd_barrier_complete(unsigned* bar, unsigned x, unsigned& nloc, unsigned& nx) {
    const unsigned G = gridDim.x * gridDim.y * gridDim.z;
    unsigned sum, cnt, mine, sp = 0u;
    for (;;) {
        sum = 0u; cnt = 0u; mine = 0u;
#pragma unroll
        for (unsigned j = 0; j < 16; ++j) { const unsigned c = xb_ld(&bar[XB_XCNT(j)]); sum += c; cnt += (c > 0u) ? 1u : 0u; mine = (j == x) ? c : mine; }
        if (sum == G) break;
        __builtin_amdgcn_s_sleep(1);
        if ((++sp & 255u) == 0u) { if (xb_ld(&bar[XB_TMO])) break; if (sp > XB_SPIN_CAP) { atomicAdd(&bar[XB_TMO], 1u); break; } }
    }
    nloc = mine > 0u ? mine : 1u; nx = cnt > 0u ? cnt : 1u;
}

__device__ __forceinline__ void xcd_barrier(const XcdBarrier& b) {
    asm volatile("s_waitcnt vmcnt(0)" ::: "memory");
    __syncthreads();
    if (threadIdx.x == 0) {
        unsigned* bar = b.bar;
        __builtin_amdgcn_s_waitcnt(0);
        unsigned nloc = b.st[0], nx = b.st[1];
        if (nloc == 0u) { xcd_barrier_complete(bar, b.x, nloc, nx); b.st[0] = nloc; b.st[1] = nx; }
        const unsigned old = xb_add(&bar[XB_XSUB(b.x)], 1u);
        const unsigned gen = old / nloc;
        if (old + 1u == (gen + 1u) * nloc) {
            __builtin_amdgcn_fence(__ATOMIC_RELEASE, "agent");
            asm volatile("s_waitcnt vmcnt(0)" ::: "memory");
            const unsigned og = xb_add(&bar[XB_TOP], 1u);
            const unsigned tg = og / nx;
            if (og + 1u == (tg + 1u) * nx) xb_add(&bar[XB_TOPGEN], 1u);
            else XB_SPIN(xb_ld(&bar[XB_TOPGEN]) == tg, bar);
            __builtin_amdgcn_fence(__ATOMIC_ACQUIRE, "agent");
            xb_add(&bar[XB_XGEN(b.x)], 1u);
            asm volatile("s_waitcnt vmcnt(0)" ::: "memory");
        } else {
            XB_SPIN(xb_ld(&bar[XB_XGEN(b.x)]) == gen, bar);
            __builtin_amdgcn_fence(__ATOMIC_ACQUIRE, "agent");
            asm volatile("s_waitcnt vmcnt(0)" ::: "memory");
        }
    }
    __syncthreads();
}


DI void xcd_local_barrier(unsigned* ctr, unsigned cnt, unsigned* bar) {
  asm volatile("s_waitcnt vmcnt(0)" ::: "memory");
  __syncthreads();
  if (threadIdx.x == 0) {
    __builtin_amdgcn_s_waitcnt(0);
    const unsigned old = xb_add(ctr, 1u);
    const unsigned round = old / cnt;
    if (old + 1u == (round + 1u) * cnt) xb_add(ctr + 32, 1u);
    else XB_SPIN(xb_ld(ctr + 32) == round, bar);
    __builtin_amdgcn_fence(__ATOMIC_ACQUIRE, "agent");
    asm volatile("s_waitcnt vmcnt(0)" ::: "memory");
  }
  __syncthreads();
}

__global__ void __launch_bounds__(NTHREADS, 2) fwd_megakernel(Params p) {
  __shared__ __attribute__((aligned(16))) char smem[SMEM_BYTES];
  cg::grid_group grid = cg::this_grid();
  const int tid = threadIdx.x;
  __shared__ uint4 xb_words;
  __shared__ int xcd_info[4];
  if (tid == 0) {
    xb_words = make_uint4(0u, 0u, 0u, 0u);
    const int x = (int)my_xcc_id();
    xcd_info[0] = x;
    xcd_info[1] = (int)atomicAdd(&p.census()[64 * x], 1u);
  }
  __syncthreads();
  (void)xcd_barrier_post(p.bar(), (volatile LAS unsigned*)&xb_words);
#define GBAR() do { XcdBarrier b_; b_.bar = p.bar(); b_.x = xb_xcc_id(); b_.st = (volatile LAS unsigned*)&xb_words; xcd_barrier(b_); } while (0)
  phase0(p, smem, tid);
  if (gridDim.y == 77u) grid.sync();
  GBAR();
  if (tid == 0) {
    int all = 1, mine = 1;
    for (int j = 0; j < 8; j++) {
      const int cj = (int)p.census()[64 * j];
      all = all && (cj > 0);
      if (j == xcd_info[0]) mine = cj;
    }
    xcd_info[2] = all;
    xcd_info[3] = mine;
  }
  __syncthreads();
#define LBAR() do { if (xcd_info[2]) xcd_local_barrier(p.lbar() + 64 * xcd_info[0], (unsigned)xcd_info[3], p.bar()); else GBAR(); } while (0)
  phase1a(p, smem, tid, xcd_info[2], xcd_info[0], xcd_info[1], xcd_info[3]);
  LBAR();
  phase_cumsum(p, smem, tid, xcd_info[2], xcd_info[0], xcd_info[1], xcd_info[3]);
  phase1b(p, smem, tid, xcd_info[0], xcd_info[1]);
  LBAR();
  phase2(p, smem, tid, xcd_info[2], xcd_info[0]);
  LBAR();
  phase3(p, smem, tid, xcd_info[0], xcd_info[1]);
  LBAR();
  phase3b(p, tid, xcd_info[2], xcd_info[0], xcd_info[1], xcd_info[3]);
  LBAR();
  phase4(p, smem, tid, xcd_info[0], xcd_info[1]);
  LBAR();
  phase5(p, smem, tid, xcd_info[2], xcd_info[0], xcd_info[1], xcd_info[3]);
  GBAR();
  phase6u(p, smem, tid, xcd_info[0], xcd_info[1]);
  GBAR();
  phase7v(p, smem, tid, xcd_info[0], xcd_info[1]);
  GBAR();
  phase8(p, tid);
}

extern "C" void kernel_launch(void* const* d_in, const int* in_sizes, int n_in, void* d_out, int out_size, void* d_ws,
                              size_t ws_size, hipStream_t stream) {
  static int grid_blocks = 0;
  if (!grid_blocks) {
    int dev = 0, cus = 0, per_cu = 0;
    hipGetDevice(&dev);
    hipDeviceGetAttribute(&cus, hipDeviceAttributeMultiprocessorCount, dev);
    hipOccupancyMaxActiveBlocksPerMultiprocessor(&per_cu, fwd_megakernel, NTHREADS, 0);
    if (per_cu > 2) per_cu = 2;
    if (per_cu < 1) per_cu = 1;
    grid_blocks = cus * per_cu;
  }
  Params p{};
  p.x = (const float*)d_in[0]; p.c = (const float*)d_in[1]; p.w_ada = (const float*)d_in[2]; p.b_ada = (const float*)d_in[3];
  p.g_attn = (const float*)d_in[4]; p.w_in = (const float*)d_in[5]; p.b_f = (const float*)d_in[6];
  p.lq1 = (const float*)d_in[7]; p.lk1 = (const float*)d_in[8]; p.lq2 = (const float*)d_in[9]; p.lk2 = (const float*)d_in[10];
  p.g_subln = (const float*)d_in[11]; p.w_o = (const float*)d_in[12]; p.g_ffn = (const float*)d_in[13];
  p.w_pq = (const float*)d_in[14]; p.sub_keys = (const float*)d_in[15]; p.u_exp = (const float*)d_in[16];
  p.v_exp = (const float*)d_in[17]; p.g_final = (const float*)d_in[18];
  p.out = (float*)d_out;
  p.ws = (char*)d_ws;
  hipMemsetAsync((char*)d_ws + 205 * 1024 * 1024, 0, 32768, stream);
  void* args[] = {&p};
  hipError_t e = hipLaunchCooperativeKernel((void*)fwd_megakernel, dim3(grid_blocks), dim3(NTHREADS), args, 0, stream);
  if (e != hipSuccess) fprintf(stderr, "cooperative launch failed: %s (grid %d)\n", hipGetErrorString(e), grid_blocks);
}
```
